# Optimizing an MI355X kernel written in HIP

```python
import math
import jax, jax.numpy as jnp
from jax import lax
import numpy as np

D_MODEL = 2048
BATCH = 4
SEQ = 4096
DEPTH = 1

CHUNK = 64
Q_BLOCK = 128
D_MIX = D_MODEL
D_ATTN = D_MIX // 2
D_CONV = D_MIX - D_ATTN
N_DIFF_HEADS = 8
DIFF_QK_DIM = D_ATTN // (2 * N_DIFF_HEADS)
DIFF_V_DIM = 2 * DIFF_QK_DIM
CONV_WIDTH = 3
CONV_GROUPS = 8
CONV_GROUP_DIM = D_CONV // CONV_GROUPS
NUM_BUCKETS = 32
MAX_DISTANCE = 128
N_GROUPS = 4
EXPERTS_PER_GROUP = 8
N_EXPERTS = N_GROUPS * EXPERTS_PER_GROUP
TOP_K = 2
D_FF_EXPERT = D_MODEL // 4
PLE_DIM = 256
EPS = 1e-6
MASK_VALUE = -1e30

kernel_name = "hybrid_diffattn_shortconv_hmoe_block"


def rms_norm(x, g):
    xf = x.astype(jnp.float32)
    y = xf * lax.rsqrt(jnp.mean(xf * xf, axis=-1, keepdims=True) + EPS)
    return (y * g.astype(jnp.float32)).astype(x.dtype)


def rel_bucket(rel):
    nb = NUM_BUCKETS // 2
    max_exact = nb // 2
    ret = jnp.where(rel > 0, nb, 0).astype(jnp.int32)
    n = jnp.abs(rel)
    nf = jnp.maximum(n, 1).astype(jnp.float32)
    large = max_exact + (jnp.log(nf / max_exact) / math.log(MAX_DISTANCE / max_exact)
                         * (nb - max_exact)).astype(jnp.int32)
    large = jnp.minimum(large, nb - 1)
    return ret + jnp.where(n < max_exact, n, large)


def diff_attention(q, k, v, g_q, g_k, lq1, lk1, lq2, lk2, g_subln, rel_bias, lam_init):
    b, s, _ = q.shape
    q = rms_norm(q.reshape(b, s, N_DIFF_HEADS, 2, DIFF_QK_DIM), g_q)
    k = rms_norm(k.reshape(b, s, N_DIFF_HEADS, 2, DIFF_QK_DIM), g_k)
    v = v.reshape(b, s, N_DIFF_HEADS, DIFF_V_DIM)
    lam = (jnp.exp(jnp.sum(lq1.astype(jnp.float32) * lk1.astype(jnp.float32)))
           - jnp.exp(jnp.sum(lq2.astype(jnp.float32) * lk2.astype(jnp.float32))) + lam_init)
    scale = DIFF_QK_DIM ** -0.5
    k_pos = jnp.arange(s, dtype=jnp.int32)

    def block(i):
        q_start = i * Q_BLOCK
        qs = lax.dynamic_slice_in_dim(q, q_start, Q_BLOCK, axis=1)
        logits = jnp.einsum('bqhcd,bkhcd->bhcqk', qs, k).astype(jnp.float32) * scale
        q_pos = q_start + jnp.arange(Q_BLOCK, dtype=jnp.int32)
        bias = rel_bias[rel_bucket(k_pos[None, :] - q_pos[:, None])]
        bias = jnp.transpose(bias, (2, 0, 1)).astype(jnp.float32)
        mask = (k_pos[None, :] // CHUNK) <= (q_pos[:, None] // CHUNK)
        logits = jnp.where(mask, logits + bias[None, :, None], MASK_VALUE)
        probs = jax.nn.softmax(logits, axis=-1)
        attn = probs[:, :, 0] - lam * probs[:, :, 1]
        return jnp.einsum('bhqk,bkhe->bqhe', attn.astype(v.dtype), v)

    out = lax.map(block, jnp.arange(s // Q_BLOCK))
    out = jnp.transpose(out, (1, 0, 2, 3, 4)).reshape(b, s, N_DIFF_HEADS, DIFF_V_DIM)
    out = rms_norm(out, g_subln) * (1.0 - lam_init)
    return out.reshape(b, s, D_ATTN)


def short_gated_conv(gate_b, gate_c, u, conv_w, conv_b, g_conv):
    b, s, _ = u.shape
    cu = gate_c * u
    kern = conv_w[:, None, :].astype(cu.dtype)
    conv = lax.conv_general_dilated(cu, kern, window_strides=(1,),
                                    padding=[(CONV_WIDTH - 1, 0)],
                                    dimension_numbers=('NWC', 'WIO', 'NWC'),
                                    feature_group_count=D_CONV)
    z = gate_b * (conv + conv_b)
    z = rms_norm(z.reshape(b, s, CONV_GROUPS, CONV_GROUP_DIM),
                 g_conv.reshape(CONV_GROUPS, CONV_GROUP_DIM))
    return z.reshape(b, s, D_CONV)


def hierarchical_moe(xn, w_group, b_group, w_expert, b_expert, w1, w3, w2):
    shape = xn.shape
    t = xn.reshape(-1, shape[-1])
    n_tok = t.shape[0]
    xf = t.astype(jnp.float32)
    group_logits = xf @ w_group.astype(jnp.float32) + b_group.astype(jnp.float32)
    group_probs = jax.nn.softmax(group_logits, axis=-1)
    g = jnp.argmax(group_logits, axis=-1)
    p_g = jnp.take_along_axis(group_probs, g[:, None], axis=1)[:, 0]
    expert_logits = (xf @ w_expert.astype(jnp.float32) + b_expert.astype(jnp.float32)
                     ).reshape(n_tok, N_GROUPS, EXPERTS_PER_GROUP)
    in_group = jnp.take_along_axis(expert_logits, g[:, None, None], axis=1)[:, 0]
    top_v, top_i = lax.top_k(in_group, TOP_K)
    w_top = jax.nn.softmax(top_v, axis=-1) * p_g[:, None]
    expert_id = g[:, None] * EXPERTS_PER_GROUP + top_i
    combine = jnp.sum(jax.nn.one_hot(expert_id, N_EXPERTS, dtype=jnp.float32)
                      * w_top[..., None], axis=1).astype(t.dtype)
    out = jnp.zeros_like(t)
    for e in range(N_EXPERTS):
        hid = jax.nn.silu(t @ w1[e]) * (t @ w3[e])
        out = out + combine[:, e:e + 1] * (hid @ w2[e])
    return out.reshape(shape)


def setup_inputs(seed: int = 0) -> dict:
    key = jax.random.key(seed)
    ks = jax.random.split(key, 32)
    f32 = jnp.float32

    def nrm(k, shape, scale):
        return jax.random.normal(k, shape, f32) * scale

    def gain(k, shape):
        return 1.0 + nrm(k, shape, 0.05)

    d_in = 3 * D_ATTN + 3 * D_CONV
    return {
        "x": nrm(ks[0], (BATCH, SEQ, D_MODEL), 1.0),
        "p": nrm(ks[1], (DEPTH, BATCH, SEQ, PLE_DIM), 1.0),
        "rel_bias": nrm(ks[2], (NUM_BUCKETS, N_DIFF_HEADS), 0.5),
        "g_mix": gain(ks[3], (DEPTH, D_MODEL)),
        "w_in": nrm(ks[4], (DEPTH, D_MODEL, d_in), D_MODEL ** -0.5),
        "g_q": gain(ks[5], (DEPTH, DIFF_QK_DIM)),
        "g_k": gain(ks[6], (DEPTH, DIFF_QK_DIM)),
        "lam_q1": nrm(ks[7], (DEPTH, DIFF_QK_DIM), 0.1),
        "lam_k1": nrm(ks[8], (DEPTH, DIFF_QK_DIM), 0.1),
        "lam_q2": nrm(ks[9], (DEPTH, DIFF_QK_DIM), 0.1),
        "lam_k2": nrm(ks[10], (DEPTH, DIFF_QK_DIM), 0.1),
        "g_subln": gain(ks[11], (DEPTH, DIFF_V_DIM)),
        "conv_w": nrm(ks[12], (DEPTH, CONV_WIDTH, D_CONV), CONV_WIDTH ** -0.5),
        "conv_b": nrm(ks[13], (DEPTH, D_CONV), 0.02),
        "g_conv": gain(ks[14], (DEPTH, D_CONV)),
        "w_o": nrm(ks[15], (DEPTH, D_MIX, D_MODEL), D_MIX ** -0.5),
        "g_ffn": gain(ks[16], (DEPTH, D_MODEL)),
        "w_group": nrm(ks[17], (DEPTH, D_MODEL, N_GROUPS), D_MODEL ** -0.5),
        "b_group": nrm(ks[18], (DEPTH, N_GROUPS), 0.01),
        "w_expert": nrm(ks[19], (DEPTH, D_MODEL, N_EXPERTS), D_MODEL ** -0.5),
        "b_expert": nrm(ks[20], (DEPTH, N_EXPERTS), 0.01),
        "w1": nrm(ks[21], (DEPTH, N_EXPERTS, D_MODEL, D_FF_EXPERT), D_MODEL ** -0.5),
        "w3": nrm(ks[22], (DEPTH, N_EXPERTS, D_MODEL, D_FF_EXPERT), D_MODEL ** -0.5),
        "w2": nrm(ks[23], (DEPTH, N_EXPERTS, D_FF_EXPERT, D_MODEL), D_FF_EXPERT ** -0.5),
        "g_ple": gain(ks[24], (DEPTH, D_MODEL)),
        "w_ple_gate": nrm(ks[25], (DEPTH, D_MODEL, D_MODEL), D_MODEL ** -0.5),
        "w_ple_proj": nrm(ks[26], (DEPTH, PLE_DIM, D_MODEL), PLE_DIM ** -0.5),
    }


def reference(x, p, rel_bias, g_mix, w_in, g_q, g_k, lam_q1, lam_k1, lam_q2, lam_k2,
              g_subln, conv_w, conv_b, g_conv, w_o, g_ffn, w_group, b_group, w_expert,
              b_expert, w1, w3, w2, g_ple, w_ple_gate, w_ple_proj):
    h = x
    splits = [D_ATTN, 2 * D_ATTN, 3 * D_ATTN, 3 * D_ATTN + D_CONV, 3 * D_ATTN + 2 * D_CONV]
    for i in range(DEPTH):
        lam_init = 0.8 - 0.6 * math.exp(-0.3 * i)
        xn = rms_norm(h, g_mix[i])
        proj = xn @ w_in[i]
        q, k, v, gate_b, gate_c, u = jnp.split(proj, splits, axis=-1)
        attn_out = diff_attention(q, k, v, g_q[i], g_k[i], lam_q1[i], lam_k1[i],
                                  lam_q2[i], lam_k2[i], g_subln[i], rel_bias, lam_init)
        conv_out = short_gated_conv(gate_b, gate_c, u, conv_w[i], conv_b[i], g_conv[i])
        h = h + jnp.concatenate([attn_out, conv_out], axis=-1) @ w_o[i]
        hn = rms_norm(h, g_ffn[i])
        h = h + hierarchical_moe(hn, w_group[i], b_group[i], w_expert[i], b_expert[i],
                                 w1[i], w3[i], w2[i])
        gate = jax.nn.sigmoid(rms_norm(h, g_ple[i]) @ w_ple_gate[i])
        h = h + gate * (p[i] @ w_ple_proj[i])
    return h
```

```cpp
#include <hip/hip_runtime.h>
#include <cstdint>
#include <cstdio>

typedef unsigned short bf16_t;
typedef float f32x4 __attribute__((ext_vector_type(4)));

constexpr int BATCH = 4, SEQ = 4096, DM = 2048, M = BATCH * SEQ;
constexpr int NH = 8, DQK = 64, DV = 128, DATT = 1024, DCONV = 1024;
constexpr int NE = 32, NG = 4, EPG = 8, DFF = 512, PLE = 256;
constexpr float EPS = 1e-6f;
constexpr float LOG2E = 1.4426950408889634f;
constexpr float LAM_INIT = 0.2f;
constexpr int BT_N = 320;

constexpr size_t MiB = 1u << 20;
constexpr size_t WS_CTL = 0;
constexpr size_t WS_BT = 64 * 1024;
constexpr size_t WS_LAM = WS_BT + 16 * 1024;
constexpr size_t WS_CNT = 128 * 1024;
constexpr size_t WS_W = 1 * MiB;
constexpr size_t WS_TMP = WS_W;
constexpr size_t WS_A = 236 * MiB;
constexpr size_t WS_B = 300 * MiB;
constexpr size_t WS_C = 364 * MiB;
constexpr size_t WS_D = 428 * MiB;
constexpr size_t WS_E = 492 * MiB;
constexpr size_t WS_PB = 556 * MiB;
constexpr size_t WS_SM = 564 * MiB;
constexpr size_t WS_RS0 = WS_SM, WS_RS1 = WS_SM + 64 * 1024, WS_RS2 = WS_SM + 128 * 1024;
constexpr size_t WS_TE = WS_SM + 192 * 1024;
constexpr size_t WS_TW = WS_SM + 320 * 1024;
constexpr size_t WS_LIST = WS_SM + 1 * MiB;
constexpr size_t WS_END = 576 * MiB;

__device__ __forceinline__ float bf2f(bf16_t v) { return __uint_as_float((unsigned)v << 16); }
__device__ __forceinline__ bf16_t f2bf(float f) { unsigned u = __float_as_uint(f); return (bf16_t)((u + 0x7fffu + ((u >> 16) & 1u)) >> 16); }

__device__ __forceinline__ int rel_bucket(int rel) {
    int ret = rel > 0 ? 16 : 0; int n = rel < 0 ? -rel : rel;
    if (n < 8) return ret + n;
    int l = 31 - __clz(n * n) + 2; if (l > 15) l = 15;
    return ret + l;
}

__device__ __forceinline__ float block_sum(float v, float* red) {
    for (int o = 32; o > 0; o >>= 1) v += __shfl_xor(v, o);
    const int w = threadIdx.x >> 6, nw = blockDim.x >> 6;
    __syncthreads();
    if ((threadIdx.x & 63) == 0) red[w] = v;
    __syncthreads();
    float s = 0.f; for (int i = 0; i < nw; ++i) s += red[i];
    return s;
}


#define GAS __attribute__((address_space(1)))
#define LAS __attribute__((address_space(3)))
typedef short bf16x8 __attribute__((ext_vector_type(8)));
typedef unsigned u32x4 __attribute__((ext_vector_type(4)));
typedef unsigned u32x2 __attribute__((ext_vector_type(2)));
typedef float f32x16 __attribute__((ext_vector_type(16)));
typedef GAS unsigned gu32;
#define RLX_AGENT __ATOMIC_RELAXED, __HIP_MEMORY_SCOPE_AGENT

constexpr int NWAVES = 8, NTHR = 512;
constexpr int RING_BYTES = 131072;
constexpr int LCTL_OFF = 145408;
constexpr int LBT_OFF = LCTL_OFF + 128;
constexpr int LLS_OFF = LBT_OFF + 1280;
constexpr int LTAB_OFF = LCTL_OFF + 128;
constexpr int LDS_BYTES = 149504;
static_assert(LLS_OFF + 1024 <= LDS_BYTES && LTAB_OFF + (192 + 192 + 32) * 4 <= LDS_BYTES, "LDS map");

constexpr size_t WS_BAR = 256 * 1024;
constexpr size_t WS_WIN = WS_W;
constexpr size_t WS_WO = WS_WIN + 24 * MiB;
constexpr size_t WS_WG = WS_WO + 8 * MiB;
constexpr size_t WS_WP = WS_WG + 8 * MiB;
constexpr size_t WS_WUP = WS_WP + 1 * MiB;
constexpr size_t WS_WDN = WS_WUP + 128 * MiB;
constexpr size_t WS_WR = WS_WDN + 64 * MiB;
static_assert(WS_WR + 1 * MiB <= WS_A, "weight region");
constexpr size_t WS_LRS = WS_SM + 6 * MiB, WS_LTW = WS_SM + 8 * MiB;
constexpr size_t WS_SSQ = WS_SM + 4 * MiB;
constexpr size_t WS_H8 = WS_E + 32 * MiB;
constexpr size_t WS_H28 = WS_C + 32 * MiB;
constexpr size_t WS_PART = WS_E;

__device__ __forceinline__ int lane_id() { return (int)__builtin_amdgcn_mbcnt_hi(~0u, __builtin_amdgcn_mbcnt_lo(~0u, 0u)); }
__device__ __forceinline__ int lane_id_fresh() { unsigned z = 0u; asm volatile("" : "+v"(z)); return (int)__builtin_amdgcn_mbcnt_hi(~0u, __builtin_amdgcn_mbcnt_lo(~0u, z)); }
typedef float f32x2_t __attribute__((ext_vector_type(2))); typedef __bf16 bf16x2_t __attribute__((ext_vector_type(2)));
__device__ __forceinline__ unsigned cvt_pk_bf16(float lo, float hi) { const f32x2_t v = {lo, hi}; const bf16x2_t b = __builtin_convertvector(v, bf16x2_t); return __builtin_bit_cast(unsigned, b); }
typedef int v8i_t __attribute__((ext_vector_type(8)));
typedef int v4i_t __attribute__((ext_vector_type(4)));
__device__ __forceinline__ unsigned pack4_fp8(f32x4 v, float sc) {
    int w = 0;
    const float a = __builtin_amdgcn_fmed3f(v[0] * sc, -448.f, 448.f), b = __builtin_amdgcn_fmed3f(v[1] * sc, -448.f, 448.f);
    const float c = __builtin_amdgcn_fmed3f(v[2] * sc, -448.f, 448.f), d = __builtin_amdgcn_fmed3f(v[3] * sc, -448.f, 448.f);
    w = __builtin_amdgcn_cvt_pk_fp8_f32(a, b, w, false); w = __builtin_amdgcn_cvt_pk_fp8_f32(c, d, w, true);
    return (unsigned)w;
}
__device__ __forceinline__ f32x4 unpack4_fp8(unsigned w) { const int iw = (int)w;
    return (f32x4){__builtin_amdgcn_cvt_f32_fp8(iw, 0), __builtin_amdgcn_cvt_f32_fp8(iw, 1), __builtin_amdgcn_cvt_f32_fp8(iw, 2), __builtin_amdgcn_cvt_f32_fp8(iw, 3)}; }
constexpr float F8_W = 256.f, F8_H = 16.f, F8_HID = 8.f, F8_Y = 32.f;
constexpr int E8_W = 0x77777777, E8_H = 0x7b7b7b7b, E8_HID = 0x7c7c7c7c;
__device__ __forceinline__ float fast_sigmoid(float z) { return __builtin_amdgcn_rcpf(1.f + __builtin_amdgcn_exp2f(-LOG2E * z)); }

__device__ __forceinline__ u32x4 pack8(f32x4 a, f32x4 b) { u32x4 w; w.x = cvt_pk_bf16(a[0], a[1]); w.y = cvt_pk_bf16(a[2], a[3]); w.z = cvt_pk_bf16(b[0], b[1]); w.w = cvt_pk_bf16(b[2], b[3]); return w; }
__device__ __forceinline__ float dot4(f32x4 a) { return (a[0] * a[0] + a[1] * a[1]) + (a[2] * a[2] + a[3] * a[3]); }

#define XB_TMO      128
#define XB_XCNT(j)  (256  + 64 * (j))
#define XB_XSUB(j)  (1280 + 64 * (j))
#define XB_XGEN(j)  (2304 + 64 * (j))
#define XB_TOP      3328
#define XB_TOPGEN   3392
#define XCD_BAR_WORDS 3456
#define XB_SPIN_CAP (1u << 18)
__device__ __forceinline__ unsigned xb_ld(unsigned* p)              { return __hip_atomic_load(p, __ATOMIC_RELAXED, __HIP_MEMORY_SCOPE_AGENT); }
__device__ __forceinline__ unsigned xb_add(unsigned* p, unsigned v) { return __hip_atomic_fetch_add(p, v, __ATOMIC_RELAXED, __HIP_MEMORY_SCOPE_AGENT); }
__device__ __forceinline__ unsigned xb_xcc_id() { return (unsigned)__builtin_amdgcn_s_getreg((3 << 11) | 20) & 0xFu; }
#define XB_SPIN(cond, bar) do { unsigned _sp = 0; while (cond) { __builtin_amdgcn_s_sleep(1); \
    if ((++_sp & 255u) == 0u) { if (xb_ld(&(bar)[XB_TMO])) break; if (_sp > XB_SPIN_CAP) { atomicAdd(&(bar)[XB_TMO], 1u); break; } } } } while (0)
struct XcdBarrier { unsigned* bar; unsigned x; volatile LAS unsigned* st; };
__device__ __forceinline__ XcdBarrier xcd_barrier_post(unsigned* bar, volatile LAS unsigned* st) {
    XcdBarrier b; b.bar = bar; b.x = xb_xcc_id(); b.st = st;
    if (threadIdx.x == 0) (void)xb_add(&bar[XB_XCNT(b.x)], 1u);
    return b;
}
__device__ __forceinline__ void xcd_barrier_complete(unsigned* bar, unsigned x, unsigned& nloc, unsigned& nx) {
    const unsigned G = gridDim.x * gridDim.y * gridDim.z;
    unsigned sum, cnt, mine, sp = 0u;
    for (;;) {
        sum = 0u; cnt = 0u; mine = 0u;
#pragma unroll
        for (unsigned j = 0; j < 16; ++j) { const unsigned c = xb_ld(&bar[XB_XCNT(j)]); sum += c; cnt += (c > 0u) ? 1u : 0u; mine = (j == x) ? c : mine; }
        if (sum == G) break;
        __builtin_amdgcn_s_sleep(1);
        if ((++sp & 255u) == 0u) { if (xb_ld(&bar[XB_TMO])) break; if (sp > XB_SPIN_CAP) { atomicAdd(&bar[XB_TMO], 1u); break; } }
    }
    nloc = mine > 0u ? mine : 1u; nx = cnt > 0u ? cnt : 1u;
}
__device__ __forceinline__ void xcd_barrier(const XcdBarrier& b) {
    asm volatile("s_waitcnt vmcnt(0)" ::: "memory");
    __syncthreads();
    if (threadIdx.x == 0) {
        unsigned* bar = b.bar;
        __builtin_amdgcn_s_waitcnt(0);
        unsigned nloc = b.st[0], nx = b.st[1];
        if (nloc == 0u) { xcd_barrier_complete(bar, b.x, nloc, nx); b.st[0] = nloc; b.st[1] = nx; }
        const unsigned old = xb_add(&bar[XB_XSUB(b.x)], 1u);
        const unsigned gen = old / nloc;
        if (old + 1u == (gen + 1u) * nloc) {
            __builtin_amdgcn_fence(__ATOMIC_RELEASE, "agent");
            asm volatile("s_waitcnt vmcnt(0)" ::: "memory");
            const unsigned og = xb_add(&bar[XB_TOP], 1u);
            const unsigned tg = og / nx;
            if (og + 1u == (tg + 1u) * nx) xb_add(&bar[XB_TOPGEN], 1u);
            else XB_SPIN(xb_ld(&bar[XB_TOPGEN]) == tg, bar);
            __builtin_amdgcn_fence(__ATOMIC_ACQUIRE, "agent");
            xb_add(&bar[XB_XGEN(b.x)], 1u);
            asm volatile("s_waitcnt vmcnt(0)" ::: "memory");
        } else {
            XB_SPIN(xb_ld(&bar[XB_XGEN(b.x)]) == gen, bar);
            __builtin_amdgcn_fence(__ATOMIC_ACQUIRE, "agent");
            asm volatile("s_waitcnt vmcnt(0)" ::: "memory");
        }
    }
    __syncthreads();
}

namespace g8 {
constexpr int BM = 256, BK = 64, HALF = 128, HTB = HALF * BK * 2, STAGE_BYTES = 8 * HTB;
static_assert(STAGE_BYTES == RING_BYTES, "ring");
__host__ __device__ __forceinline__ int lds_byte(int r, int c) { const int st = (r >> 4) * 2 + (c >> 5), rr = r & 15, cc = c & 31, ob = rr * 64 + cc * 2; return st * 1024 + (ob ^ (((ob >> 9) & 1) << 5)); }
__host__ __device__ __forceinline__ void stage_rc(int b, int& R, int& C) { const int st = b / 1024, sb = b % 1024, swz = sb ^ (((sb >> 9) & 1) << 5); R = (st >> 1) * 16 + swz / 64; C = (st & 1) * 32 + (swz % 64) / 2; }
struct Unit { int pm, pn, e; };

struct DenseSched {
    static constexpr bool GATHER = false;
    const char* A; const char* Bt; int lda, ldb; int nM, nN, nwg, G, c;
    __device__ __forceinline__ void init(const void* A_, int lda_, const void* Bt_, int ldb_, int Mrows, int N, int G_, int c_) { A = (const char*)A_; Bt = (const char*)Bt_; lda = lda_; ldb = ldb_; nM = Mrows / BM; nN = N / BM; nwg = nM * nN; G = G_; c = c_; }
    __device__ __forceinline__ bool next(int i, Unit& u) const {
        const long L = (long)i * G + c; if (L >= nwg) return false;
        int wgid = (int)L; { const int q = nwg / 8, r = nwg % 8, xcd = wgid % 8, off = wgid / 8; wgid = (xcd < r ? xcd * (q + 1) : r * (q + 1) + (xcd - r) * q) + off; }
        const int nig = 8 * nN, gid = wgid / nig, fm = gid * 8, gsz = (nM - fm) < 8 ? (nM - fm) : 8;
        u.pm = fm + ((wgid % nig) % gsz); u.pn = (wgid % nig) / gsz; u.e = 0; return true;
    }
    __device__ __forceinline__ const char* a_base(const Unit& u) const { return A + (size_t)u.pm * BM * lda; }
    __device__ __forceinline__ const char* b_base(const Unit& u) const { return Bt + (size_t)u.pn * BM * ldb; }
    __device__ __forceinline__ unsigned a_off(const Unit&, int row, int C) const { return (unsigned)(row * lda + C * 2); }
    __device__ __forceinline__ unsigned b_off(int row, int C) const { return (unsigned)(row * ldb + C * 2); }
};

template <class Epi, class Sched, bool F8 = false>
__device__ __forceinline__ void gemm_phase(LAS unsigned char* lds, const int wid, const int K, const Sched& S, const Epi& E, const int sclW = 0, const int sclA = 0) {
    const int lane = lane_id(), tid = wid * 64 + lane, wr = wid >> 2, wc = wid & 3, fr = lane & 15, fq = lane >> 4;
    const int nt = F8 ? K / 128 : K / BK;
    int Rr[2], Cc[2];
#pragma unroll
    for (int i = 0; i < 2; ++i) stage_rc(tid * 16 + i * 8192, Rr[i], Cc[i]);
    unsigned voffB[2];
#pragma unroll
    for (int i = 0; i < 2; ++i) voffB[i] = S.b_off(Rr[i], Cc[i]);
    const size_t kstep = (size_t)(BK * 2);
    const size_t hstepB = (size_t)S.b_off(HALF, 0);
    const unsigned ldsw = (unsigned)wid * 1024u;
    const int aoff = lds_byte(wr * 64 + fr, fq * 8), boff = lds_byte(wc * 32 + fr, fq * 8);
#define G8_SA(b, h) (((b) * 2 + (h)) * HTB)
#define G8_SB(b, h) ((4 + (b) * 2 + (h)) * HTB)
#define G8_STAGE(bufoff, gbase, voff) do { _Pragma("unroll") for (int _i = 0; _i < 2; ++_i) { unsigned _o = (voff)[_i]; asm volatile("" : "+v"(_o));     \
        __builtin_amdgcn_global_load_lds((const unsigned*)((const char*)(gbase) + _o), (LAS unsigned*)(lds + (bufoff) + ldsw + _i * 8192), 16, 0, 0); } } while (0)
#define G8_LD32(p) __builtin_shufflevector(*(const LAS v4i_t*)(p), *(const LAS v4i_t*)((p) + 1024), 0, 1, 2, 3, 4, 5, 6, 7)
#define G8_LDA(dst, b, h) do { _Pragma("unroll") for (int m = 0; m < 4; ++m) dst[m] = G8_LD32(lds + G8_SA(b, h) + aoff + m * 2048); } while (0)
#define G8_LDB(dst, b, h) do { _Pragma("unroll") for (int n = 0; n < 2; ++n) dst[n] = G8_LD32(lds + G8_SB(b, h) + boff + n * 2048); } while (0)
#define G8_LO(x) __builtin_bit_cast(bf16x8, __builtin_shufflevector(x, x, 0, 1, 2, 3))
#define G8_HI(x) __builtin_bit_cast(bf16x8, __builtin_shufflevector(x, x, 4, 5, 6, 7))
#define G8_MMA(ai, bj, At, Bt) do { __builtin_amdgcn_s_setprio(1); _Pragma("unroll") for (int m = 0; m < 4; ++m) _Pragma("unroll") for (int n = 0; n < 2; ++n) { \
        if constexpr (F8) acc[ai][bj][m][n] = __builtin_amdgcn_mfma_scale_f32_16x16x128_f8f6f4(Bt[n], At[m], acc[ai][bj][m][n], 0, 0, 0, sclW, 0, sclA); \
        else { acc[ai][bj][m][n] = __builtin_amdgcn_mfma_f32_16x16x32_bf16(G8_LO(Bt[n]), G8_LO(At[m]), acc[ai][bj][m][n], 0, 0, 0); \
               acc[ai][bj][m][n] = __builtin_amdgcn_mfma_f32_16x16x32_bf16(G8_HI(Bt[n]), G8_HI(At[m]), acc[ai][bj][m][n], 0, 0, 0); } } \
        __builtin_amdgcn_s_setprio(0); } while (0)
#define G8_WAIT_V(n) asm volatile("s_waitcnt vmcnt(" #n ")" ::: "memory")
#define G8_WAIT_L(n) asm volatile("s_waitcnt lgkmcnt(" #n ")" ::: "memory")
#define G8_BAR __builtin_amdgcn_s_barrier()
#define G8_SCHED __builtin_amdgcn_sched_barrier(0)
    Unit cur, nxt; int ui = 0;
    if (!S.next(0, cur)) return;
    f32x4 acc[2][2][4][2];
#pragma unroll
    for (int a = 0; a < 2; ++a)
#pragma unroll
        for (int b = 0; b < 2; ++b)
#pragma unroll
            for (int m = 0; m < 4; ++m)
#pragma unroll
                for (int n = 0; n < 2; ++n) acc[a][b][m][n] = (f32x4){0.f, 0.f, 0.f, 0.f};
    v8i_t At[4], B0[2], B1[2];
    unsigned cvA[2][2];
#define G8_NVSLOT ((LAS u32x4*)(lds + RING_BYTES) + (lane_id_fresh() + wid * 64))
#pragma unroll
    for (int h = 0; h < 2; ++h)
#pragma unroll
        for (int i = 0; i < 2; ++i) cvA[h][i] = S.a_off(cur, h * HALF + Rr[i], Cc[i]);
    const char* cA = S.a_base(cur); const char* cB = S.b_base(cur);
    G8_STAGE(G8_SB(0, 0), cB, voffB); G8_STAGE(G8_SB(0, 1), cB + hstepB, voffB); G8_STAGE(G8_SA(0, 0), cA, cvA[0]); G8_STAGE(G8_SA(0, 1), cA, cvA[1]);
    if (wr == 1) G8_BAR;
    G8_WAIT_V(2); G8_BAR;
    G8_STAGE(G8_SB(1, 0), cB + kstep, voffB); G8_STAGE(G8_SA(1, 0), cA + kstep, cvA[0]); G8_STAGE(G8_SB(1, 1), cB + hstepB + kstep, voffB);
    G8_WAIT_V(6); G8_BAR;
    for (;;) {
        const bool has_next = S.next(ui + 1, nxt);
        const char* nA = has_next ? S.a_base(nxt) : cA; const char* nB = has_next ? S.b_base(nxt) : cB;
        if constexpr (Sched::GATHER) {
            const int t2 = lane_id_fresh() + wid * 64;
            int R0, C0, R1, C1; stage_rc(t2 * 16, R0, C0); stage_rc(t2 * 16 + 8192, R1, C1);
            u32x4 nv;
            nv.x = has_next ? S.a_off(nxt, R0, C0) : cvA[0][0]; nv.y = has_next ? S.a_off(nxt, R1, C1) : cvA[0][1];
            nv.z = has_next ? S.a_off(nxt, HALF + R0, C0) : cvA[1][0]; nv.w = has_next ? S.a_off(nxt, HALF + R1, C1) : cvA[1][1];
            *((LAS u32x4*)(lds + RING_BYTES) + t2) = nv;
        }
        for (int t = 0; t < nt; t += 2) {
            const bool last = (t == nt - 2);
            const char* a1 = cA + (size_t)(t + 1) * kstep;
            const char* a2 = last ? nA : cA + (size_t)(t + 2) * kstep; const char* b2 = last ? nB : cB + (size_t)(t + 2) * kstep;
            const char* a3 = a2 + kstep; const char* b3 = b2 + kstep;
            unsigned v2[2][2];
            if (Sched::GATHER && last) { const u32x4 nv = *G8_NVSLOT; v2[0][0] = nv.x; v2[0][1] = nv.y; v2[1][0] = nv.z; v2[1][1] = nv.w; }
            else { v2[0][0] = cvA[0][0]; v2[0][1] = cvA[0][1]; v2[1][0] = cvA[1][0]; v2[1][1] = cvA[1][1]; }
            G8_LDB(B0, 0, 0); G8_LDB(B1, 0, 1); G8_SCHED; G8_LDA(At, 0, 0); G8_STAGE(G8_SA(1, 1), a1, cvA[1]);
            G8_WAIT_V(8); G8_WAIT_L(0); G8_BAR; G8_MMA(0, 0, At, B0); G8_MMA(0, 1, At, B1); G8_BAR; G8_SCHED;
            G8_LDA(At, 0, 1); G8_STAGE(G8_SB(0, 0), b2, voffB); G8_STAGE(G8_SB(0, 1), b2 + hstepB, voffB); G8_STAGE(G8_SA(0, 0), a2, v2[0]);
            G8_WAIT_V(8); G8_WAIT_L(0); G8_BAR; G8_MMA(1, 0, At, B0); G8_MMA(1, 1, At, B1); G8_BAR; G8_SCHED;
            G8_LDB(B0, 1, 0); G8_LDB(B1, 1, 1); G8_SCHED; G8_LDA(At, 1, 0); G8_STAGE(G8_SA(0, 1), a2, v2[1]);
            G8_WAIT_V(8); G8_WAIT_L(0); G8_BAR; G8_MMA(0, 0, At, B0); G8_MMA(0, 1, At, B1); G8_BAR; G8_SCHED;
            G8_LDA(At, 1, 1); G8_STAGE(G8_SB(1, 0), b3, voffB); G8_STAGE(G8_SB(1, 1), b3 + hstepB, voffB); G8_STAGE(G8_SA(1, 0), a3, v2[0]);
            G8_WAIT_V(8); G8_WAIT_L(0); G8_BAR; G8_MMA(1, 0, At, B0); G8_MMA(1, 1, At, B1); G8_BAR; G8_SCHED;
        }
        if (wr == 0) G8_BAR;
        { const int lf = lane_id_fresh(); E(acc, cur, wr, wc, lf & 15, lf >> 4); }
        if (!has_next) break;
#pragma unroll
        for (int a = 0; a < 2; ++a)
#pragma unroll
            for (int b = 0; b < 2; ++b)
#pragma unroll
                for (int m = 0; m < 4; ++m)
#pragma unroll
                    for (int n = 0; n < 2; ++n) acc[a][b][m][n] = (f32x4){0.f, 0.f, 0.f, 0.f};
        cur = nxt; cA = nA; cB = nB; ++ui;
        if constexpr (Sched::GATHER) { const u32x4 nv = *G8_NVSLOT; cvA[0][0] = nv.x; cvA[0][1] = nv.y; cvA[1][0] = nv.z; cvA[1][1] = nv.w; }
        if (wr == 1) G8_BAR;
    }
    G8_WAIT_V(0);
    G8_BAR;
#undef G8_SA
#undef G8_SB
#undef G8_STAGE
#undef G8_LDA
#undef G8_LDB
#undef G8_MMA
#undef G8_NVSLOT
#undef G8_LO
#undef G8_HI
#undef G8_LD32
#undef G8_WAIT_V
#undef G8_WAIT_L
#undef G8_BAR
#undef G8_SCHED
}


struct EpiProj {
    const float* rs0; const float* g_q; const float* g_k; bf16_t *Q, *Kb, *V, *GB, *CU;
    __device__ __forceinline__ void operator()(f32x4 (&acc)[2][2][4][2], const Unit& u, int wr, int wc, int fr, int fq) const {
        const int pn = u.pn, rbase = u.pm * BM + wr * 64 + fr;
        float rsv[2][4];
#pragma unroll
        for (int ai = 0; ai < 2; ++ai)
#pragma unroll
            for (int m = 0; m < 4; ++m) rsv[ai][m] = rs0[rbase + ai * HALF + m * 16];
        if (pn < 8) {
            const bool isq = pn < 4; const float* gn = isq ? g_q : g_k; const float sc = isq ? 0.125f * LOG2E : 1.f;
            bf16_t* O = isq ? Q : Kb; const int colb = (pn & 3) * 256 + wc * 64 + fq * 8;
            f32x4 gv[2][2];
#pragma unroll
            for (int bj = 0; bj < 2; ++bj)
#pragma unroll
                for (int n = 0; n < 2; ++n) gv[bj][n] = *(const f32x4*)(gn + bj * 32 + fq * 8 + n * 4);
#pragma unroll
            for (int ai = 0; ai < 2; ++ai)
#pragma unroll
                for (int m = 0; m < 4; ++m) {
                    const int row = rbase + ai * HALF + m * 16; const float rs = rsv[ai][m];
                    float ss = 0.f;
#pragma unroll
                    for (int bj = 0; bj < 2; ++bj)
#pragma unroll
                        for (int n = 0; n < 2; ++n) { acc[ai][bj][m][n] = acc[ai][bj][m][n] * rs; ss += dot4(acc[ai][bj][m][n]); }
                    ss += __shfl_xor(ss, 16); ss += __shfl_xor(ss, 32);
                    const float r = rsqrtf(ss * (1.f / 64.f) + EPS) * sc;
#pragma unroll
                    for (int bj = 0; bj < 2; ++bj) *(u32x4*)(O + (size_t)row * 1024 + colb + bj * 32) = pack8(acc[ai][bj][m][0] * r * gv[bj][0], acc[ai][bj][m][1] * r * gv[bj][1]);
                }
        } else if (pn < 16) {
            bf16_t* O = pn < 12 ? V : GB; const int colb = (pn & 3) * 256 + wc * 32 + fq * 8;
#pragma unroll
            for (int ai = 0; ai < 2; ++ai)
#pragma unroll
                for (int m = 0; m < 4; ++m) {
                    const int row = rbase + ai * HALF + m * 16; const float rs = rsv[ai][m];
#pragma unroll
                    for (int bj = 0; bj < 2; ++bj) *(u32x4*)(O + (size_t)row * 1024 + colb + bj * 128) = pack8(acc[ai][bj][m][0] * rs, acc[ai][bj][m][1] * rs);
                }
        } else {
            const int colb = (pn - 16) * 128 + wc * 32 + fq * 8;
#pragma unroll
            for (int ai = 0; ai < 2; ++ai)
#pragma unroll
                for (int m = 0; m < 4; ++m) {
                    const int row = rbase + ai * HALF + m * 16; const float rs = rsv[ai][m], rs2 = rs * rs;
                    *(u32x4*)(CU + (size_t)row * 1024 + colb) = pack8(acc[ai][0][m][0] * acc[ai][1][m][0] * rs2, acc[ai][0][m][1] * acc[ai][1][m][1] * rs2);
                }
        }
    }
};
struct EpiBf16 {
    bf16_t* O; int ldo;
    __device__ __forceinline__ void operator()(f32x4 (&acc)[2][2][4][2], const Unit& u, int wr, int wc, int fr, int fq) const {
        const int rbase = u.pm * BM + wr * 64 + fr, colb = u.pn * BM + wc * 32 + fq * 8;
#pragma unroll
        for (int ai = 0; ai < 2; ++ai)
#pragma unroll
            for (int m = 0; m < 4; ++m) { const int row = rbase + ai * HALF + m * 16;
#pragma unroll
                for (int bj = 0; bj < 2; ++bj) *(u32x4*)(O + (size_t)row * ldo + colb + bj * 128) = pack8(acc[ai][bj][m][0], acc[ai][bj][m][1]); }
    }
};
struct EpiRes {
    const float* x; bf16_t* H; float* SSQ; unsigned char* H8;
    __device__ __forceinline__ void operator()(f32x4 (&acc)[2][2][4][2], const Unit& u, int wr, int wc, int fr, int fq) const {
        const int rbase = u.pm * BM + wr * 64 + fr, colb = u.pn * BM + wc * 32 + fq * 8;
        f32x4 xa[2][2][2][2];
#define ER_LOAD(buf, b) do { _Pragma("unroll") for (int r2 = 0; r2 < 2; ++r2) { const int row_ = rbase + ((b) >> 1) * HALF + (((b) & 1) * 2 + r2) * 16; \
            _Pragma("unroll") for (int bj = 0; bj < 2; ++bj) { const size_t o_ = (size_t)row_ * DM + colb + bj * 128; xa[buf][r2][bj][0] = *(const f32x4*)(x + o_); xa[buf][r2][bj][1] = *(const f32x4*)(x + o_ + 4); } } } while (0)
        ER_LOAD(0, 0);
#pragma unroll
        for (int b = 0; b < 4; ++b) {
            if (b == 0) ER_LOAD(1, 1); else if (b == 1) ER_LOAD(0, 2); else if (b == 2) ER_LOAD(1, 3);
#pragma unroll
            for (int r2 = 0; r2 < 2; ++r2) { const int ai = b >> 1, m = (b & 1) * 2 + r2, row = rbase + ai * HALF + m * 16; float ss = 0.f;
#pragma unroll
                for (int bj = 0; bj < 2; ++bj) { const size_t o = (size_t)row * DM + colb + bj * 128;
                    const f32x4 h0 = acc[ai][bj][m][0] + xa[b & 1][r2][bj][0], h1 = acc[ai][bj][m][1] + xa[b & 1][r2][bj][1];
                    ss += dot4(h0) + dot4(h1);
                    *(u32x4*)(H + o) = pack8(h0, h1);
                    u32x2 w8; w8.x = pack4_fp8(h0, F8_H); w8.y = pack4_fp8(h1, F8_H); *(u32x2*)(H8 + o) = w8; }
                ss += __shfl_xor(ss, 16); ss += __shfl_xor(ss, 32);
                if (fq == 0) SSQ[(size_t)row * 32 + u.pn * 4 + wc] = ss; }
        }
#undef ER_LOAD
    }
};
struct EpiRouter {
    float* PART;
    __device__ __forceinline__ void operator()(f32x4 (&acc)[2][2][4][2], const Unit& u, int wr, int wc, int fr, int fq) const {
        if (wc < 2) {
            const int rbase = u.pm * BM + wr * 64 + fr;
#pragma unroll
            for (int ai = 0; ai < 2; ++ai)
#pragma unroll
                for (int m = 0; m < 4; ++m) { const int row = rbase + ai * HALF + m * 16;
#pragma unroll
                    for (int n = 0; n < 2; ++n) *(f32x4*)(PART + ((size_t)u.e * M + row) * 64 + wc * 32 + n * 16 + fq * 4) = acc[ai][0][m][n]; }
        }
    }
};
struct KSplitSched {
    static constexpr bool GATHER = false;
    const char* A; const char* Bt; int G, c;
    __device__ __forceinline__ bool next(int i, Unit& u) const { const int L = i * G + c; if (L >= (M / BM) * 4) return false; u.pm = L >> 2; u.pn = 0; u.e = L & 3; return true; }
    __device__ __forceinline__ const char* a_base(const Unit& u) const { return A + (size_t)u.pm * BM * DM * 2 + (size_t)u.e * 512 * 2; }
    __device__ __forceinline__ const char* b_base(const Unit& u) const { return Bt + (size_t)u.e * 512 * 2; }
    __device__ __forceinline__ unsigned a_off(const Unit&, int row, int C) const { return (unsigned)(row * DM + C) * 2u; }
    __device__ __forceinline__ unsigned b_off(int row, int C) const { return (unsigned)(row * DM + C) * 2u; }
};
__device__ __forceinline__ f32x4 bf4lo(unsigned a, unsigned b) { return (f32x4){__uint_as_float(a << 16), __uint_as_float(a & 0xffff0000u), __uint_as_float(b << 16), __uint_as_float(b & 0xffff0000u)}; }
struct EpiFinal {
    const bf16_t* H2B; const bf16_t* PP; const float* rs2; float* out;
    __device__ __forceinline__ void operator()(f32x4 (&acc)[2][2][4][2], const Unit& u, int wr, int wc, int fr, int fq) const {
        const int rbase = u.pm * BM + wr * 64 + fr, colb = u.pn * BM + wc * 32 + fq * 8;
        float rsv[2][4];
#pragma unroll
        for (int ai = 0; ai < 2; ++ai)
#pragma unroll
            for (int m = 0; m < 4; ++m) rsv[ai][m] = rs2[rbase + ai * HALF + m * 16];
        u32x4 hb[2][2][2], pb[2][2][2];
#define EF_LOAD(buf, b) do { _Pragma("unroll") for (int r2 = 0; r2 < 2; ++r2) { const int row_ = rbase + ((b) >> 1) * HALF + (((b) & 1) * 2 + r2) * 16; \
            _Pragma("unroll") for (int bj = 0; bj < 2; ++bj) { const size_t o_ = (size_t)row_ * DM + colb + bj * 128; hb[buf][r2][bj] = *(const u32x4*)(H2B + o_); pb[buf][r2][bj] = *(const u32x4*)(PP + o_); } } } while (0)
        EF_LOAD(0, 0);
#pragma unroll
        for (int b = 0; b < 4; ++b) {
            if (b == 0) EF_LOAD(1, 1); else if (b == 1) EF_LOAD(0, 2); else if (b == 2) EF_LOAD(1, 3);
#pragma unroll
            for (int r2 = 0; r2 < 2; ++r2) { const int ai = b >> 1, m = (b & 1) * 2 + r2, row = rbase + ai * HALF + m * 16; const float rs = rsv[ai][m];
#pragma unroll
                for (int bj = 0; bj < 2; ++bj) { const size_t o = (size_t)row * DM + colb + bj * 128;
                    const u32x4 hv = hb[b & 1][r2][bj], pv = pb[b & 1][r2][bj];
                    const f32x4 h0 = bf4lo(hv.x, hv.y), h1 = bf4lo(hv.z, hv.w), p0 = bf4lo(pv.x, pv.y), p1 = bf4lo(pv.z, pv.w);
                    f32x4 z0 = acc[ai][bj][m][0] * rs, z1 = acc[ai][bj][m][1] * rs, o0, o1;
#pragma unroll
                    for (int j = 0; j < 4; ++j) { o0[j] = h0[j] + p0[j] * fast_sigmoid(z0[j]); o1[j] = h1[j] + p1[j] * fast_sigmoid(z1[j]); }
                    *(f32x4*)(out + o) = o0; *(f32x4*)(out + o + 4) = o1; } }
        }
#undef EF_LOAD
    }
};

struct MoeTab { const LAS int* texp; const LAS int* trow0; const LAS int* tcnt; int ntile; };
struct UpSched {
    static constexpr bool GATHER = true;
    const char* Hb; const char* Wup; const int* LIST; MoeTab T; int G, c;
    __device__ __forceinline__ bool next(int i, Unit& u) const { const int L = i * G + c; if (L >= T.ntile * 4) return false; u.pm = L >> 2; u.pn = L & 3; u.e = T.texp[u.pm]; return true; }
    __device__ __forceinline__ const char* a_base(const Unit&) const { return Hb; }
    __device__ __forceinline__ const char* b_base(const Unit& u) const { return Wup + ((size_t)u.e * 1024 + (size_t)u.pn * 256) * DM; }
    __device__ __forceinline__ unsigned a_off(const Unit& u, int row, int C) const {
        int idx = T.trow0[u.pm] + row; const int n = T.tcnt[u.e]; idx = idx < n ? idx : n - 1;
        const int slot = LIST[(size_t)u.e * M + idx]; return (unsigned)(slot >> 1) * (unsigned)DM + (unsigned)C * 2u; }
    __device__ __forceinline__ unsigned b_off(int row, int C) const { return (unsigned)(row * DM + C * 2); }
};
struct DnSched {
    static constexpr bool GATHER = false;
    const char* HID; const char* Wdn; MoeTab T; int G, c;
    __device__ __forceinline__ bool next(int i, Unit& u) const { const int L = i * G + c; if (L >= T.ntile * 8) return false; u.pm = L >> 3; u.pn = L & 7; u.e = T.texp[u.pm]; return true; }
    __device__ __forceinline__ const char* a_base(const Unit& u) const { return HID + (size_t)u.pm * 256 * DFF; }
    __device__ __forceinline__ const char* b_base(const Unit& u) const { return Wdn + ((size_t)u.e * DM + (size_t)u.pn * 256) * DFF; }
    __device__ __forceinline__ unsigned a_off(const Unit&, int row, int C) const { return (unsigned)(row * DFF + C * 2); }
    __device__ __forceinline__ unsigned b_off(int row, int C) const { return (unsigned)(row * DFF + C * 2); }
};
struct EpiUp {
    const float* LRS; bf16_t* HID; MoeTab T;
    __device__ __forceinline__ void operator()(f32x4 (&acc)[2][2][4][2], const Unit& u, int wr, int wc, int fr, int fq) const {
        const int r0 = T.trow0[u.pm], n = T.tcnt[u.e], colb = u.pn * 128 + wc * 32 + fq * 8;
        float rsv[2][4];
#pragma unroll
        for (int ai = 0; ai < 2; ++ai)
#pragma unroll
            for (int m = 0; m < 4; ++m) { const int idx = r0 + ai * HALF + wr * 64 + m * 16 + fr; rsv[ai][m] = LRS[(size_t)u.e * M + (idx < n ? idx : n - 1)]; }
#pragma unroll
        for (int ai = 0; ai < 2; ++ai)
#pragma unroll
            for (int m = 0; m < 4; ++m) {
                const int rit = ai * HALF + wr * 64 + m * 16 + fr; const bool valid = r0 + rit < n; const float rs = rsv[ai][m];
                f32x4 h[2];
#pragma unroll
                for (int nn = 0; nn < 2; ++nn) { const f32x4 a = acc[ai][0][m][nn] * rs, b = acc[ai][1][m][nn] * rs;
#pragma unroll
                    for (int j = 0; j < 4; ++j) h[nn][j] = valid ? a[j] * fast_sigmoid(a[j]) * b[j] : 0.f; }
                u32x2 w8; w8.x = pack4_fp8(h[0], F8_HID); w8.y = pack4_fp8(h[1], F8_HID);
                *(u32x2*)((unsigned char*)HID + ((size_t)u.pm * 256 + rit) * DFF + colb) = w8;
            }
    }
};
struct EpiDn {
    const int* LIST; const float* LTW; bf16_t* Y0; bf16_t* Y1; MoeTab T;
    __device__ __forceinline__ void operator()(f32x4 (&acc)[2][2][4][2], const Unit& u, int wr, int wc, int fr, int fq) const {
        const int r0 = T.trow0[u.pm], n = T.tcnt[u.e], colb = u.pn * BM + wc * 32 + fq * 8;
        int slv[2][4]; float twv[2][4];
#pragma unroll
        for (int ai = 0; ai < 2; ++ai)
#pragma unroll
            for (int m = 0; m < 4; ++m) { const int idx = r0 + ai * HALF + wr * 64 + m * 16 + fr; const size_t p = (size_t)u.e * M + (idx < n ? idx : n - 1); slv[ai][m] = LIST[p]; twv[ai][m] = LTW[p]; }
#pragma unroll
        for (int ai = 0; ai < 2; ++ai)
#pragma unroll
            for (int m = 0; m < 4; ++m) {
                const int idx = r0 + ai * HALF + wr * 64 + m * 16 + fr;
                if (idx < n) { const int slot = slv[ai][m]; const float tw = twv[ai][m];
                    unsigned char* Y = (unsigned char*)((slot & 1) ? Y1 : Y0) + (size_t)(slot >> 1) * DM + colb;
#pragma unroll
                    for (int bj = 0; bj < 2; ++bj) { u32x2 w8; w8.x = pack4_fp8(acc[ai][bj][m][0] * tw, F8_Y); w8.y = pack4_fp8(acc[ai][bj][m][1] * tw, F8_Y); *(u32x2*)(Y + bj * 128) = w8; } }
            }
    }
};
}

struct Args { const float* in[27]; float* out; unsigned char* ws; int ph_lo, ph_hi, li, pad; };
struct Frame {
    LAS unsigned char* lds; volatile LAS unsigned* MISC; unsigned char* ws;
    int wave, vcu, G;
};

__device__ __forceinline__ float wave_sum(float v) {
#pragma unroll
    for (int o = 1; o < 64; o <<= 1) v += __shfl_xor(v, o);
    return v;
}

__device__ __forceinline__ void tr_item(const float* src, int ld, const float* ks, int k0, int c0, bf16_t* dst, int ldk, int d0, int d1, LAS float* scr, int lane) {
    f32x4 v[16];
#pragma unroll
    for (int i = 0; i < 16; ++i) v[i] = *(const f32x4*)(src + (size_t)(k0 + 4 * i + (lane >> 4)) * ld + c0 + (lane & 15) * 4);
    const int c8 = lane & 7;
    f32x4 g0 = (f32x4){1.f, 1.f, 1.f, 1.f}, g1 = g0;
    if (ks) { g0 = *(const f32x4*)(ks + k0 + 8 * c8); g1 = *(const f32x4*)(ks + k0 + 8 * c8 + 4); }
#pragma unroll
    for (int i = 0; i < 16; ++i) { LAS float* s = scr + (4 * i + (lane >> 4)) * 65 + (lane & 15) * 4; s[0] = v[i][0]; s[1] = v[i][1]; s[2] = v[i][2]; s[3] = v[i][3]; }
    asm volatile("s_waitcnt lgkmcnt(0)" ::: "memory");
#pragma unroll
    for (int j = 0; j < 8; ++j) { const int rr = j * 8 + (lane >> 3), c32 = rr & 31;
        const int p32 = ((c32 >> 2) & 1) * 16 + (c32 >> 3) * 4 + (c32 & 3), drow = ((rr >> 5) ? d1 : d0) + p32;
        const LAS float* s = scr + (8 * c8) * 65 + rr;
        u32x4 o; o.x = cvt_pk_bf16(s[0] * g0[0], s[65] * g0[1]); o.y = cvt_pk_bf16(s[2 * 65] * g0[2], s[3 * 65] * g0[3]); o.z = cvt_pk_bf16(s[4 * 65] * g1[0], s[5 * 65] * g1[1]); o.w = cvt_pk_bf16(s[6 * 65] * g1[2], s[7 * 65] * g1[3]);
        *(u32x4*)(dst + (size_t)drow * ldk + k0 + 8 * c8) = o; }
    asm volatile("s_waitcnt lgkmcnt(0)" ::: "memory");
}
__device__ __forceinline__ void tr_item8(const float* src, int ld, const float* ks, int k0, int c0, unsigned char* dst, int ldk, int d0, int d1, LAS float* scr, int lane) {
    f32x4 v[16];
#pragma unroll
    for (int i = 0; i < 16; ++i) v[i] = *(const f32x4*)(src + (size_t)(k0 + 4 * i + (lane >> 4)) * ld + c0 + (lane & 15) * 4);
    const int c8 = lane & 7;
    f32x4 g0 = (f32x4){1.f, 1.f, 1.f, 1.f}, g1 = g0;
    if (ks) { g0 = *(const f32x4*)(ks + k0 + 8 * c8); g1 = *(const f32x4*)(ks + k0 + 8 * c8 + 4); }
#pragma unroll
    for (int i = 0; i < 16; ++i) { LAS float* s = scr + (4 * i + (lane >> 4)) * 65 + (lane & 15) * 4; s[0] = v[i][0]; s[1] = v[i][1]; s[2] = v[i][2]; s[3] = v[i][3]; }
    asm volatile("s_waitcnt lgkmcnt(0)" ::: "memory");
#pragma unroll
    for (int j = 0; j < 8; ++j) { const int rr = j * 8 + (lane >> 3), c32 = rr & 31;
        const int p32 = ((c32 >> 2) & 1) * 16 + (c32 >> 3) * 4 + (c32 & 3), drow = ((rr >> 5) ? d1 : d0) + p32;
        const LAS float* s = scr + (8 * c8) * 65 + rr;
        u32x2 o; o.x = pack4_fp8((f32x4){s[0], s[65], s[2 * 65], s[3 * 65]} * g0, F8_W); o.y = pack4_fp8((f32x4){s[4 * 65], s[5 * 65], s[6 * 65], s[7 * 65]} * g1, F8_W);
        *(u32x2*)(dst + (size_t)drow * ldk + k0 + 8 * c8) = o; }
    asm volatile("s_waitcnt lgkmcnt(0)" ::: "memory");
}
__device__ __forceinline__ int map_in(int c) {
    if (c < 2048) { const int w = c & 255; return (c & ~255) + ((w >> 5) & 1) * 128 + (w >> 6) * 32; }
    if (c < 4096) return c;
    const int ch = (c - 4096) & 1023; return (16 + (ch >> 7)) * 256 + ((ch >> 5) & 3) * 32 + (c >= 5120 ? 128 : 0);
}

__device__ __forceinline__ void prep_row(const float* x, const float* p, bf16_t* XB, float* RS0, bf16_t* PB, int row, int lane) {
    const GAS f32x4* xr = (const GAS f32x4*)(x + (size_t)row * DM) + lane;
    f32x4 v[8]; float s = 0.f;
#pragma unroll
    for (int j = 0; j < 8; ++j) { v[j] = xr[64 * j]; s += dot4(v[j]); }
    s = wave_sum(s);
    GAS u32x2* o = (GAS u32x2*)(XB + (size_t)row * DM) + lane;
#pragma unroll
    for (int j = 0; j < 8; ++j) { u32x2 w; w.x = cvt_pk_bf16(v[j][0], v[j][1]); w.y = cvt_pk_bf16(v[j][2], v[j][3]); o[64 * j] = w; }
    if (lane == 0) RS0[row] = rsqrtf(s * (1.f / DM) + EPS);
    const f32x4 pv = *((const GAS f32x4*)(p + (size_t)row * PLE) + lane);
    u32x2 w; w.x = cvt_pk_bf16(pv[0], pv[1]); w.y = cvt_pk_bf16(pv[2], pv[3]);
    *((GAS u32x2*)(PB + (size_t)row * PLE) + lane) = w;
}

__device__ __forceinline__ void p0_prologue(Frame& F, const Args& a) {
    unsigned char* ws = F.ws; const int lane = lane_id(), tid = F.wave * 64 + lane;
    const float* w_in = a.in[4]; const float* g_mix = a.in[3]; const float* w_o = a.in[15]; const float* g_ffn = a.in[16];
    const float* w1 = a.in[21]; const float* w3 = a.in[22]; const float* w2 = a.in[23]; const float* g_ple = a.in[24]; const float* w_gate = a.in[25]; const float* w_proj = a.in[26];
    if (blockIdx.x == 0 && tid < 256) {
        LAS float* red = (LAS float*)(F.lds + LCTL_OFF + 128);
        const float* rel_bias = a.in[2]; const int t = tid;
        float gq = 0.f, gk = 0.f, rb = fabsf(rel_bias[t]);
        if (t < 64) { gq = fabsf(a.in[5][t]); gk = fabsf(a.in[6][t]); }
        for (int o = 32; o > 0; o >>= 1) { gq = fmaxf(gq, __shfl_xor(gq, o)); gk = fmaxf(gk, __shfl_xor(gk, o)); rb = fmaxf(rb, __shfl_xor(rb, o)); }
        if ((t & 63) == 0) { red[t >> 6] = rb; if (t == 0) { red[8] = gq; red[9] = gk; } }
    }
    __syncthreads();
    if (blockIdx.x == 0 && tid < 256) {
        LAS float* red = (LAS float*)(F.lds + LCTL_OFF + 128);
        const float* rel_bias = a.in[2]; const int t = tid;
        const float rbm = fmaxf(fmaxf(red[0], red[1]), fmaxf(red[2], red[3]));
        const float m0 = 8.f * red[8] * red[9] + rbm;
        float* BT = (float*)(ws + WS_BT);
        for (int i = t; i < NH * BT_N; i += 256) { const int h = i / BT_N, idx = i % BT_N, rel = idx - 255; BT[i] = (rel_bias[rel_bucket(rel) * NH + h] - m0) * LOG2E; }
        if (t < 64) {
            float x1 = a.in[7][t] * a.in[8][t], x2 = a.in[9][t] * a.in[10][t];
            for (int o = 32; o > 0; o >>= 1) { x1 += __shfl_xor(x1, o); x2 += __shfl_xor(x2, o); }
            if (t == 0) ((float*)(ws + WS_LAM))[0] = expf(x1) - expf(x2) + LAM_INIT;
        }
    }
    __syncthreads();
    const int gw = F.vcu * NWAVES + F.wave, NGW = F.G * NWAVES;
    for (int m = gw; m < M; m += NGW) prep_row(a.in[0], a.in[1], (bf16_t*)(ws + WS_A), (float*)(ws + WS_RS0), (bf16_t*)(ws + WS_PB), m, lane);
    { const float* w_group = a.in[17]; const float* w_expert = a.in[19]; bf16_t* WR = (bf16_t*)(ws + WS_WR);
      for (int i = (F.vcu * NWAVES + F.wave) * 64 + lane; i < 256 * (DM / 8); i += F.G * NTHR) { const int pr = i / (DM / 8), k8 = (i % (DM / 8)) * 8;
          float v[8];
#pragma unroll
          for (int q = 0; q < 8; ++q) { const int k = k8 + q; v[q] = pr < 4 ? g_ffn[k] * w_group[k * 4 + pr] : pr < 36 ? g_ffn[k] * w_expert[k * 32 + pr - 4] : 0.f; }
          u32x4 o; o.x = cvt_pk_bf16(v[0], v[1]); o.y = cvt_pk_bf16(v[2], v[3]); o.z = cvt_pk_bf16(v[4], v[5]); o.w = cvt_pk_bf16(v[6], v[7]);
          *(u32x4*)(WR + (size_t)pr * DM + k8) = o; } }
    LAS float* scr = (LAS float*)(F.lds + F.wave * 16640);
    constexpr int I_IN = 32 * 96, I_O = 32 * 32, I_G = 32 * 32, I_P = 4 * 32, I_UP = 32 * 512, I_DN = 32 * 256;
    constexpr int NITEMS = I_IN + I_O + I_G + I_P + I_UP + I_DN;
    for (int it = gw; it < NITEMS; it += NGW) {
        int r = it;
        if (r < I_IN) { const int kb = r / 96, cb = r % 96, c0 = cb * 64; tr_item(w_in, 6144, g_mix, kb * 64, c0, (bf16_t*)(ws + WS_WIN), DM, map_in(c0), map_in(c0 + 32), scr, lane); continue; } r -= I_IN;
        if (r < I_O) { const int kb = r / 32, c0 = (r % 32) * 64; tr_item(w_o, DM, nullptr, kb * 64, c0, (bf16_t*)(ws + WS_WO), DM, c0, c0 + 32, scr, lane); continue; } r -= I_O;
        if (r < I_G) { const int kb = r / 32, c0 = (r % 32) * 64; tr_item8(w_gate, DM, g_ple, kb * 64, c0, ws + WS_WG, DM, c0, c0 + 32, scr, lane); continue; } r -= I_G;
        if (r < I_P) { const int kb = r / 32, c0 = (r % 32) * 64; tr_item(w_proj, DM, nullptr, kb * 64, c0, (bf16_t*)(ws + WS_WP), PLE, c0, c0 + 32, scr, lane); continue; } r -= I_P;
        if (r < I_UP) { const int e = r / 512, q = r % 512, which = q / 256, q2 = q % 256, kb = q2 / 8, c0 = (q2 % 8) * 64;
            const float* src = (which ? w3 : w1) + (size_t)e * DM * DFF;
            const int d0 = (c0 >> 7) * 256 + ((c0 >> 5) & 3) * 32 + which * 128, d1 = ((c0 + 32) >> 7) * 256 + (((c0 + 32) >> 5) & 3) * 32 + which * 128;
            tr_item8(src, DFF, g_ffn, kb * 64, c0, ws + WS_WUP + (size_t)e * 1024 * DM, DM, d0, d1, scr, lane); continue; } r -= I_UP;
        { const int e = r / 256, q = r % 256, kb = q / 32, c0 = (q % 32) * 64;
            tr_item8(w2 + (size_t)e * DFF * DM, DM, nullptr, kb * 64, c0, ws + WS_WDN + (size_t)e * DM * DFF, DFF, c0, c0 + 32, scr, lane); }
    }
}


namespace att {
typedef short v4i16_t __attribute__((ext_vector_type(4)));
constexpr int SLOT = 32768, STG_STRIDE = 132, STG_BYTES = 32 * STG_STRIDE * 4;
static_assert(4 * SLOT <= RING_BYTES && 8 * STG_BYTES <= LCTL_OFF, "attention LDS");
__device__ __forceinline__ void glds16(const void* gsrc, unsigned lds_dst) { unsigned keep;
    asm volatile("s_mov_b32 %0, m0\n\ts_mov_b32 m0, %2\n\ts_nop 0\n\tglobal_load_lds_dwordx4 %1, off\n\ts_mov_b32 m0, %0" : "=&s"(keep) : "v"(gsrc), "s"(lds_dst) : "memory"); }
__device__ __forceinline__ v4i16_t vtr(const LAS unsigned char* p) { return __builtin_amdgcn_ds_read_tr16_b64_v4i16((LAS v4i16_t*)p); }
__device__ __forceinline__ int crow(int r, int hi) { return (r & 3) + 8 * (r >> 2) + 4 * hi; }

__device__ __forceinline__ void attn_unit(int b, int h, int qb, const bf16_t* Q, const bf16_t* K, const bf16_t* V, bf16_t* AO, const float* g_subln, float lam, LAS unsigned char* lds, int wid) {
    const int lane = lane_id(), r32 = lane & 31, hi = lane >> 5;
    const int pair = wid >> 1, comp = wid & 1;
    const long rowbase = (long)b * SEQ; const int q0 = qb * 128, myrow0 = q0 + pair * 32;
    const int cw = myrow0 >> 6;
    const int NT = (q0 >> 6) + 2;
    const LAS float* bt = (const LAS float*)(lds + LBT_OFF);
    bf16x8 qr[4];
#pragma unroll
    for (int d0 = 0; d0 < 4; ++d0) qr[d0] = *(const bf16x8*)(Q + (size_t)(rowbase + myrow0 + r32) * 1024 + h * 128 + comp * 64 + d0 * 16 + hi * 8);
    asm volatile("" :: "v"(qr[0]), "v"(qr[1]), "v"(qr[2]), "v"(qr[3]));
    const bf16_t* ksrc = K + (size_t)(rowbase + lane) * 1024 + h * 128 + wid * 8;
    const bf16_t* vsrc = V + (size_t)(rowbase + 16 * (wid & 3) + (lane >> 2)) * 1024 + h * 128 + (wid >> 2) * 32 + (lane & 3) * 8;
    const unsigned lds0 = (unsigned)(size_t)lds;
    const unsigned kdst = lds0 + wid * 1024, vdst = lds0 + 16384 + (wid >> 2) * 4096 + (wid & 3) * 1024;
#define ATT_DMA(t, sl) do { const size_t go_ = (size_t)(t) * 65536; const unsigned so_ = (unsigned)(sl); \
        glds16(ksrc + go_, (unsigned)__builtin_amdgcn_readfirstlane(kdst + so_)); glds16(ksrc + go_ + 64, (unsigned)__builtin_amdgcn_readfirstlane(kdst + so_ + 8192)); \
        glds16(vsrc + go_, (unsigned)__builtin_amdgcn_readfirstlane(vdst + so_)); glds16(vsrc + go_ + 64, (unsigned)__builtin_amdgcn_readfirstlane(vdst + so_ + 8192)); } while (0)
    f32x16 o[4];
#pragma unroll
    for (int d = 0; d < 4; ++d)
#pragma unroll
        for (int r = 0; r < 16; ++r) o[d][r] = 0.f;
    float l = 0.f;
    ATT_DMA(0, 0); ATT_DMA(1, SLOT);
    int sl_cur = 0, sl_prev = 3 * SLOT, sl_nn = 2 * SLOT;
    const int kofs = comp * 8192 + hi * 1024 + r32 * 16;
    const int vofs = 16384 + ((lane >> 4) & 1) * 32 + (lane & 3) * 8 + (4 * hi + ((lane & 15) >> 2)) * 64;
    const bool grpY = wid >= 4;
    u32x4 pw[4];
#define ATT_QKEXP(t, slot) do { const LAS unsigned char* sb = lds + (slot); f32x16 p0, p1; \
        if ((t) >= cw - 2) { const int base = 64 * (t) + 4 * hi - (myrow0 + r32) + 255; \
            _Pragma("unroll") for (int r = 0; r < 16; ++r) { p0[r] = bt[base + (r & 3) + 8 * (r >> 2)]; p1[r] = bt[base + 32 + (r & 3) + 8 * (r >> 2)]; } } \
        else { const float bf = bt[0]; _Pragma("unroll") for (int r = 0; r < 16; ++r) { p0[r] = bf; p1[r] = bf; } } \
        _Pragma("unroll") for (int d0 = 0; d0 < 4; ++d0) { \
            const bf16x8 k0 = *(const LAS bf16x8*)(sb + kofs + d0 * 2048), k1 = *(const LAS bf16x8*)(sb + kofs + d0 * 2048 + 512); \
            p0 = __builtin_amdgcn_mfma_f32_32x32x16_bf16(k0, qr[d0], p0, 0, 0, 0); p1 = __builtin_amdgcn_mfma_f32_32x32x16_bf16(k1, qr[d0], p1, 0, 0, 0); } \
        float sacc = 0.f; \
        _Pragma("unroll") for (int r = 0; r < 16; ++r) { p0[r] = __builtin_amdgcn_exp2f(p0[r]); p1[r] = __builtin_amdgcn_exp2f(p1[r]); sacc += p0[r] + p1[r]; } \
        l += sacc; \
        _Pragma("unroll") for (int i = 0; i < 4; ++i) { pw[0][i] = cvt_pk_bf16(p0[2 * i], p0[2 * i + 1]); pw[1][i] = cvt_pk_bf16(p0[8 + 2 * i], p0[9 + 2 * i]); \
                                                        pw[2][i] = cvt_pk_bf16(p1[2 * i], p1[2 * i + 1]); pw[3][i] = cvt_pk_bf16(p1[8 + 2 * i], p1[9 + 2 * i]); } } while (0)
#define ATT_PV(slot) do { const LAS unsigned char* sb = lds + (slot); \
        _Pragma("unroll") for (int db = 0; db < 4; ++db) _Pragma("unroll") for (int ks = 0; ks < 4; ++ks) { \
            const v4i16_t lo = vtr(sb + vofs + db * 4096 + ks * 1024), hh = vtr(sb + vofs + db * 4096 + ks * 1024 + 512); \
            const bf16x8 vf = (bf16x8){lo[0], lo[1], lo[2], lo[3], hh[0], hh[1], hh[2], hh[3]}; \
            o[db] = __builtin_amdgcn_mfma_f32_32x32x16_bf16(__builtin_bit_cast(bf16x8, pw[ks]), vf, o[db], 0, 0, 0); } } while (0)
#define ATT_WAIT_A(s_) do { if ((s_) + 1 < NT) asm volatile("s_waitcnt vmcnt(4) lgkmcnt(0)\n\ts_barrier" ::: "memory"); else asm volatile("s_waitcnt vmcnt(0) lgkmcnt(0)\n\ts_barrier" ::: "memory"); } while (0)
#define ATT_BAR_B() asm volatile("s_waitcnt lgkmcnt(0)\n\ts_barrier" ::: "memory")
    if (!grpY) {
        for (int s = 0; s <= NT; ++s) {
            ATT_WAIT_A(s);
            if (s < NT && s <= cw) ATT_QKEXP(s, sl_cur);
            ATT_BAR_B();
            if (s + 2 < NT) ATT_DMA(s + 2, sl_nn);
            if (s < NT && s <= cw) ATT_PV(sl_cur);
            sl_prev = sl_cur; sl_cur = (sl_cur == 3 * SLOT) ? 0 : sl_cur + SLOT; sl_nn = (sl_nn == 3 * SLOT) ? 0 : sl_nn + SLOT;
        }
    } else {
        for (int s = 0; s <= NT; ++s) {
            ATT_WAIT_A(s);
            if (s >= 1 && s - 1 <= cw) ATT_PV(sl_prev);
            ATT_BAR_B();
            if (s + 2 < NT) ATT_DMA(s + 2, sl_nn);
            if (s < NT && s <= cw) ATT_QKEXP(s, sl_cur);
            sl_prev = sl_cur; sl_cur = (sl_cur == 3 * SLOT) ? 0 : sl_cur + SLOT; sl_nn = (sl_nn == 3 * SLOT) ? 0 : sl_nn + SLOT;
        }
    }
#undef ATT_WAIT_A
#undef ATT_BAR_B
#undef ATT_QKEXP
#undef ATT_PV
#undef ATT_DMA
    l += __shfl_xor(l, 32);
    asm volatile("s_waitcnt vmcnt(0) lgkmcnt(0)\n\ts_barrier" ::: "memory");
    {   LAS float* st = (LAS float*)(lds + wid * STG_BYTES);
#pragma unroll
        for (int db = 0; db < 4; ++db)
#pragma unroll
            for (int r = 0; r < 16; ++r) st[crow(r, hi) * STG_STRIDE + db * 32 + r32] = o[db][r];
        if (hi == 0) ((LAS float*)(lds + LLS_OFF))[wid * 32 + r32] = l;
    }
    asm volatile("s_waitcnt lgkmcnt(0)\n\ts_barrier" ::: "memory");
    {   const int rsel = comp * 16 + (lane >> 2), quarter = lane & 3;
        const LAS float* s1 = (const LAS float*)(lds + (pair * 2) * STG_BYTES) + rsel * STG_STRIDE + quarter * 32;
        const LAS float* s2 = (const LAS float*)(lds + (pair * 2 + 1) * STG_BYTES) + rsel * STG_STRIDE + quarter * 32;
        const LAS float* ls = (const LAS float*)(lds + LLS_OFF);
        const float i1 = 1.f / ls[(pair * 2) * 32 + rsel], i2 = lam / ls[(pair * 2 + 1) * 32 + rsel];
        f32x4 v[8]; float ss = 0.f;
#pragma unroll
        for (int c = 0; c < 8; ++c) { v[c] = *(const LAS f32x4*)(s1 + c * 4) * i1 - *(const LAS f32x4*)(s2 + c * 4) * i2; ss += dot4(v[c]); }
        ss += __shfl_xor(ss, 1); ss += __shfl_xor(ss, 2);
        const float rstd = rsqrtf(ss * (1.f / 128.f) + EPS) * (1.f - LAM_INIT);
        bf16_t* op = AO + (size_t)(rowbase + myrow0 + rsel - comp * 16 + comp * 16) * DM + h * 128 + quarter * 32;
#pragma unroll
        for (int c = 0; c < 4; ++c) { const f32x4 g0 = *(const f32x4*)(g_subln + quarter * 32 + c * 8), g1 = *(const f32x4*)(g_subln + quarter * 32 + c * 8 + 4);
            *(u32x4*)(op + c * 8) = pack8(v[2 * c] * rstd * g0, v[2 * c + 1] * rstd * g1); }
    }
    asm volatile("s_waitcnt lgkmcnt(0)\n\ts_barrier" ::: "memory");
}
}

__device__ __forceinline__ void p2_conv(Frame& F, const Args& a) {
    unsigned char* ws = F.ws; const int lane = lane_id(), c0 = lane * 16;
    const bf16_t* CU = (const bf16_t*)(ws + WS_D); const bf16_t* GB = (const bf16_t*)(ws + WS_C) + (size_t)M * 1024; bf16_t* AO = (bf16_t*)(ws + WS_A);
    const float* conv_w = a.in[12]; const float* conv_b = a.in[13]; const float* g_conv = a.in[14];
    f32x4 w0[4], w1[4], w2[4], cb[4], gc[4];
#pragma unroll
    for (int i = 0; i < 4; ++i) { w0[i] = *(const f32x4*)(conv_w + c0 + i * 4); w1[i] = *(const f32x4*)(conv_w + 1024 + c0 + i * 4); w2[i] = *(const f32x4*)(conv_w + 2048 + c0 + i * 4);
        cb[i] = *(const f32x4*)(conv_b + c0 + i * 4); gc[i] = *(const f32x4*)(g_conv + c0 + i * 4); }
    const int gw = F.vcu * NWAVES + F.wave, NGW = F.G * NWAVES;
    for (int row = gw; row < M; row += NGW) {
        const int s = row & (SEQ - 1);
        const u32x4 zz = (u32x4){0u, 0u, 0u, 0u};
        u32x4 x0[2], x1[2], x2[2], gb[2];
#pragma unroll
        for (int i = 0; i < 2; ++i) { x0[i] = *(const u32x4*)(CU + (size_t)row * 1024 + c0 + i * 8); gb[i] = *(const u32x4*)(GB + (size_t)row * 1024 + c0 + i * 8);
            x1[i] = s >= 1 ? *(const u32x4*)(CU + (size_t)(row - 1) * 1024 + c0 + i * 8) : zz; x2[i] = s >= 2 ? *(const u32x4*)(CU + (size_t)(row - 2) * 1024 + c0 + i * 8) : zz; }
        f32x4 z[4]; float ss = 0.f;
#pragma unroll
        for (int i = 0; i < 4; ++i) { const int q = i >> 1;
            const f32x4 a0 = (i & 1) ? g8::bf4lo(x0[q].z, x0[q].w) : g8::bf4lo(x0[q].x, x0[q].y), a1 = (i & 1) ? g8::bf4lo(x1[q].z, x1[q].w) : g8::bf4lo(x1[q].x, x1[q].y);
            const f32x4 a2 = (i & 1) ? g8::bf4lo(x2[q].z, x2[q].w) : g8::bf4lo(x2[q].x, x2[q].y), g = (i & 1) ? g8::bf4lo(gb[q].z, gb[q].w) : g8::bf4lo(gb[q].x, gb[q].y);
            z[i] = g * (w2[i] * a0 + w1[i] * a1 + w0[i] * a2 + cb[i]); ss += dot4(z[i]); }
        ss += __shfl_xor(ss, 1); ss += __shfl_xor(ss, 2); ss += __shfl_xor(ss, 4);
        const float r = rsqrtf(ss * (1.f / 128.f) + EPS);
        *(u32x4*)(AO + (size_t)row * DM + 1024 + c0) = pack8(z[0] * r * gc[0], z[1] * r * gc[1]);
        *(u32x4*)(AO + (size_t)row * DM + 1024 + c0 + 8) = pack8(z[2] * r * gc[2], z[3] * r * gc[3]);
    }
}
__device__ __forceinline__ void p2_attention(Frame& F, const Args& a) {
    unsigned char* ws = F.ws; const int tid = F.wave * 64 + lane_id();
    const bf16_t* Qb = (const bf16_t*)(ws + WS_B); const bf16_t* Kb = Qb + (size_t)M * 1024; const bf16_t* Vb = (const bf16_t*)(ws + WS_C); bf16_t* AO = (bf16_t*)(ws + WS_A);
    const int bh = F.vcu >> 3, j = F.vcu & 7, b = bh >> 3, h = bh & 7;
    if (bh >= BATCH * NH) return;
    const float lam = ((const float*)(ws + WS_LAM))[0];
    { LAS float* bt = (LAS float*)(F.lds + LBT_OFF); const float* BT = (const float*)(ws + WS_BT) + h * BT_N; if (tid < BT_N) bt[tid] = BT[tid]; }
    asm volatile("s_waitcnt vmcnt(0) lgkmcnt(0)\n\ts_barrier" ::: "memory");
    for (int i = 0; i < 4; ++i) { const int qb = (i == 0) ? 31 - j : (i == 1) ? 16 + j : (i == 2) ? 15 - j : j;
        att::attn_unit(b, h, qb, Qb, Kb, Vb, AO, a.in[11], lam, F.lds, F.wave); }
}

__device__ __forceinline__ void p5_route(Frame& F, const Args& a) {
    unsigned char* ws = F.ws; const int lane = lane_id();
    const float* PART = (const float*)(ws + WS_PART); const float* SSQ = (const float*)(ws + WS_SSQ);
    const float* b_group = a.in[18]; const float* b_expert = a.in[20];
    float* RS1 = (float*)(ws + WS_RS1); int* TE = (int*)(ws + WS_TE); float* TW = (float*)(ws + WS_TW); unsigned* CNT = (unsigned*)(ws + WS_CNT); int* LIST = (int*)(ws + WS_LIST);
    for (int row = (F.vcu * NWAVES + F.wave) * 64 + lane; row < M; row += F.G * NTHR) {
        float ss = 0.f;
#pragma unroll
        for (int i = 0; i < 8; ++i) { const f32x4 v = *(const f32x4*)(SSQ + (size_t)row * 32 + i * 4); ss += (v[0] + v[1]) + (v[2] + v[3]); }
        const float rs = rsqrtf(ss * (1.f / DM) + EPS);
        f32x4 gl = (f32x4){0.f, 0.f, 0.f, 0.f};
#pragma unroll
        for (int ks = 0; ks < 4; ++ks) gl = gl + *(const f32x4*)(PART + ((size_t)ks * M + row) * 64);
        int gi = 0; float gm = -1e30f; float glv[4];
#pragma unroll
        for (int g = 0; g < 4; ++g) { glv[g] = gl[g] * rs + b_group[g]; if (glv[g] > gm) { gm = glv[g]; gi = g; } }
        float den = 0.f;
#pragma unroll
        for (int g = 0; g < 4; ++g) den += expf(glv[g] - gm);
        const float pg = 1.f / den;
        f32x4 e0 = (f32x4){0.f, 0.f, 0.f, 0.f}, e1 = e0;
#pragma unroll
        for (int ks = 0; ks < 4; ++ks) { const float* pp = PART + ((size_t)ks * M + row) * 64 + 4 + gi * 8; e0 = e0 + *(const f32x4*)pp; e1 = e1 + *(const f32x4*)(pp + 4); }
        float v0 = -1e30f, v1 = -1e30f; int i0 = 0, i1 = 0;
#pragma unroll
        for (int e = 0; e < 8; ++e) { const float v = (e < 4 ? e0[e & 3] : e1[e & 3]) * rs + b_expert[gi * 8 + e];
            if (v > v0) { v1 = v0; i1 = i0; v0 = v; i0 = e; } else if (v > v1) { v1 = v; i1 = e; } }
        const float ex = expf(v1 - v0), w0 = pg / (1.f + ex), w1 = pg * ex / (1.f + ex);
        const int x0 = gi * 8 + i0, x1 = gi * 8 + i1;
        RS1[row] = rs; TE[row * 2] = x0; TE[row * 2 + 1] = x1; TW[row * 2] = w0; TW[row * 2 + 1] = w1;
        float* LRS = (float*)(ws + WS_LRS); float* LTW = (float*)(ws + WS_LTW);
        const unsigned p0 = atomicAdd(&CNT[x0], 1u); LIST[(size_t)x0 * M + p0] = row * 2; LRS[(size_t)x0 * M + p0] = rs; LTW[(size_t)x0 * M + p0] = w0;
        const unsigned p1 = atomicAdd(&CNT[x1], 1u); LIST[(size_t)x1 * M + p1] = row * 2 + 1; LRS[(size_t)x1 * M + p1] = rs; LTW[(size_t)x1 * M + p1] = w1;
    }
}
__device__ __forceinline__ g8::MoeTab moe_tables(Frame& F) {
    LAS int* tab = (LAS int*)(F.lds + LTAB_OFF); const int tid = F.wave * 64 + lane_id();
    const unsigned* CNT = (const unsigned*)(F.ws + WS_CNT);
    __syncthreads();
    if (tid < 32) tab[384 + tid] = (int)__hip_atomic_load(CNT + tid, __ATOMIC_RELAXED, __HIP_MEMORY_SCOPE_AGENT);
    __syncthreads();
    if (tid == 0) { int nt = 0;
        for (int e = 0; e < NE; ++e) { const int n = tab[384 + e]; for (int r = 0; r < n && nt < 192; r += 256) { tab[nt] = e; tab[192 + nt] = r; ++nt; } }
        tab[416] = nt; }
    __syncthreads();
    g8::MoeTab T; T.texp = tab; T.trow0 = tab + 192; T.tcnt = tab + 384; T.ntile = tab[416];
    return T;
}
__device__ __forceinline__ void p7_combine(Frame& F) {
    unsigned char* ws = F.ws;
    bf16_t* H = (bf16_t*)(ws + WS_B); const bf16_t* Y0 = (const bf16_t*)(ws + WS_A); const bf16_t* Y1 = (const bf16_t*)(ws + WS_D); float* RS2 = (float*)(ws + WS_RS2); unsigned char* H28 = ws + WS_H28;
    const int gw = F.vcu * NWAVES + F.wave, NGW = F.G * NWAVES, lane = lane_id();
    for (int row = gw; row < M; row += NGW) {
        float ss = 0.f;
#pragma unroll
        for (int j = 0; j < 4; ++j) { const size_t o = (size_t)row * DM + j * 512 + lane * 8;
            const u32x4 hv = *(const u32x4*)(H + o); const u32x2 y0 = *(const u32x2*)((const unsigned char*)Y0 + o), y1 = *(const u32x2*)((const unsigned char*)Y1 + o);
            const f32x4 a = g8::bf4lo(hv.x, hv.y) + (unpack4_fp8(y0.x) + unpack4_fp8(y1.x)) * (1.f / F8_Y), b = g8::bf4lo(hv.z, hv.w) + (unpack4_fp8(y0.y) + unpack4_fp8(y1.y)) * (1.f / F8_Y);
            ss += dot4(a) + dot4(b);
            *(u32x4*)(H + o) = pack8(a, b);
            u32x2 w8; w8.x = pack4_fp8(a, F8_H); w8.y = pack4_fp8(b, F8_H); *(u32x2*)(H28 + o) = w8; }
        ss = wave_sum(ss);
        if (lane == 0) RS2[row] = rsqrtf(ss * (1.f / DM) + EPS);
    }
}

__global__ void __launch_bounds__(NTHR, 2) mk_fwd(Args args) {
    extern __shared__ __attribute__((aligned(16))) unsigned char lds_raw[];
    Frame F;
    F.lds = (LAS unsigned char*)lds_raw; F.MISC = (volatile LAS unsigned*)(F.lds + LCTL_OFF); F.ws = args.ws;
    F.wave = __builtin_amdgcn_readfirstlane(threadIdx.x >> 6);
    F.G = gridDim.x; { const int bx = blockIdx.x; F.vcu = (F.G % 8 == 0) ? (bx % 8) * (F.G / 8) + bx / 8 : bx; }
    unsigned char* ws = args.ws;
    if (threadIdx.x < 32) F.MISC[threadIdx.x] = 0u;
    __syncthreads();
    XcdBarrier bar = xcd_barrier_post((unsigned*)(ws + WS_BAR) + args.li * XCD_BAR_WORDS, F.MISC + 8);
    const int lo = args.ph_lo, hi = args.ph_hi;
#define IN(k) (lo <= (k) && (k) < hi)
#define SEAM(k) do { if (IN(k) && IN((k) + 1)) xcd_barrier(bar); } while (0)

    bf16_t* XB = (bf16_t*)(ws + WS_A); bf16_t* AO = XB;
    bf16_t* Qb = (bf16_t*)(ws + WS_B); bf16_t* Kb = Qb + (size_t)M * 1024; bf16_t* H = Qb;
    bf16_t* Vb = (bf16_t*)(ws + WS_C); bf16_t* GB = Vb + (size_t)M * 1024;
    bf16_t* CU = (bf16_t*)(ws + WS_D);
    bf16_t* PP = (bf16_t*)(ws + WS_E); bf16_t* PB = (bf16_t*)(ws + WS_PB);
    float* RS0 = (float*)(ws + WS_RS0); float* RS2 = (float*)(ws + WS_RS2);

    if (IN(0)) { p0_prologue(F, args); } SEAM(0);

    if (IN(1)) {
        g8::DenseSched S; S.init(XB, DM * 2, ws + WS_WIN, DM * 2, M, 6144, F.G, (int)blockIdx.x);
        g8::EpiProj E{RS0, args.in[5], args.in[6], Qb, Kb, Vb, GB, CU};
        g8::gemm_phase<g8::EpiProj, g8::DenseSched>(F.lds, F.wave, DM, S, E);
    } SEAM(1);

    if (IN(2)) { p2_conv(F, args); p2_attention(F, args); } SEAM(2);

    if (IN(3)) {
        g8::DenseSched S; S.init(AO, DM * 2, ws + WS_WO, DM * 2, M, DM, F.G, (int)blockIdx.x);
        g8::EpiRes E{args.in[0], H, (float*)(ws + WS_SSQ), ws + WS_H8};
        g8::gemm_phase<g8::EpiRes, g8::DenseSched>(F.lds, F.wave, DM, S, E);
    } SEAM(3);

    if (IN(4)) {
        g8::KSplitSched S{(const char*)H, (const char*)(ws + WS_WR), F.G, (int)blockIdx.x};
        g8::EpiRouter E{(float*)(ws + WS_PART)};
        g8::gemm_phase<g8::EpiRouter, g8::KSplitSched>(F.lds, F.wave, 512, S, E);
    } SEAM(4);

    if (IN(5)) { p5_route(F, args); } SEAM(5);

    if (IN(6)) {
        const g8::MoeTab T = moe_tables(F);
        g8::UpSched S{(const char*)(ws + WS_H8), (const char*)(ws + WS_WUP), (const int*)(ws + WS_LIST), T, F.G, F.vcu};
        g8::EpiUp E{(const float*)(ws + WS_LRS), Vb  , T};
        g8::gemm_phase<g8::EpiUp, g8::UpSched, true>(F.lds, F.wave, DM, S, E, E8_W, E8_H);
    } SEAM(6);

    if (IN(7)) {
        const g8::MoeTab T = moe_tables(F);
        g8::DnSched S{(const char*)Vb, (const char*)(ws + WS_WDN), T, F.G, F.vcu};
        g8::EpiDn E{(const int*)(ws + WS_LIST), (const float*)(ws + WS_LTW), XB  , CU  , T};
        int kdff = DFF; asm volatile("" : "+s"(kdff));
        g8::gemm_phase<g8::EpiDn, g8::DnSched, true>(F.lds, F.wave, kdff, S, E, E8_W, E8_HID);
    } SEAM(7);

    if (IN(8)) { p7_combine(F); } SEAM(8);

    if (IN(9)) {
        { g8::DenseSched S; S.init(PB, PLE * 2, ws + WS_WP, PLE * 2, M, DM, F.G, (int)blockIdx.x);
          g8::EpiBf16 E{PP, DM};
          int kple = PLE; asm volatile("" : "+s"(kple));
          g8::gemm_phase<g8::EpiBf16, g8::DenseSched>(F.lds, F.wave, kple, S, E);
          asm volatile("s_waitcnt vmcnt(0)" ::: "memory"); __syncthreads(); }
        g8::DenseSched S; S.init(ws + WS_H28, DM, ws + WS_WG, DM, M, DM, F.G, (int)blockIdx.x);
        g8::EpiFinal E{H, PP, RS2, args.out};
        g8::gemm_phase<g8::EpiFinal, g8::DenseSched, true>(F.lds, F.wave, DM, S, E, E8_W, E8_H);
    }
#undef IN
#undef SEAM
}


static int mk_grid = 0;
static void launch_mk(Args a, int lo, int hi, int li, hipStream_t stream) {
    a.ph_lo = lo; a.ph_hi = hi; a.li = li; a.pad = 0;
    hipLaunchKernelGGL(mk_fwd, dim3(mk_grid), dim3(NTHR), LDS_BYTES, stream, a);
}

extern "C" void kernel_launch(void* const* d_in, const int* in_sizes, int n_in, void* d_out, int out_size, void* d_ws, size_t ws_size, hipStream_t stream) {
    if (n_in != 27 || ws_size < WS_END) { fprintf(stderr, "kernel_launch: unexpected n_in %d / ws %zu\n", n_in, ws_size); return; }
    if (mk_grid == 0) {
        int dev = 0, cus = 0;
        (void)hipGetDevice(&dev); (void)hipDeviceGetAttribute(&cus, hipDeviceAttributeMultiprocessorCount, dev);
        (void)hipFuncSetAttribute((const void*)mk_fwd, hipFuncAttributeMaxDynamicSharedMemorySize, LDS_BYTES);
        int per_cu = 0; (void)hipOccupancyMaxActiveBlocksPerMultiprocessor(&per_cu, (const void*)mk_fwd, NTHR, LDS_BYTES); (void)hipGetLastError();
        mk_grid = 256;
        if (cus != 256 || per_cu < 1) fprintf(stderr, "kernel_launch: note: %d CUs, occupancy query %d; built for 256 CUs x 1 workgroup\n", cus, per_cu);
    }
    float* out = (float*)d_out; unsigned char* ws = (unsigned char*)d_ws;
    (void)in_sizes; (void)out_size;
    (void)hipMemsetAsync(ws + WS_CTL, 0, 1 * MiB, stream);
    Args a{};
    for (int i = 0; i < 27; ++i) a.in[i] = (const float*)d_in[i];
    a.out = out; a.ws = ws;
    launch_mk(a, 0, 10, 0, stream);
#ifdef HOST_PROBE_N
    for (int r = 0; r < HOST_PROBE_N; ++r) launch_mk(a, HOST_PROBE_LO, HOST_PROBE_HI, 1 + r, stream);
#endif
}
```

```cpp
#include <hip/hip_runtime.h>
#include <cstdint>
#include <cstdio>

typedef unsigned short bf16_t;
typedef float f32x4 __attribute__((ext_vector_type(4)));

constexpr int BATCH = 4, SEQ = 4096, DM = 2048, M = BATCH * SEQ;
constexpr int NH = 8, DQK = 64, DV = 128, DATT = 1024, DCONV = 1024;
constexpr int NE = 32, NG = 4, EPG = 8, DFF = 512, PLE = 256;
constexpr float EPS = 1e-6f;
constexpr float LOG2E = 1.4426950408889634f;
constexpr float LAM_INIT = 0.2f;
constexpr int BT_N = 320;

constexpr size_t MiB = 1u << 20;
constexpr size_t WS_CTL = 0;
constexpr size_t WS_BT = 64 * 1024;
constexpr size_t WS_LAM = WS_BT + 16 * 1024;
constexpr size_t WS_CNT = 128 * 1024;
constexpr size_t WS_W = 1 * MiB;
constexpr size_t WS_A = 236 * MiB;
constexpr size_t WS_B = 300 * MiB;
constexpr size_t WS_C = 364 * MiB;
constexpr size_t WS_D = 428 * MiB;
constexpr size_t WS_E = 492 * MiB;
constexpr size_t WS_PB = 556 * MiB;
constexpr size_t WS_SM = 564 * MiB;
constexpr size_t WS_RS0 = WS_SM, WS_RS1 = WS_SM + 64 * 1024, WS_RS2 = WS_SM + 128 * 1024;
constexpr size_t WS_TE = WS_SM + 192 * 1024;
constexpr size_t WS_TW = WS_SM + 320 * 1024;
constexpr size_t WS_LIST = WS_SM + 1 * MiB;
constexpr size_t WS_END = 576 * MiB;

__device__ __forceinline__ float bf2f(bf16_t v) { return __uint_as_float((unsigned)v << 16); }
__device__ __forceinline__ bf16_t f2bf(float f) { unsigned u = __float_as_uint(f); return (bf16_t)((u + 0x7fffu + ((u >> 16) & 1u)) >> 16); }

__device__ __forceinline__ int rel_bucket(int rel) {
    int ret = rel > 0 ? 16 : 0; int n = rel < 0 ? -rel : rel;
    if (n < 8) return ret + n;
    int l = 31 - __clz(n * n) + 2; if (l > 15) l = 15;
    return ret + l;
}

__device__ __forceinline__ float block_sum(float v, float* red) {
    for (int o = 32; o > 0; o >>= 1) v += __shfl_xor(v, o);
    const int w = threadIdx.x >> 6, nw = blockDim.x >> 6;
    __syncthreads();
    if ((threadIdx.x & 63) == 0) red[w] = v;
    __syncthreads();
    float s = 0.f; for (int i = 0; i < nw; ++i) s += red[i];
    return s;
}


#define GAS __attribute__((address_space(1)))
#define LAS __attribute__((address_space(3)))
typedef short bf16x8 __attribute__((ext_vector_type(8)));
typedef unsigned u32x4 __attribute__((ext_vector_type(4)));
typedef unsigned u32x2 __attribute__((ext_vector_type(2)));
typedef float f32x16 __attribute__((ext_vector_type(16)));
typedef GAS unsigned gu32;
#define RLX_AGENT __ATOMIC_RELAXED, __HIP_MEMORY_SCOPE_AGENT

constexpr int NWAVES = 8, NTHR = 512;
constexpr int RING_BYTES = 131072;
constexpr int LCTL_OFF = 145408;
constexpr int LBT_OFF = LCTL_OFF + 128;
constexpr int LLS_OFF = LBT_OFF + 1280;
constexpr int LTAB_OFF = LCTL_OFF + 128;
constexpr int LDS_BYTES = 149504;
static_assert(LLS_OFF + 1024 <= LDS_BYTES && LTAB_OFF + (192 + 192 + 32) * 4 <= LDS_BYTES, "LDS map");

constexpr size_t WS_BAR = 256 * 1024;
constexpr size_t WS_WIN = WS_W;
constexpr size_t WS_WO = WS_WIN + 24 * MiB;
constexpr size_t WS_WG = WS_WO + 8 * MiB;
constexpr size_t WS_WP = WS_WG + 8 * MiB;
constexpr size_t WS_WUP = WS_WP + 1 * MiB;
constexpr size_t WS_WDN = WS_WUP + 128 * MiB;
constexpr size_t WS_WR = WS_WDN + 64 * MiB;
static_assert(WS_WR + 1 * MiB <= WS_A, "weight region");
constexpr size_t WS_LRS = WS_SM + 6 * MiB, WS_LTW = WS_SM + 8 * MiB;
constexpr size_t WS_SSQ = WS_SM + 4 * MiB;
constexpr size_t WS_H8 = WS_E + 32 * MiB;
constexpr size_t WS_H28 = WS_C + 32 * MiB;
constexpr size_t WS_PART = WS_E;

__device__ __forceinline__ int lane_id() { return (int)__builtin_amdgcn_mbcnt_hi(~0u, __builtin_amdgcn_mbcnt_lo(~0u, 0u)); }
__device__ __forceinline__ int lane_id_fresh() { unsigned z = 0u; asm volatile("" : "+v"(z)); return (int)__builtin_amdgcn_mbcnt_hi(~0u, __builtin_amdgcn_mbcnt_lo(~0u, z)); }
typedef float f32x2_t __attribute__((ext_vector_type(2))); typedef __bf16 bf16x2_t __attribute__((ext_vector_type(2)));
__device__ __forceinline__ unsigned cvt_pk_bf16(float lo, float hi) { const f32x2_t v = {lo, hi}; const bf16x2_t b = __builtin_convertvector(v, bf16x2_t); return __builtin_bit_cast(unsigned, b); }
typedef int v8i_t __attribute__((ext_vector_type(8)));
typedef int v4i_t __attribute__((ext_vector_type(4)));
__device__ __forceinline__ unsigned pack4_fp8(f32x4 v, float sc) {
    int w = 0;
    const float a = __builtin_amdgcn_fmed3f(v[0] * sc, -448.f, 448.f), b = __builtin_amdgcn_fmed3f(v[1] * sc, -448.f, 448.f);
    const float c = __builtin_amdgcn_fmed3f(v[2] * sc, -448.f, 448.f), d = __builtin_amdgcn_fmed3f(v[3] * sc, -448.f, 448.f);
    w = __builtin_amdgcn_cvt_pk_fp8_f32(a, b, w, false); w = __builtin_amdgcn_cvt_pk_fp8_f32(c, d, w, true);
    return (unsigned)w;
}
__device__ __forceinline__ f32x4 unpack4_fp8(unsigned w) { const int iw = (int)w;
    return (f32x4){__builtin_amdgcn_cvt_f32_fp8(iw, 0), __builtin_amdgcn_cvt_f32_fp8(iw, 1), __builtin_amdgcn_cvt_f32_fp8(iw, 2), __builtin_amdgcn_cvt_f32_fp8(iw, 3)}; }
constexpr float F8_W = 256.f, F8_H = 16.f, F8_HID = 8.f, F8_Y = 32.f;
constexpr int E8_W = 0x77777777, E8_H = 0x7b7b7b7b, E8_HID = 0x7c7c7c7c;
__device__ __forceinline__ float fast_sigmoid(float z) { return __builtin_amdgcn_rcpf(1.f + __builtin_amdgcn_exp2f(-LOG2E * z)); }

__device__ __forceinline__ u32x4 pack8(f32x4 a, f32x4 b) { u32x4 w; w.x = cvt_pk_bf16(a[0], a[1]); w.y = cvt_pk_bf16(a[2], a[3]); w.z = cvt_pk_bf16(b[0], b[1]); w.w = cvt_pk_bf16(b[2], b[3]); return w; }
__device__ __forceinline__ float dot4(f32x4 a) { return (a[0] * a[0] + a[1] * a[1]) + (a[2] * a[2] + a[3] * a[3]); }

#define XB_TMO      128
#define XB_XCNT(j)  (256  + 64 * (j))
#define XB_XSUB(j)  (1280 + 64 * (j))
#define XB_XGEN(j)  (2304 + 64 * (j))
#define XB_TOP      3328
#define XB_TOPGEN   3392
#define XCD_BAR_WORDS 3456
#define XB_SPIN_CAP (1u << 18)
__device__ __forceinline__ unsigned xb_ld(unsigned* p)              { return __hip_atomic_load(p, __ATOMIC_RELAXED, __HIP_MEMORY_SCOPE_AGENT); }
__device__ __forceinline__ unsigned xb_add(unsigned* p, unsigned v) { return __hip_atomic_fetch_add(p, v, __ATOMIC_RELAXED, __HIP_MEMORY_SCOPE_AGENT); }
__device__ __forceinline__ unsigned xb_xcc_id() { return (unsigned)__builtin_amdgcn_s_getreg((3 << 11) | 20) & 0xFu; }
#define XB_SPIN(cond, bar) do { unsigned _sp = 0; while (cond) { __builtin_amdgcn_s_sleep(1); \
    if ((++_sp & 255u) == 0u) { if (xb_ld(&(bar)[XB_TMO])) break; if (_sp > XB_SPIN_CAP) { atomicAdd(&(bar)[XB_TMO], 1u); break; } } } } while (0)
struct XcdBarrier { unsigned* bar; unsigned x; volatile LAS unsigned* st; };
__device__ __forceinline__ XcdBarrier xcd_barrier_post(unsigned* bar, volatile LAS unsigned* st) {
    XcdBarrier b; b.bar = bar; b.x = xb_xcc_id(); b.st = st;
    if (threadIdx.x == 0) (void)xb_add(&bar[XB_XCNT(b.x)], 1u);
    return b;
}
__device__ __forceinline__ void xcd_barrier_complete(unsigned* bar, unsigned x, unsigned& nloc, unsigned& nx) {
    const unsigned G = gridDim.x * gridDim.y * gridDim.z;
    unsigned sum, cnt, mine, sp = 0u;
    for (;;) {
        sum = 0u; cnt = 0u; mine = 0u;
#pragma unroll
        for (unsigned j = 0; j < 16; ++j) { const unsigned c = xb_ld(&bar[XB_XCNT(j)]); sum += c; cnt += (c > 0u) ? 1u : 0u; mine = (j == x) ? c : mine; }
        if (sum == G) break;
        __builtin_amdgcn_s_sleep(1);
        if ((++sp & 255u) == 0u) { if (xb_ld(&bar[XB_TMO])) break; if (sp > XB_SPIN_CAP) { atomicAdd(&bar[XB_TMO], 1u); break; } }
    }
    nloc = mine > 0u ? mine : 1u; nx = cnt > 0u ? cnt : 1u;
}
__device__ __forceinline__ void xcd_barrier(const XcdBarrier& b) {
    asm volatile("s_waitcnt vmcnt(0)" ::: "memory");
    __syncthreads();
    if (threadIdx.x == 0) {
        unsigned* bar = b.bar;
        __builtin_amdgcn_s_waitcnt(0);
        unsigned nloc = b.st[0], nx = b.st[1];
        if (nloc == 0u) { xcd_barrier_complete(bar, b.x, nloc, nx); b.st[0] = nloc; b.st[1] = nx; }
        const unsigned old = xb_add(&bar[XB_XSUB(b.x)], 1u);
        const unsigned gen = old / nloc;
        if (old + 1u == (gen + 1u) * nloc) {
            __builtin_amdgcn_fence(__ATOMIC_RELEASE, "agent");
            asm volatile("s_waitcnt vmcnt(0)" ::: "memory");
            const unsigned og = xb_add(&bar[XB_TOP], 1u);
            const unsigned tg = og / nx;
            if (og + 1u == (tg + 1u) * nx) xb_add(&bar[XB_TOPGEN], 1u);
            else XB_SPIN(xb_ld(&bar[XB_TOPGEN]) == tg, bar);
            __builtin_amdgcn_fence(__ATOMIC_ACQUIRE, "agent");
            xb_add(&bar[XB_XGEN(b.x)], 1u);
            asm volatile("s_waitcnt vmcnt(0)" ::: "memory");
        } else {
            XB_SPIN(xb_ld(&bar[XB_XGEN(b.x)]) == gen, bar);
            __builtin_amdgcn_fence(__ATOMIC_ACQUIRE, "agent");
            asm volatile("s_waitcnt vmcnt(0)" ::: "memory");
        }
    }
    __syncthreads();
}

namespace g8 {
constexpr int BM = 256, BK = 64, HALF = 128, HTB = HALF * BK * 2, STAGE_BYTES = 8 * HTB;
static_assert(STAGE_BYTES == RING_BYTES, "ring");
__host__ __device__ __forceinline__ int lds_byte(int r, int c) { const int st = (r >> 4) * 2 + (c >> 5), rr = r & 15, cc = c & 31, ob = rr * 64 + cc * 2; return st * 1024 + (ob ^ (((ob >> 9) & 1) << 5)); }
__host__ __device__ __forceinline__ void stage_rc(int b, int& R, int& C) { const int st = b / 1024, sb = b % 1024, swz = sb ^ (((sb >> 9) & 1) << 5); R = (st >> 1) * 16 + swz / 64; C = (st & 1) * 32 + (swz % 64) / 2; }
struct Unit { int pm, pn, e; };

struct DenseSched {
    static constexpr bool GATHER = false;
    const char* A; const char* Bt; int lda, ldb; int nM, nN, nwg, G, c;
    __device__ __forceinline__ void init(const void* A_, int lda_, const void* Bt_, int ldb_, int Mrows, int N, int G_, int c_) { A = (const char*)A_; Bt = (const char*)Bt_; lda = lda_; ldb = ldb_; nM = Mrows / BM; nN = N / BM; nwg = nM * nN; G = G_; c = c_; }
    __device__ __forceinline__ bool next(int i, Unit& u) const {
        const long L = (long)i * G + c; if (L >= nwg) return false;
        int wgid = (int)L; { const int q = nwg / 8, r = nwg % 8, xcd = wgid % 8, off = wgid / 8; wgid = (xcd < r ? xcd * (q + 1) : r * (q + 1) + (xcd - r) * q) + off; }
        const int nig = 8 * nN, gid = wgid / nig, fm = gid * 8, gsz = (nM - fm) < 8 ? (nM - fm) : 8;
        u.pm = fm + ((wgid % nig) % gsz); u.pn = (wgid % nig) / gsz; u.e = 0; return true;
    }
    __device__ __forceinline__ const char* a_base(const Unit& u) const { return A + (size_t)u.pm * BM * lda; }
    __device__ __forceinline__ const char* b_base(const Unit& u) const { return Bt + (size_t)u.pn * BM * ldb; }
    __device__ __forceinline__ unsigned a_off(const Unit&, int row, int C) const { return (unsigned)(row * lda + C * 2); }
    __device__ __forceinline__ unsigned b_off(int row, int C) const { return (unsigned)(row * ldb + C * 2); }
};

template <class Epi, class Sched, bool F8 = false>
__device__ __forceinline__ void gemm_phase(LAS unsigned char* lds, const int wid, const int K, const Sched& S, const Epi& E, const int sclW = 0, const int sclA = 0) {
    const int lane = lane_id(), tid = wid * 64 + lane, wr = wid >> 2, wc = wid & 3, fr = lane & 15, fq = lane >> 4;
    const int nt = F8 ? K / 128 : K / BK;
    int Rr[2], Cc[2];
#pragma unroll
    for (int i = 0; i < 2; ++i) stage_rc(tid * 16 + i * 8192, Rr[i], Cc[i]);
    unsigned voffB[2];
#pragma unroll
    for (int i = 0; i < 2; ++i) voffB[i] = S.b_off(Rr[i], Cc[i]);
    const size_t kstep = (size_t)(BK * 2);
    const size_t hstepB = (size_t)S.b_off(HALF, 0);
    const unsigned ldsw = (unsigned)wid * 1024u;
    const int aoff = lds_byte(wr * 64 + fr, fq * 8), boff = lds_byte(wc * 32 + fr, fq * 8);
#define G8_SA(b, h) (((b) * 2 + (h)) * HTB)
#define G8_SB(b, h) ((4 + (b) * 2 + (h)) * HTB)
#define G8_STAGE(bufoff, gbase, voff) do { _Pragma("unroll") for (int _i = 0; _i < 2; ++_i) { unsigned _o = (voff)[_i]; asm volatile("" : "+v"(_o));     \
        __builtin_amdgcn_global_load_lds((const unsigned*)((const char*)(gbase) + _o), (LAS unsigned*)(lds + (bufoff) + ldsw + _i * 8192), 16, 0, 0); } } while (0)
#define G8_LD32(p) __builtin_shufflevector(*(const LAS v4i_t*)(p), *(const LAS v4i_t*)((p) + 1024), 0, 1, 2, 3, 4, 5, 6, 7)
#define G8_LDA(dst, b, h) do { _Pragma("unroll") for (int m = 0; m < 4; ++m) dst[m] = G8_LD32(lds + G8_SA(b, h) + aoff + m * 2048); } while (0)
#define G8_LDB(dst, b, h) do { _Pragma("unroll") for (int n = 0; n < 2; ++n) dst[n] = G8_LD32(lds + G8_SB(b, h) + boff + n * 2048); } while (0)
#define G8_LO(x) __builtin_bit_cast(bf16x8, __builtin_shufflevector(x, x, 0, 1, 2, 3))
#define G8_HI(x) __builtin_bit_cast(bf16x8, __builtin_shufflevector(x, x, 4, 5, 6, 7))
#define G8_MMA(ai, bj, At, Bt) do { __builtin_amdgcn_s_setprio(1); _Pragma("unroll") for (int m = 0; m < 4; ++m) _Pragma("unroll") for (int n = 0; n < 2; ++n) { \
        if constexpr (F8) acc[ai][bj][m][n] = __builtin_amdgcn_mfma_scale_f32_16x16x128_f8f6f4(Bt[n], At[m], acc[ai][bj][m][n], 0, 0, 0, sclW, 0, sclA); \
        else { acc[ai][bj][m][n] = __builtin_amdgcn_mfma_f32_16x16x32_bf16(G8_LO(Bt[n]), G8_LO(At[m]), acc[ai][bj][m][n], 0, 0, 0); \
               acc[ai][bj][m][n] = __builtin_amdgcn_mfma_f32_16x16x32_bf16(G8_HI(Bt[n]), G8_HI(At[m]), acc[ai][bj][m][n], 0, 0, 0); } } \
        __builtin_amdgcn_s_setprio(0); } while (0)
#define G8_WAIT_V(n) asm volatile("s_waitcnt vmcnt(" #n ")" ::: "memory")
#define G8_WAIT_L(n) asm volatile("s_waitcnt lgkmcnt(" #n ")" ::: "memory")
#define G8_BAR __builtin_amdgcn_s_barrier()
#define G8_SCHED __builtin_amdgcn_sched_barrier(0)
    Unit cur, nxt; int ui = 0;
    if (!S.next(0, cur)) return;
    f32x4 acc[2][2][4][2];
#pragma unroll
    for (int a = 0; a < 2; ++a)
#pragma unroll
        for (int b = 0; b < 2; ++b)
#pragma unroll
            for (int m = 0; m < 4; ++m)
#pragma unroll
                for (int n = 0; n < 2; ++n) acc[a][b][m][n] = (f32x4){0.f, 0.f, 0.f, 0.f};
    v8i_t At[4], B0[2], B1[2];
    unsigned cvA[2][2];
#define G8_NVSLOT ((LAS u32x4*)(lds + RING_BYTES) + (lane_id_fresh() + wid * 64))
#pragma unroll
    for (int h = 0; h < 2; ++h)
#pragma unroll
        for (int i = 0; i < 2; ++i) cvA[h][i] = S.a_off(cur, h * HALF + Rr[i], Cc[i]);
    const char* cA = S.a_base(cur); const char* cB = S.b_base(cur);
    G8_STAGE(G8_SB(0, 0), cB, voffB); G8_STAGE(G8_SB(0, 1), cB + hstepB, voffB); G8_STAGE(G8_SA(0, 0), cA, cvA[0]); G8_STAGE(G8_SA(0, 1), cA, cvA[1]);
    if (wr == 1) G8_BAR;
    G8_WAIT_V(2); G8_BAR;
    G8_STAGE(G8_SB(1, 0), cB + kstep, voffB); G8_STAGE(G8_SA(1, 0), cA + kstep, cvA[0]); G8_STAGE(G8_SB(1, 1), cB + hstepB + kstep, voffB);
    G8_WAIT_V(6); G8_BAR;
    for (;;) {
        const bool has_next = S.next(ui + 1, nxt);
        const char* nA = has_next ? S.a_base(nxt) : cA; const char* nB = has_next ? S.b_base(nxt) : cB;
        if constexpr (Sched::GATHER) {
            const int t2 = lane_id_fresh() + wid * 64;
            int R0, C0, R1, C1; stage_rc(t2 * 16, R0, C0); stage_rc(t2 * 16 + 8192, R1, C1);
            u32x4 nv;
            nv.x = has_next ? S.a_off(nxt, R0, C0) : cvA[0][0]; nv.y = has_next ? S.a_off(nxt, R1, C1) : cvA[0][1];
            nv.z = has_next ? S.a_off(nxt, HALF + R0, C0) : cvA[1][0]; nv.w = has_next ? S.a_off(nxt, HALF + R1, C1) : cvA[1][1];
            *((LAS u32x4*)(lds + RING_BYTES) + t2) = nv;
        }
        asm volatile(".p2align 8" ::: "memory");
        for (int t = 0; t < nt; t += 2) {
            const bool last = (t == nt - 2);
            const char* a1 = cA + (size_t)(t + 1) * kstep;
            const char* a2 = last ? nA : cA + (size_t)(t + 2) * kstep; const char* b2 = last ? nB : cB + (size_t)(t + 2) * kstep;
            const char* a3 = a2 + kstep; const char* b3 = b2 + kstep;
            unsigned v2[2][2];
            if (Sched::GATHER && last) { const u32x4 nv = *G8_NVSLOT; v2[0][0] = nv.x; v2[0][1] = nv.y; v2[1][0] = nv.z; v2[1][1] = nv.w; }
            else { v2[0][0] = cvA[0][0]; v2[0][1] = cvA[0][1]; v2[1][0] = cvA[1][0]; v2[1][1] = cvA[1][1]; }
            G8_LDB(B0, 0, 0); G8_LDB(B1, 0, 1); G8_SCHED; G8_LDA(At, 0, 0); G8_STAGE(G8_SA(1, 1), a1, cvA[1]);
            G8_WAIT_V(8); G8_WAIT_L(0); G8_BAR; G8_MMA(0, 0, At, B0); G8_MMA(0, 1, At, B1); G8_BAR; G8_SCHED;
            G8_LDA(At, 0, 1); G8_STAGE(G8_SB(0, 0), b2, voffB); G8_STAGE(G8_SB(0, 1), b2 + hstepB, voffB); G8_STAGE(G8_SA(0, 0), a2, v2[0]);
            G8_WAIT_V(8); G8_WAIT_L(0); G8_BAR; G8_MMA(1, 0, At, B0); G8_MMA(1, 1, At, B1); G8_BAR; G8_SCHED;
            G8_LDB(B0, 1, 0); G8_LDB(B1, 1, 1); G8_SCHED; G8_LDA(At, 1, 0); G8_STAGE(G8_SA(0, 1), a2, v2[1]);
            G8_WAIT_V(8); G8_WAIT_L(0); G8_BAR; G8_MMA(0, 0, At, B0); G8_MMA(0, 1, At, B1); G8_BAR; G8_SCHED;
            G8_LDA(At, 1, 1); G8_STAGE(G8_SB(1, 0), b3, voffB); G8_STAGE(G8_SB(1, 1), b3 + hstepB, voffB); G8_STAGE(G8_SA(1, 0), a3, v2[0]);
            G8_WAIT_V(8); G8_WAIT_L(0); G8_BAR; G8_MMA(1, 0, At, B0); G8_MMA(1, 1, At, B1); G8_BAR; G8_SCHED;
        }
        if (wr == 0) G8_BAR;
        { const int lf = lane_id_fresh(); E(acc, cur, wr, wc, lf & 15, lf >> 4); }
        if (!has_next) break;
#pragma unroll
        for (int a = 0; a < 2; ++a)
#pragma unroll
            for (int b = 0; b < 2; ++b)
#pragma unroll
                for (int m = 0; m < 4; ++m)
#pragma unroll
                    for (int n = 0; n < 2; ++n) acc[a][b][m][n] = (f32x4){0.f, 0.f, 0.f, 0.f};
        cur = nxt; cA = nA; cB = nB; ++ui;
        if constexpr (Sched::GATHER) { const u32x4 nv = *G8_NVSLOT; cvA[0][0] = nv.x; cvA[0][1] = nv.y; cvA[1][0] = nv.z; cvA[1][1] = nv.w; }
        if (wr == 1) G8_BAR;
    }
    G8_WAIT_V(0);
    G8_BAR;
#undef G8_SA
#undef G8_SB
#undef G8_STAGE
#undef G8_LDA
#undef G8_LDB
#undef G8_MMA
#undef G8_NVSLOT
#undef G8_LO
#undef G8_HI
#undef G8_LD32
#undef G8_WAIT_V
#undef G8_WAIT_L
#undef G8_BAR
#undef G8_SCHED
}


struct EpiProj {
    const float* rs0; const float* g_q; const float* g_k; bf16_t *Q, *Kb, *V, *GB, *CU;
    __device__ __forceinline__ void operator()(f32x4 (&acc)[2][2][4][2], const Unit& u, int wr, int wc, int fr, int fq) const {
        const int pn = u.pn, rbase = u.pm * BM + wr * 64 + fr;
        float rsv[2][4];
#pragma unroll
        for (int ai = 0; ai < 2; ++ai)
#pragma unroll
            for (int m = 0; m < 4; ++m) rsv[ai][m] = rs0[rbase + ai * HALF + m * 16];
        if (pn < 8) {
            const bool isq = pn < 4; const float* gn = isq ? g_q : g_k; const float sc = isq ? 0.125f * LOG2E : 1.f;
            bf16_t* O = isq ? Q : Kb; const int colb = (pn & 3) * 256 + wc * 64 + fq * 8;
            f32x4 gv[2][2];
#pragma unroll
            for (int bj = 0; bj < 2; ++bj)
#pragma unroll
                for (int n = 0; n < 2; ++n) gv[bj][n] = *(const f32x4*)(gn + bj * 32 + fq * 8 + n * 4);
#pragma unroll
            for (int ai = 0; ai < 2; ++ai)
#pragma unroll
                for (int m = 0; m < 4; ++m) {
                    const int row = rbase + ai * HALF + m * 16; const float rs = rsv[ai][m];
                    float ss = 0.f;
#pragma unroll
                    for (int bj = 0; bj < 2; ++bj)
#pragma unroll
                        for (int n = 0; n < 2; ++n) { acc[ai][bj][m][n] = acc[ai][bj][m][n] * rs; ss += dot4(acc[ai][bj][m][n]); }
                    ss += __shfl_xor(ss, 16); ss += __shfl_xor(ss, 32);
                    const float r = rsqrtf(ss * (1.f / 64.f) + EPS) * sc;
#pragma unroll
                    for (int bj = 0; bj < 2; ++bj) *(u32x4*)(O + (size_t)row * 1024 + colb + bj * 32) = pack8(acc[ai][bj][m][0] * r * gv[bj][0], acc[ai][bj][m][1] * r * gv[bj][1]);
                }
        } else if (pn < 16) {
            bf16_t* O = pn < 12 ? V : GB; const int colb = (pn & 3) * 256 + wc * 32 + fq * 8;
#pragma unroll
            for (int ai = 0; ai < 2; ++ai)
#pragma unroll
                for (int m = 0; m < 4; ++m) {
                    const int row = rbase + ai * HALF + m * 16; const float rs = rsv[ai][m];
#pragma unroll
                    for (int bj = 0; bj < 2; ++bj) *(u32x4*)(O + (size_t)row * 1024 + colb + bj * 128) = pack8(acc[ai][bj][m][0] * rs, acc[ai][bj][m][1] * rs);
                }
        } else {
            const int colb = (pn - 16) * 128 + wc * 32 + fq * 8;
#pragma unroll
            for (int ai = 0; ai < 2; ++ai)
#pragma unroll
                for (int m = 0; m < 4; ++m) {
                    const int row = rbase + ai * HALF + m * 16; const float rs = rsv[ai][m], rs2 = rs * rs;
                    *(u32x4*)(CU + (size_t)row * 1024 + colb) = pack8(acc[ai][0][m][0] * acc[ai][1][m][0] * rs2, acc[ai][0][m][1] * acc[ai][1][m][1] * rs2);
                }
        }
    }
};
struct EpiBf16 {
    bf16_t* O; int ldo;
    __device__ __forceinline__ void operator()(f32x4 (&acc)[2][2][4][2], const Unit& u, int wr, int wc, int fr, int fq) const {
        const int rbase = u.pm * BM + wr * 64 + fr, colb = u.pn * BM + wc * 32 + fq * 8;
#pragma unroll
        for (int ai = 0; ai < 2; ++ai)
#pragma unroll
            for (int m = 0; m < 4; ++m) { const int row = rbase + ai * HALF + m * 16;
#pragma unroll
                for (int bj = 0; bj < 2; ++bj) *(u32x4*)(O + (size_t)row * ldo + colb + bj * 128) = pack8(acc[ai][bj][m][0], acc[ai][bj][m][1]); }
    }
};
struct EpiRes {
    const float* x; bf16_t* H; float* SSQ; unsigned char* H8;
    __device__ __forceinline__ void operator()(f32x4 (&acc)[2][2][4][2], const Unit& u, int wr, int wc, int fr, int fq) const {
        const int rbase = u.pm * BM + wr * 64 + fr, colb = u.pn * BM + wc * 32 + fq * 8;
        f32x4 xa[2][2][2][2];
#define ER_LOAD(buf, b) do { _Pragma("unroll") for (int r2 = 0; r2 < 2; ++r2) { const int row_ = rbase + ((b) >> 1) * HALF + (((b) & 1) * 2 + r2) * 16; \
            _Pragma("unroll") for (int bj = 0; bj < 2; ++bj) { const size_t o_ = (size_t)row_ * DM + colb + bj * 128; xa[buf][r2][bj][0] = *(const f32x4*)(x + o_); xa[buf][r2][bj][1] = *(const f32x4*)(x + o_ + 4); } } } while (0)
        ER_LOAD(0, 0);
#pragma unroll
        for (int b = 0; b < 4; ++b) {
            if (b == 0) ER_LOAD(1, 1); else if (b == 1) ER_LOAD(0, 2); else if (b == 2) ER_LOAD(1, 3);
#pragma unroll
            for (int r2 = 0; r2 < 2; ++r2) { const int ai = b >> 1, m = (b & 1) * 2 + r2, row = rbase + ai * HALF + m * 16; float ss = 0.f;
#pragma unroll
                for (int bj = 0; bj < 2; ++bj) { const size_t o = (size_t)row * DM + colb + bj * 128;
                    const f32x4 h0 = acc[ai][bj][m][0] + xa[b & 1][r2][bj][0], h1 = acc[ai][bj][m][1] + xa[b & 1][r2][bj][1];
                    ss += dot4(h0) + dot4(h1);
                    *(u32x4*)(H + o) = pack8(h0, h1);
                    u32x2 w8; w8.x = pack4_fp8(h0, F8_H); w8.y = pack4_fp8(h1, F8_H); *(u32x2*)(H8 + o) = w8; }
                ss += __shfl_xor(ss, 16); ss += __shfl_xor(ss, 32);
                if (fq == 0) SSQ[(size_t)row * 32 + u.pn * 4 + wc] = ss; }
        }
#undef ER_LOAD
    }
};
struct EpiRouter {
    float* PART;
    __device__ __forceinline__ void operator()(f32x4 (&acc)[2][2][4][2], const Unit& u, int wr, int wc, int fr, int fq) const {
        if (wc < 2) {
            const int rbase = u.pm * BM + wr * 64 + fr;
#pragma unroll
            for (int ai = 0; ai < 2; ++ai)
#pragma unroll
                for (int m = 0; m < 4; ++m) { const int row = rbase + ai * HALF + m * 16;
#pragma unroll
                    for (int n = 0; n < 2; ++n) *(f32x4*)(PART + ((size_t)u.e * M + row) * 64 + wc * 32 + n * 16 + fq * 4) = acc[ai][0][m][n]; }
        }
    }
};
struct KSplitSched {
    static constexpr bool GATHER = false;
    const char* A; const char* Bt; int G, c;
    __device__ __forceinline__ bool next(int i, Unit& u) const { const int L = i * G + c; if (L >= (M / BM) * 4) return false; u.pm = L >> 2; u.pn = 0; u.e = L & 3; return true; }
    __device__ __forceinline__ const char* a_base(const Unit& u) const { return A + (size_t)u.pm * BM * DM * 2 + (size_t)u.e * 512 * 2; }
    __device__ __forceinline__ const char* b_base(const Unit& u) const { return Bt + (size_t)u.e * 512 * 2; }
    __device__ __forceinline__ unsigned a_off(const Unit&, int row, int C) const { return (unsigned)(row * DM + C) * 2u; }
    __device__ __forceinline__ unsigned b_off(int row, int C) const { return (unsigned)(row * DM + C) * 2u; }
};
__device__ __forceinline__ f32x4 bf4lo(unsigned a, unsigned b) { return (f32x4){__uint_as_float(a << 16), __uint_as_float(a & 0xffff0000u), __uint_as_float(b << 16), __uint_as_float(b & 0xffff0000u)}; }
struct EpiFinal {
    const bf16_t* H2B; const bf16_t* PP; const float* rs2; float* out;
    __device__ __forceinline__ void operator()(f32x4 (&acc)[2][2][4][2], const Unit& u, int wr, int wc, int fr, int fq) const {
        const int rbase = u.pm * BM + wr * 64 + fr, colb = u.pn * BM + wc * 32 + fq * 8;
        float rsv[2][4];
#pragma unroll
        for (int ai = 0; ai < 2; ++ai)
#pragma unroll
            for (int m = 0; m < 4; ++m) rsv[ai][m] = rs2[rbase + ai * HALF + m * 16];
        u32x4 hb[2][2][2], pb[2][2][2];
#define EF_LOAD(buf, b) do { _Pragma("unroll") for (int r2 = 0; r2 < 2; ++r2) { const int row_ = rbase + ((b) >> 1) * HALF + (((b) & 1) * 2 + r2) * 16; \
            _Pragma("unroll") for (int bj = 0; bj < 2; ++bj) { const size_t o_ = (size_t)row_ * DM + colb + bj * 128; hb[buf][r2][bj] = *(const u32x4*)(H2B + o_); pb[buf][r2][bj] = *(const u32x4*)(PP + o_); } } } while (0)
        EF_LOAD(0, 0);
#pragma unroll
        for (int b = 0; b < 4; ++b) {
            if (b == 0) EF_LOAD(1, 1); else if (b == 1) EF_LOAD(0, 2); else if (b == 2) EF_LOAD(1, 3);
#pragma unroll
            for (int r2 = 0; r2 < 2; ++r2) { const int ai = b >> 1, m = (b & 1) * 2 + r2, row = rbase + ai * HALF + m * 16; const float rs = rsv[ai][m];
#pragma unroll
                for (int bj = 0; bj < 2; ++bj) { const size_t o = (size_t)row * DM + colb + bj * 128;
                    const u32x4 hv = hb[b & 1][r2][bj], pv = pb[b & 1][r2][bj];
                    const f32x4 h0 = bf4lo(hv.x, hv.y), h1 = bf4lo(hv.z, hv.w), p0 = bf4lo(pv.x, pv.y), p1 = bf4lo(pv.z, pv.w);
                    f32x4 z0 = acc[ai][bj][m][0] * rs, z1 = acc[ai][bj][m][1] * rs, o0, o1;
#pragma unroll
                    for (int j = 0; j < 4; ++j) { o0[j] = h0[j] + p0[j] * fast_sigmoid(z0[j]); o1[j] = h1[j] + p1[j] * fast_sigmoid(z1[j]); }
                    *(f32x4*)(out + o) = o0; *(f32x4*)(out + o + 4) = o1; } }
        }
#undef EF_LOAD
    }
};

struct MoeTab { const LAS int* texp; const LAS int* trow0; const LAS int* tcnt; int ntile; };
struct UpSched {
    static constexpr bool GATHER = true;
    const char* Hb; const char* Wup; const int* LIST; MoeTab T; int G, c;
    __device__ __forceinline__ bool next(int i, Unit& u) const { const int L = i * G + c; if (L >= T.ntile * 4) return false; u.pm = L >> 2; u.pn = L & 3; u.e = T.texp[u.pm]; return true; }
    __device__ __forceinline__ const char* a_base(const Unit&) const { return Hb; }
    __device__ __forceinline__ const char* b_base(const Unit& u) const { return Wup + ((size_t)u.e * 1024 + (size_t)u.pn * 256) * DM; }
    __device__ __forceinline__ unsigned a_off(const Unit& u, int row, int C) const {
        int idx = T.trow0[u.pm] + row; const int n = T.tcnt[u.e]; idx = idx < n ? idx : n - 1;
        const int slot = LIST[(size_t)u.e * M + idx]; return (unsigned)(slot >> 1) * (unsigned)DM + (unsigned)C * 2u; }
    __device__ __forceinline__ unsigned b_off(int row, int C) const { return (unsigned)(row * DM + C * 2); }
};
struct DnSched {
    static constexpr bool GATHER = false;
    const char* HID; const char* Wdn; MoeTab T; int G, c;
    __device__ __forceinline__ bool next(int i, Unit& u) const { const int L = i * G + c; if (L >= T.ntile * 8) return false; u.pm = L >> 3; u.pn = L & 7; u.e = T.texp[u.pm]; return true; }
    __device__ __forceinline__ const char* a_base(const Unit& u) const { return HID + (size_t)u.pm * 256 * DFF; }
    __device__ __forceinline__ const char* b_base(const Unit& u) const { return Wdn + ((size_t)u.e * DM + (size_t)u.pn * 256) * DFF; }
    __device__ __forceinline__ unsigned a_off(const Unit&, int row, int C) const { return (unsigned)(row * DFF + C * 2); }
    __device__ __forceinline__ unsigned b_off(int row, int C) const { return (unsigned)(row * DFF + C * 2); }
};
struct EpiUp {
    const float* LRS; bf16_t* HID; MoeTab T;
    __device__ __forceinline__ void operator()(f32x4 (&acc)[2][2][4][2], const Unit& u, int wr, int wc, int fr, int fq) const {
        const int r0 = T.trow0[u.pm], n = T.tcnt[u.e], colb = u.pn * 128 + wc * 32 + fq * 8;
        float rsv[2][4];
#pragma unroll
        for (int ai = 0; ai < 2; ++ai)
#pragma unroll
            for (int m = 0; m < 4; ++m) { const int idx = r0 + ai * HALF + wr * 64 + m * 16 + fr; rsv[ai][m] = LRS[(size_t)u.e * M + (idx < n ? idx : n - 1)]; }
#pragma unroll
        for (int ai = 0; ai < 2; ++ai)
#pragma unroll
            for (int m = 0; m < 4; ++m) {
                const int rit = ai * HALF + wr * 64 + m * 16 + fr; const float vmask = (r0 + rit < n) ? 1.f : 0.f, rs = rsv[ai][m];
                f32x4 h[2];
#pragma unroll
                for (int nn = 0; nn < 2; ++nn) { const f32x4 a = acc[ai][0][m][nn] * rs, b = acc[ai][1][m][nn] * (rs * vmask);
#pragma unroll
                    for (int j = 0; j < 4; ++j) h[nn][j] = a[j] * fast_sigmoid(a[j]) * b[j]; }
                u32x2 w8; w8.x = pack4_fp8(h[0], F8_HID); w8.y = pack4_fp8(h[1], F8_HID);
                *(u32x2*)((unsigned char*)HID + ((size_t)u.pm * 256 + rit) * DFF + colb) = w8;
            }
    }
};
struct EpiDn {
    const int* LIST; const float* LTW; bf16_t* Y0; bf16_t* Y1; MoeTab T;
    __device__ __forceinline__ void operator()(f32x4 (&acc)[2][2][4][2], const Unit& u, int wr, int wc, int fr, int fq) const {
        const int r0 = T.trow0[u.pm], n = T.tcnt[u.e], colb = u.pn * BM + wc * 32 + fq * 8;
        int slv[2][4]; float twv[2][4];
#pragma unroll
        for (int ai = 0; ai < 2; ++ai)
#pragma unroll
            for (int m = 0; m < 4; ++m) { const int idx = r0 + ai * HALF + wr * 64 + m * 16 + fr; const size_t p = (size_t)u.e * M + (idx < n ? idx : n - 1); slv[ai][m] = LIST[p]; twv[ai][m] = LTW[p]; }
#pragma unroll
        for (int ai = 0; ai < 2; ++ai)
#pragma unroll
            for (int m = 0; m < 4; ++m) {
                const int idx = r0 + ai * HALF + wr * 64 + m * 16 + fr;
                if (idx < n) { const int slot = slv[ai][m]; const float tw = twv[ai][m];
                    unsigned char* Y = (unsigned char*)((slot & 1) ? Y1 : Y0) + (size_t)(slot >> 1) * DM + colb;
#pragma unroll
                    for (int bj = 0; bj < 2; ++bj) { u32x2 w8; w8.x = pack4_fp8(acc[ai][bj][m][0] * tw, F8_Y); w8.y = pack4_fp8(acc[ai][bj][m][1] * tw, F8_Y); *(u32x2*)(Y + bj * 128) = w8; } }
            }
    }
};
}

struct Args { const float* in[27]; float* out; unsigned char* ws; int ph_lo, ph_hi, li, pad; };
struct Frame {
    LAS unsigned char* lds; volatile LAS unsigned* MISC; unsigned char* ws;
    int wave, vcu, G;
};

__device__ __forceinline__ float wave_sum(float v) {
#pragma unroll
    for (int o = 1; o < 64; o <<= 1) v += __shfl_xor(v, o);
    return v;
}

__device__ __forceinline__ void tr_item(const float* src, int ld, const float* ks, int k0, int c0, bf16_t* dst, int ldk, int d0, int d1, LAS float* scr, int lane) {
    f32x4 v[16];
#pragma unroll
    for (int i = 0; i < 16; ++i) v[i] = *(const f32x4*)(src + (size_t)(k0 + 4 * i + (lane >> 4)) * ld + c0 + (lane & 15) * 4);
    const int c8 = lane & 7;
    f32x4 g0 = (f32x4){1.f, 1.f, 1.f, 1.f}, g1 = g0;
    if (ks) { g0 = *(const f32x4*)(ks + k0 + 8 * c8); g1 = *(const f32x4*)(ks + k0 + 8 * c8 + 4); }
#pragma unroll
    for (int i = 0; i < 16; ++i) { LAS float* s = scr + (4 * i + (lane >> 4)) * 65 + (lane & 15) * 4; s[0] = v[i][0]; s[1] = v[i][1]; s[2] = v[i][2]; s[3] = v[i][3]; }
    asm volatile("s_waitcnt lgkmcnt(0)" ::: "memory");
#pragma unroll
    for (int j = 0; j < 8; ++j) { const int rr = j * 8 + (lane >> 3), c32 = rr & 31;
        const int p32 = ((c32 >> 2) & 1) * 16 + (c32 >> 3) * 4 + (c32 & 3), drow = ((rr >> 5) ? d1 : d0) + p32;
        const LAS float* s = scr + (8 * c8) * 65 + rr;
        u32x4 o; o.x = cvt_pk_bf16(s[0] * g0[0], s[65] * g0[1]); o.y = cvt_pk_bf16(s[2 * 65] * g0[2], s[3 * 65] * g0[3]); o.z = cvt_pk_bf16(s[4 * 65] * g1[0], s[5 * 65] * g1[1]); o.w = cvt_pk_bf16(s[6 * 65] * g1[2], s[7 * 65] * g1[3]);
        *(u32x4*)(dst + (size_t)drow * ldk + k0 + 8 * c8) = o; }
    asm volatile("s_waitcnt lgkmcnt(0)" ::: "memory");
}
__device__ __forceinline__ void tr_item8(const float* src, int ld, const float* ks, int k0, int c0, unsigned char* dst, int ldk, int d0, int d1, LAS float* scr, int lane) {
    f32x4 v[16];
#pragma unroll
    for (int i = 0; i < 16; ++i) v[i] = *(const f32x4*)(src + (size_t)(k0 + 4 * i + (lane >> 4)) * ld + c0 + (lane & 15) * 4);
    const int c8 = lane & 7;
    f32x4 g0 = (f32x4){1.f, 1.f, 1.f, 1.f}, g1 = g0;
    if (ks) { g0 = *(const f32x4*)(ks + k0 + 8 * c8); g1 = *(const f32x4*)(ks + k0 + 8 * c8 + 4); }
#pragma unroll
    for (int i = 0; i < 16; ++i) { LAS float* s = scr + (4 * i + (lane >> 4)) * 65 + (lane & 15) * 4; s[0] = v[i][0]; s[1] = v[i][1]; s[2] = v[i][2]; s[3] = v[i][3]; }
    asm volatile("s_waitcnt lgkmcnt(0)" ::: "memory");
#pragma unroll
    for (int j = 0; j < 8; ++j) { const int rr = j * 8 + (lane >> 3), c32 = rr & 31;
        const int p32 = ((c32 >> 2) & 1) * 16 + (c32 >> 3) * 4 + (c32 & 3), drow = ((rr >> 5) ? d1 : d0) + p32;
        const LAS float* s = scr + (8 * c8) * 65 + rr;
        u32x2 o; o.x = pack4_fp8((f32x4){s[0], s[65], s[2 * 65], s[3 * 65]} * g0, F8_W); o.y = pack4_fp8((f32x4){s[4 * 65], s[5 * 65], s[6 * 65], s[7 * 65]} * g1, F8_W);
        *(u32x2*)(dst + (size_t)drow * ldk + k0 + 8 * c8) = o; }
    asm volatile("s_waitcnt lgkmcnt(0)" ::: "memory");
}
__device__ __forceinline__ int map_in(int c) {
    if (c < 2048) { const int w = c & 255; return (c & ~255) + ((w >> 5) & 1) * 128 + (w >> 6) * 32; }
    if (c < 4096) return c;
    const int ch = (c - 4096) & 1023; return (16 + (ch >> 7)) * 256 + ((ch >> 5) & 3) * 32 + (c >= 5120 ? 128 : 0);
}

__device__ __forceinline__ void prep_row(const float* x, const float* p, bf16_t* XB, float* RS0, bf16_t* PB, int row, int lane) {
    const GAS f32x4* xr = (const GAS f32x4*)(x + (size_t)row * DM) + lane;
    f32x4 v[8]; float s = 0.f;
#pragma unroll
    for (int j = 0; j < 8; ++j) v[j] = xr[64 * j];
    const f32x4 pv = *((const GAS f32x4*)(p + (size_t)row * PLE) + lane);
#pragma unroll
    for (int j = 0; j < 8; ++j) s += dot4(v[j]);
    s = wave_sum(s);
    GAS u32x2* o = (GAS u32x2*)(XB + (size_t)row * DM) + lane;
#pragma unroll
    for (int j = 0; j < 8; ++j) { u32x2 w; w.x = cvt_pk_bf16(v[j][0], v[j][1]); w.y = cvt_pk_bf16(v[j][2], v[j][3]); o[64 * j] = w; }
    if (lane == 0) RS0[row] = rsqrtf(s * (1.f / DM) + EPS);
    u32x2 w; w.x = cvt_pk_bf16(pv[0], pv[1]); w.y = cvt_pk_bf16(pv[2], pv[3]);
    *((GAS u32x2*)(PB + (size_t)row * PLE) + lane) = w;
}

__device__ __forceinline__ void p0_prologue(Frame& F, const Args& a) {
    unsigned char* ws = F.ws; const int lane = lane_id(), tid = F.wave * 64 + lane;
    const float* w_in = a.in[4]; const float* g_mix = a.in[3]; const float* w_o = a.in[15]; const float* g_ffn = a.in[16];
    const float* w1 = a.in[21]; const float* w3 = a.in[22]; const float* w2 = a.in[23]; const float* g_ple = a.in[24]; const float* w_gate = a.in[25]; const float* w_proj = a.in[26];
    if (blockIdx.x == 0 && tid < 256) {
        LAS float* red = (LAS float*)(F.lds + LCTL_OFF + 128);
        const float* rel_bias = a.in[2]; const int t = tid;
        float gq = 0.f, gk = 0.f, rb = fabsf(rel_bias[t]);
        if (t < 64) { gq = fabsf(a.in[5][t]); gk = fabsf(a.in[6][t]); }
        for (int o = 32; o > 0; o >>= 1) { gq = fmaxf(gq, __shfl_xor(gq, o)); gk = fmaxf(gk, __shfl_xor(gk, o)); rb = fmaxf(rb, __shfl_xor(rb, o)); }
        if ((t & 63) == 0) { red[t >> 6] = rb; if (t == 0) { red[8] = gq; red[9] = gk; } }
    }
    __syncthreads();
    if (blockIdx.x == 0 && tid < 256) {
        LAS float* red = (LAS float*)(F.lds + LCTL_OFF + 128);
        const float* rel_bias = a.in[2]; const int t = tid;
        const float rbm = fmaxf(fmaxf(red[0], red[1]), fmaxf(red[2], red[3]));
        const float m0 = 8.f * red[8] * red[9] + rbm;
        float* BT = (float*)(ws + WS_BT);
        for (int i = t; i < NH * BT_N; i += 256) { const int h = i / BT_N, idx = i % BT_N, rel = idx - 255; BT[i] = (rel_bias[rel_bucket(rel) * NH + h] - m0) * LOG2E; }
        if (t < 64) {
            float x1 = a.in[7][t] * a.in[8][t], x2 = a.in[9][t] * a.in[10][t];
            for (int o = 32; o > 0; o >>= 1) { x1 += __shfl_xor(x1, o); x2 += __shfl_xor(x2, o); }
            if (t == 0) ((float*)(ws + WS_LAM))[0] = expf(x1) - expf(x2) + LAM_INIT;
        }
    }
    __syncthreads();
    const int gw = F.vcu * NWAVES + F.wave, NGW = F.G * NWAVES;
    for (int m = gw; m < M; m += NGW) prep_row(a.in[0], a.in[1], (bf16_t*)(ws + WS_A), (float*)(ws + WS_RS0), (bf16_t*)(ws + WS_PB), m, lane);
    { const float* w_group = a.in[17]; const float* w_expert = a.in[19]; bf16_t* WR = (bf16_t*)(ws + WS_WR);
      for (int i = (F.vcu * NWAVES + F.wave) * 64 + lane; i < 256 * (DM / 8); i += F.G * NTHR) { const int pr = i / (DM / 8), k8 = (i % (DM / 8)) * 8;
          float v[8];
#pragma unroll
          for (int q = 0; q < 8; ++q) { const int k = k8 + q; v[q] = pr < 4 ? g_ffn[k] * w_group[k * 4 + pr] : pr < 36 ? g_ffn[k] * w_expert[k * 32 + pr - 4] : 0.f; }
          u32x4 o; o.x = cvt_pk_bf16(v[0], v[1]); o.y = cvt_pk_bf16(v[2], v[3]); o.z = cvt_pk_bf16(v[4], v[5]); o.w = cvt_pk_bf16(v[6], v[7]);
          *(u32x4*)(WR + (size_t)pr * DM + k8) = o; } }
    LAS float* scr = (LAS float*)(F.lds + F.wave * 16640);
    constexpr int I_IN = 32 * 96, I_O = 32 * 32, I_G = 32 * 32, I_P = 4 * 32, I_UP = 32 * 512, I_DN = 32 * 256;
    constexpr int NITEMS = I_IN + I_O + I_G + I_P + I_UP + I_DN;
    for (int it = gw; it < NITEMS; it += NGW) {
        int r = it;
        if (r < I_IN) { const int kb = r / 96, cb = r % 96, c0 = cb * 64; tr_item(w_in, 6144, g_mix, kb * 64, c0, (bf16_t*)(ws + WS_WIN), DM, map_in(c0), map_in(c0 + 32), scr, lane); continue; } r -= I_IN;
        if (r < I_O) { const int kb = r / 32, c0 = (r % 32) * 64; tr_item(w_o, DM, nullptr, kb * 64, c0, (bf16_t*)(ws + WS_WO), DM, c0, c0 + 32, scr, lane); continue; } r -= I_O;
        if (r < I_G) { const int kb = r / 32, c0 = (r % 32) * 64; tr_item8(w_gate, DM, g_ple, kb * 64, c0, ws + WS_WG, DM, c0, c0 + 32, scr, lane); continue; } r -= I_G;
        if (r < I_P) { const int kb = r / 32, c0 = (r % 32) * 64; tr_item(w_proj, DM, nullptr, kb * 64, c0, (bf16_t*)(ws + WS_WP), PLE, c0, c0 + 32, scr, lane); continue; } r -= I_P;
        if (r < I_UP) { const int e = r / 512, q = r % 512, which = q / 256, q2 = q % 256, kb = q2 / 8, c0 = (q2 % 8) * 64;
            const float* src = (which ? w3 : w1) + (size_t)e * DM * DFF;
            const int d0 = (c0 >> 7) * 256 + ((c0 >> 5) & 3) * 32 + which * 128, d1 = ((c0 + 32) >> 7) * 256 + (((c0 + 32) >> 5) & 3) * 32 + which * 128;
            tr_item8(src, DFF, g_ffn, kb * 64, c0, ws + WS_WUP + (size_t)e * 1024 * DM, DM, d0, d1, scr, lane); continue; } r -= I_UP;
        { const int e = r / 256, q = r % 256, kb = q / 32, c0 = (q % 32) * 64;
            tr_item8(w2 + (size_t)e * DFF * DM, DM, nullptr, kb * 64, c0, ws + WS_WDN + (size_t)e * DM * DFF, DFF, c0, c0 + 32, scr, lane); }
    }
}


namespace att {
typedef short v4i16_t __attribute__((ext_vector_type(4)));
constexpr int SLOT = 32768, STG_STRIDE = 132, STG_BYTES = 32 * STG_STRIDE * 4;
static_assert(4 * SLOT <= RING_BYTES && 8 * STG_BYTES <= LCTL_OFF, "attention LDS");
__device__ __forceinline__ void glds16(const void* gsrc, unsigned lds_dst) { unsigned keep;
    asm volatile("s_mov_b32 %0, m0\n\ts_mov_b32 m0, %2\n\ts_nop 0\n\tglobal_load_lds_dwordx4 %1, off\n\ts_mov_b32 m0, %0" : "=&s"(keep) : "v"(gsrc), "s"(lds_dst) : "memory"); }
__device__ __forceinline__ v4i16_t vtr(const LAS unsigned char* p) { return __builtin_amdgcn_ds_read_tr16_b64_v4i16((LAS v4i16_t*)p); }
__device__ __forceinline__ int crow(int r, int hi) { return (r & 3) + 8 * (r >> 2) + 4 * hi; }

__device__ __forceinline__ void attn_unit(int b, int h, int qb, const bf16_t* Q, const bf16_t* K, const bf16_t* V, bf16_t* AO, const float* g_subln, float lam, LAS unsigned char* lds, int wid) {
    const int lane = lane_id(), r32 = lane & 31, hi = lane >> 5;
    const int pair = wid >> 1, comp = wid & 1;
    const long rowbase = (long)b * SEQ; const int q0 = qb * 128, myrow0 = q0 + pair * 32;
    const int cw = myrow0 >> 6;
    const int NT = (q0 >> 6) + 2;
    const LAS float* bt = (const LAS float*)(lds + LBT_OFF);
    const bf16_t* ksrc = K + (size_t)(rowbase + lane) * 1024 + h * 128 + wid * 8;
    const bf16_t* vsrc = V + (size_t)(rowbase + 16 * (wid & 3) + (lane >> 2)) * 1024 + h * 128 + (wid >> 2) * 32 + (lane & 3) * 8;
    const unsigned lds0 = (unsigned)(size_t)lds;
    const unsigned kdst = lds0 + wid * 1024, vdst = lds0 + 16384 + (wid >> 2) * 4096 + (wid & 3) * 1024;
#define ATT_DMA(t, sl) do { const size_t go_ = (size_t)(t) * 65536; const unsigned so_ = (unsigned)(sl); \
        glds16(ksrc + go_, (unsigned)__builtin_amdgcn_readfirstlane(kdst + so_)); glds16(ksrc + go_ + 64, (unsigned)__builtin_amdgcn_readfirstlane(kdst + so_ + 8192)); \
        glds16(vsrc + go_, (unsigned)__builtin_amdgcn_readfirstlane(vdst + so_)); glds16(vsrc + go_ + 64, (unsigned)__builtin_amdgcn_readfirstlane(vdst + so_ + 8192)); } while (0)
    f32x16 o[4];
#pragma unroll
    for (int d = 0; d < 4; ++d)
#pragma unroll
        for (int r = 0; r < 16; ++r) o[d][r] = 0.f;
    float l = 0.f;
    ATT_DMA(0, 0); ATT_DMA(1, SLOT);
    bf16x8 qr[4];
#pragma unroll
    for (int d0 = 0; d0 < 4; ++d0) qr[d0] = *(const bf16x8*)(Q + (size_t)(rowbase + myrow0 + r32) * 1024 + h * 128 + comp * 64 + d0 * 16 + hi * 8);
    asm volatile("" :: "v"(qr[0]), "v"(qr[1]), "v"(qr[2]), "v"(qr[3]));
    int sl_cur = 0, sl_prev = 3 * SLOT, sl_nn = 2 * SLOT;
    const int kofs = comp * 8192 + hi * 1024 + r32 * 16;
    const int vofs = 16384 + ((lane >> 4) & 1) * 32 + (lane & 3) * 8 + (4 * hi + ((lane & 15) >> 2)) * 64;
    const bool grpY = wid >= 4;
    u32x4 pw[4];
#define ATT_SGB(mask, n) __builtin_amdgcn_sched_group_barrier(mask, n, 0)
    f32x16 p1;
#define ATT_QKEXP(t, slot) do { const LAS unsigned char* sb = lds + (slot); f32x16 p0; \
        bf16x8 kf[4][2]; \
        _Pragma("unroll") for (int d0 = 0; d0 < 4; ++d0) { kf[d0][0] = *(const LAS bf16x8*)(sb + kofs + d0 * 2048); kf[d0][1] = *(const LAS bf16x8*)(sb + kofs + d0 * 2048 + 512); } \
        if ((t) >= cw - 2) { const int base = 64 * (t) + 4 * hi - (myrow0 + r32) + 255; \
            _Pragma("unroll") for (int r = 0; r < 16; ++r) { p0[r] = bt[base + (r & 3) + 8 * (r >> 2)]; p1[r] = bt[base + 32 + (r & 3) + 8 * (r >> 2)]; } } \
        else { const float bf = bt[0]; _Pragma("unroll") for (int r = 0; r < 16; ++r) { p0[r] = bf; p1[r] = bf; } } \
        _Pragma("unroll") for (int d0 = 0; d0 < 4; ++d0) { \
            p0 = __builtin_amdgcn_mfma_f32_32x32x16_bf16(kf[d0][0], qr[d0], p0, 0, 0, 0); p1 = __builtin_amdgcn_mfma_f32_32x32x16_bf16(kf[d0][1], qr[d0], p1, 0, 0, 0); } \
        float sacc = 0.f; \
        _Pragma("unroll") for (int r = 0; r < 16; ++r) { p0[r] = __builtin_amdgcn_exp2f(p0[r]); sacc += p0[r]; } \
        l += sacc; \
        _Pragma("unroll") for (int i = 0; i < 4; ++i) { pw[0][i] = cvt_pk_bf16(p0[2 * i], p0[2 * i + 1]); pw[1][i] = cvt_pk_bf16(p0[8 + 2 * i], p0[9 + 2 * i]); } } while (0)
#define ATT_VLD2(dst, db, k0) do { _Pragma("unroll") for (int kk = 0; kk < 2; ++kk) { \
            const v4i16_t lo = vtr(sb + vofs + (db) * 4096 + ((k0) + kk) * 1024), hh = vtr(sb + vofs + (db) * 4096 + ((k0) + kk) * 1024 + 512); \
            dst[(db) * 2 + kk] = (bf16x8){lo[0], lo[1], lo[2], lo[3], hh[0], hh[1], hh[2], hh[3]}; } } while (0)
#define ATT_PV(slot) do { const LAS unsigned char* sb = lds + (slot); bf16x8 h1[8], h2[8]; \
        _Pragma("unroll") for (int db = 0; db < 4; ++db) ATT_VLD2(h1, db, 0); \
        _Pragma("unroll") for (int db = 0; db < 4; ++db) ATT_VLD2(h2, db, 2); \
        _Pragma("unroll") for (int db = 0; db < 4; ++db) { o[db] = __builtin_amdgcn_mfma_f32_32x32x16_bf16(__builtin_bit_cast(bf16x8, pw[0]), h1[db * 2], o[db], 0, 0, 0); \
                                                         o[db] = __builtin_amdgcn_mfma_f32_32x32x16_bf16(__builtin_bit_cast(bf16x8, pw[1]), h1[db * 2 + 1], o[db], 0, 0, 0); } \
        float sacc = 0.f; \
        _Pragma("unroll") for (int r = 0; r < 16; ++r) { p1[r] = __builtin_amdgcn_exp2f(p1[r]); sacc += p1[r]; } \
        l += sacc; \
        _Pragma("unroll") for (int i = 0; i < 4; ++i) { pw[2][i] = cvt_pk_bf16(p1[2 * i], p1[2 * i + 1]); pw[3][i] = cvt_pk_bf16(p1[8 + 2 * i], p1[9 + 2 * i]); } \
        _Pragma("unroll") for (int db = 0; db < 4; ++db) { o[db] = __builtin_amdgcn_mfma_f32_32x32x16_bf16(__builtin_bit_cast(bf16x8, pw[2]), h2[db * 2], o[db], 0, 0, 0); \
                                                         o[db] = __builtin_amdgcn_mfma_f32_32x32x16_bf16(__builtin_bit_cast(bf16x8, pw[3]), h2[db * 2 + 1], o[db], 0, 0, 0); } } while (0)
#define ATT_WAIT_A(s_) do { if ((s_) + 1 < NT) asm volatile("s_waitcnt vmcnt(4) lgkmcnt(0)\n\ts_barrier" ::: "memory"); else asm volatile("s_waitcnt vmcnt(0) lgkmcnt(0)\n\ts_barrier" ::: "memory"); } while (0)
#define ATT_BAR_B() asm volatile("s_waitcnt lgkmcnt(0)\n\ts_barrier" ::: "memory")
    asm volatile(".p2align 8" ::: "memory");
    if (!grpY) {
        for (int s = 0; s <= NT; ++s) {
            ATT_WAIT_A(s);
            if (s < NT && s <= cw) ATT_QKEXP(s, sl_cur);
            ATT_BAR_B();
            if (s + 2 < NT) ATT_DMA(s + 2, sl_nn);
            if (s < NT && s <= cw) ATT_PV(sl_cur);
            sl_prev = sl_cur; sl_cur = (sl_cur == 3 * SLOT) ? 0 : sl_cur + SLOT; sl_nn = (sl_nn == 3 * SLOT) ? 0 : sl_nn + SLOT;
        }
    } else {
        for (int s = 0; s <= NT; ++s) {
            ATT_WAIT_A(s);
            if (s >= 1 && s - 1 <= cw) ATT_PV(sl_prev);
            ATT_BAR_B();
            if (s + 2 < NT) ATT_DMA(s + 2, sl_nn);
            if (s < NT && s <= cw) ATT_QKEXP(s, sl_cur);
            sl_prev = sl_cur; sl_cur = (sl_cur == 3 * SLOT) ? 0 : sl_cur + SLOT; sl_nn = (sl_nn == 3 * SLOT) ? 0 : sl_nn + SLOT;
        }
    }
#undef ATT_WAIT_A
#undef ATT_BAR_B
#undef ATT_QKEXP
#undef ATT_PV
#undef ATT_VLD2
#undef ATT_SGB
#undef ATT_DMA
    l += __shfl_xor(l, 32);
    asm volatile("s_waitcnt vmcnt(0) lgkmcnt(0)\n\ts_barrier" ::: "memory");
    {   LAS float* st = (LAS float*)(lds + wid * STG_BYTES);
#pragma unroll
        for (int db = 0; db < 4; ++db)
#pragma unroll
            for (int r = 0; r < 16; ++r) st[crow(r, hi) * STG_STRIDE + db * 32 + r32] = o[db][r];
        if (hi == 0) ((LAS float*)(lds + LLS_OFF))[wid * 32 + r32] = l;
    }
    asm volatile("s_waitcnt lgkmcnt(0)\n\ts_barrier" ::: "memory");
    {   const int rsel = comp * 16 + (lane >> 2), quarter = lane & 3;
        const LAS float* s1 = (const LAS float*)(lds + (pair * 2) * STG_BYTES) + rsel * STG_STRIDE + quarter * 32;
        const LAS float* s2 = (const LAS float*)(lds + (pair * 2 + 1) * STG_BYTES) + rsel * STG_STRIDE + quarter * 32;
        const LAS float* ls = (const LAS float*)(lds + LLS_OFF);
        const float i1 = 1.f / ls[(pair * 2) * 32 + rsel], i2 = lam / ls[(pair * 2 + 1) * 32 + rsel];
        f32x4 v[8]; float ss = 0.f;
#pragma unroll
        for (int c = 0; c < 8; ++c) { v[c] = *(const LAS f32x4*)(s1 + c * 4) * i1 - *(const LAS f32x4*)(s2 + c * 4) * i2; ss += dot4(v[c]); }
        ss += __shfl_xor(ss, 1); ss += __shfl_xor(ss, 2);
        const float rstd = rsqrtf(ss * (1.f / 128.f) + EPS) * (1.f - LAM_INIT);
        bf16_t* op = AO + (size_t)(rowbase + myrow0 + rsel - comp * 16 + comp * 16) * DM + h * 128 + quarter * 32;
#pragma unroll
        for (int c = 0; c < 4; ++c) { const f32x4 g0 = *(const f32x4*)(g_subln + quarter * 32 + c * 8), g1 = *(const f32x4*)(g_subln + quarter * 32 + c * 8 + 4);
            *(u32x4*)(op + c * 8) = pack8(v[2 * c] * rstd * g0, v[2 * c + 1] * rstd * g1); }
    }
    asm volatile("s_waitcnt lgkmcnt(0)\n\ts_barrier" ::: "memory");
}
}

__device__ __forceinline__ void p2_conv(Frame& F, const Args& a) {
    unsigned char* ws = F.ws; const int lane = lane_id(), c0 = lane * 16;
    const bf16_t* CU = (const bf16_t*)(ws + WS_D); const bf16_t* GB = (const bf16_t*)(ws + WS_C) + (size_t)M * 1024; bf16_t* AO = (bf16_t*)(ws + WS_A);
    const float* conv_w = a.in[12]; const float* conv_b = a.in[13]; const float* g_conv = a.in[14];
    f32x4 w0[4], w1[4], w2[4], cb[4], gc[4];
#pragma unroll
    for (int i = 0; i < 4; ++i) { w0[i] = *(const f32x4*)(conv_w + c0 + i * 4); w1[i] = *(const f32x4*)(conv_w + 1024 + c0 + i * 4); w2[i] = *(const f32x4*)(conv_w + 2048 + c0 + i * 4);
        cb[i] = *(const f32x4*)(conv_b + c0 + i * 4); gc[i] = *(const f32x4*)(g_conv + c0 + i * 4); }
    const int gw = F.vcu * NWAVES + F.wave, NGW = F.G * NWAVES;
    for (int row = gw; row < M; row += NGW) {
        const int s = row & (SEQ - 1);
        const u32x4 zz = (u32x4){0u, 0u, 0u, 0u};
        u32x4 x0[2], x1[2], x2[2], gb[2];
#pragma unroll
        for (int i = 0; i < 2; ++i) { x0[i] = *(const u32x4*)(CU + (size_t)row * 1024 + c0 + i * 8); gb[i] = *(const u32x4*)(GB + (size_t)row * 1024 + c0 + i * 8);
            x1[i] = s >= 1 ? *(const u32x4*)(CU + (size_t)(row - 1) * 1024 + c0 + i * 8) : zz; x2[i] = s >= 2 ? *(const u32x4*)(CU + (size_t)(row - 2) * 1024 + c0 + i * 8) : zz; }
        f32x4 z[4]; float ss = 0.f;
#pragma unroll
        for (int i = 0; i < 4; ++i) { const int q = i >> 1;
            const f32x4 a0 = (i & 1) ? g8::bf4lo(x0[q].z, x0[q].w) : g8::bf4lo(x0[q].x, x0[q].y), a1 = (i & 1) ? g8::bf4lo(x1[q].z, x1[q].w) : g8::bf4lo(x1[q].x, x1[q].y);
            const f32x4 a2 = (i & 1) ? g8::bf4lo(x2[q].z, x2[q].w) : g8::bf4lo(x2[q].x, x2[q].y), g = (i & 1) ? g8::bf4lo(gb[q].z, gb[q].w) : g8::bf4lo(gb[q].x, gb[q].y);
            z[i] = g * (w2[i] * a0 + w1[i] * a1 + w0[i] * a2 + cb[i]); ss += dot4(z[i]); }
        ss += __shfl_xor(ss, 1); ss += __shfl_xor(ss, 2); ss += __shfl_xor(ss, 4);
        const float r = rsqrtf(ss * (1.f / 128.f) + EPS);
        *(u32x4*)(AO + (size_t)row * DM + 1024 + c0) = pack8(z[0] * r * gc[0], z[1] * r * gc[1]);
        *(u32x4*)(AO + (size_t)row * DM + 1024 + c0 + 8) = pack8(z[2] * r * gc[2], z[3] * r * gc[3]);
    }
}
__device__ __forceinline__ void p2_attention(Frame& F, const Args& a) {
    unsigned char* ws = F.ws; const int tid = F.wave * 64 + lane_id();
    const bf16_t* Qb = (const bf16_t*)(ws + WS_B); const bf16_t* Kb = Qb + (size_t)M * 1024; const bf16_t* Vb = (const bf16_t*)(ws + WS_C); bf16_t* AO = (bf16_t*)(ws + WS_A);
    const int bh = F.vcu >> 3, j = F.vcu & 7, b = bh >> 3, h = bh & 7;
    if (bh >= BATCH * NH) return;
    const float lam = ((const float*)(ws + WS_LAM))[0];
    { LAS float* bt = (LAS float*)(F.lds + LBT_OFF); const float* BT = (const float*)(ws + WS_BT) + h * BT_N; if (tid < BT_N) bt[tid] = BT[tid]; }
    asm volatile("s_waitcnt vmcnt(0) lgkmcnt(0)\n\ts_barrier" ::: "memory");
    for (int i = 0; i < 4; ++i) { const int qb = (i == 0) ? 31 - j : (i == 1) ? 16 + j : (i == 2) ? 15 - j : j;
        att::attn_unit(b, h, qb, Qb, Kb, Vb, AO, a.in[11], lam, F.lds, F.wave); }
}

__device__ __forceinline__ void p5_route(Frame& F, const Args& a) {
    unsigned char* ws = F.ws; const int lane = lane_id();
    const float* PART = (const float*)(ws + WS_PART); const float* SSQ = (const float*)(ws + WS_SSQ);
    const float* b_group = a.in[18]; const float* b_expert = a.in[20];
    float* RS1 = (float*)(ws + WS_RS1); int* TE = (int*)(ws + WS_TE); float* TW = (float*)(ws + WS_TW); unsigned* CNT = (unsigned*)(ws + WS_CNT); int* LIST = (int*)(ws + WS_LIST);
    for (int row = (F.vcu * NWAVES + F.wave) * 64 + lane; row < M; row += F.G * NTHR) {
        float ss = 0.f;
#pragma unroll
        for (int i = 0; i < 8; ++i) { const f32x4 v = *(const f32x4*)(SSQ + (size_t)row * 32 + i * 4); ss += (v[0] + v[1]) + (v[2] + v[3]); }
        const float rs = rsqrtf(ss * (1.f / DM) + EPS);
        f32x4 gl = (f32x4){0.f, 0.f, 0.f, 0.f};
#pragma unroll
        for (int ks = 0; ks < 4; ++ks) gl = gl + *(const f32x4*)(PART + ((size_t)ks * M + row) * 64);
        int gi = 0; float gm = -1e30f; float glv[4];
#pragma unroll
        for (int g = 0; g < 4; ++g) { glv[g] = gl[g] * rs + b_group[g]; if (glv[g] > gm) { gm = glv[g]; gi = g; } }
        float den = 0.f;
#pragma unroll
        for (int g = 0; g < 4; ++g) den += expf(glv[g] - gm);
        const float pg = 1.f / den;
        f32x4 e0 = (f32x4){0.f, 0.f, 0.f, 0.f}, e1 = e0;
#pragma unroll
        for (int ks = 0; ks < 4; ++ks) { const float* pp = PART + ((size_t)ks * M + row) * 64 + 4 + gi * 8; e0 = e0 + *(const f32x4*)pp; e1 = e1 + *(const f32x4*)(pp + 4); }
        float v0 = -1e30f, v1 = -1e30f; int i0 = 0, i1 = 0;
#pragma unroll
        for (int e = 0; e < 8; ++e) { const float v = (e < 4 ? e0[e & 3] : e1[e & 3]) * rs + b_expert[gi * 8 + e];
            if (v > v0) { v1 = v0; i1 = i0; v0 = v; i0 = e; } else if (v > v1) { v1 = v; i1 = e; } }
        const float ex = expf(v1 - v0), w0 = pg / (1.f + ex), w1 = pg * ex / (1.f + ex);
        const int x0 = gi * 8 + i0, x1 = gi * 8 + i1;
        RS1[row] = rs; TE[row * 2] = x0; TE[row * 2 + 1] = x1; TW[row * 2] = w0; TW[row * 2 + 1] = w1;
        float* LRS = (float*)(ws + WS_LRS); float* LTW = (float*)(ws + WS_LTW);
        const unsigned p0 = atomicAdd(&CNT[x0], 1u); LIST[(size_t)x0 * M + p0] = row * 2; LRS[(size_t)x0 * M + p0] = rs; LTW[(size_t)x0 * M + p0] = w0;
        const unsigned p1 = atomicAdd(&CNT[x1], 1u); LIST[(size_t)x1 * M + p1] = row * 2 + 1; LRS[(size_t)x1 * M + p1] = rs; LTW[(size_t)x1 * M + p1] = w1;
    }
}
__device__ __forceinline__ g8::MoeTab moe_tables(Frame& F) {
    LAS int* tab = (LAS int*)(F.lds + LTAB_OFF); const int tid = F.wave * 64 + lane_id();
    const unsigned* CNT = (const unsigned*)(F.ws + WS_CNT);
    __syncthreads();
    if (tid < 32) tab[384 + tid] = (int)__hip_atomic_load(CNT + tid, __ATOMIC_RELAXED, __HIP_MEMORY_SCOPE_AGENT);
    __syncthreads();
    if (tid == 0) { int nt = 0;
        for (int e = 0; e < NE; ++e) { const int n = tab[384 + e]; for (int r = 0; r < n && nt < 192; r += 256) { tab[nt] = e; tab[192 + nt] = r; ++nt; } }
        tab[416] = nt; }
    __syncthreads();
    g8::MoeTab T; T.texp = tab; T.trow0 = tab + 192; T.tcnt = tab + 384; T.ntile = tab[416];
    return T;
}
__device__ __forceinline__ void p7_combine(Frame& F) {
    unsigned char* ws = F.ws;
    bf16_t* H = (bf16_t*)(ws + WS_B); const bf16_t* Y0 = (const bf16_t*)(ws + WS_A); const bf16_t* Y1 = (const bf16_t*)(ws + WS_D); float* RS2 = (float*)(ws + WS_RS2); unsigned char* H28 = ws + WS_H28;
    const int gw = F.vcu * NWAVES + F.wave, NGW = F.G * NWAVES, lane = lane_id();
    for (int row = gw; row < M; row += NGW) {
        float ss = 0.f;
#pragma unroll
        for (int j = 0; j < 4; ++j) { const size_t o = (size_t)row * DM + j * 512 + lane * 8;
            const u32x4 hv = *(const u32x4*)(H + o); const u32x2 y0 = *(const u32x2*)((const unsigned char*)Y0 + o), y1 = *(const u32x2*)((const unsigned char*)Y1 + o);
            const f32x4 a = g8::bf4lo(hv.x, hv.y) + (unpack4_fp8(y0.x) + unpack4_fp8(y1.x)) * (1.f / F8_Y), b = g8::bf4lo(hv.z, hv.w) + (unpack4_fp8(y0.y) + unpack4_fp8(y1.y)) * (1.f / F8_Y);
            ss += dot4(a) + dot4(b);
            *(u32x4*)(H + o) = pack8(a, b);
            u32x2 w8; w8.x = pack4_fp8(a, F8_H); w8.y = pack4_fp8(b, F8_H); *(u32x2*)(H28 + o) = w8; }
        ss = wave_sum(ss);
        if (lane == 0) RS2[row] = rsqrtf(ss * (1.f / DM) + EPS);
    }
}

__global__ void __launch_bounds__(NTHR, 2) mk_fwd(Args args) {
    extern __shared__ __attribute__((aligned(16))) unsigned char lds_raw[];
    Frame F;
    F.lds = (LAS unsigned char*)lds_raw; F.MISC = (volatile LAS unsigned*)(F.lds + LCTL_OFF); F.ws = args.ws;
    F.wave = __builtin_amdgcn_readfirstlane(threadIdx.x >> 6);
    F.G = gridDim.x; { const int bx = blockIdx.x; F.vcu = (F.G % 8 == 0) ? (bx % 8) * (F.G / 8) + bx / 8 : bx; }
    unsigned char* ws = args.ws;
    if (threadIdx.x < 32) F.MISC[threadIdx.x] = 0u;
    __syncthreads();
    XcdBarrier bar = xcd_barrier_post((unsigned*)(ws + WS_BAR) + args.li * XCD_BAR_WORDS, F.MISC + 8);
    const int lo = args.ph_lo, hi = args.ph_hi;
#define IN(k) (lo <= (k) && (k) < hi)
#define SEAM(k) do { if (IN(k) && IN((k) + 1)) xcd_barrier(bar); } while (0)

    bf16_t* XB = (bf16_t*)(ws + WS_A); bf16_t* AO = XB;
    bf16_t* Qb = (bf16_t*)(ws + WS_B); bf16_t* Kb = Qb + (size_t)M * 1024; bf16_t* H = Qb;
    bf16_t* Vb = (bf16_t*)(ws + WS_C); bf16_t* GB = Vb + (size_t)M * 1024;
    bf16_t* CU = (bf16_t*)(ws + WS_D);
    bf16_t* PP = (bf16_t*)(ws + WS_E); bf16_t* PB = (bf16_t*)(ws + WS_PB);
    float* RS0 = (float*)(ws + WS_RS0); float* RS2 = (float*)(ws + WS_RS2);

    if (IN(0)) { p0_prologue(F, args); } SEAM(0);

    if (IN(1)) {
        g8::DenseSched S; S.init(XB, DM * 2, ws + WS_WIN, DM * 2, M, 6144, F.G, (int)blockIdx.x);
        g8::EpiProj E{RS0, args.in[5], args.in[6], Qb, Kb, Vb, GB, CU};
        g8::gemm_phase<g8::EpiProj, g8::DenseSched>(F.lds, F.wave, DM, S, E);
    } SEAM(1);

    if (IN(2)) { p2_conv(F, args); p2_attention(F, args); } SEAM(2);

    if (IN(3)) {
        g8::DenseSched S; S.init(AO, DM * 2, ws + WS_WO, DM * 2, M, DM, F.G, (int)blockIdx.x);
        g8::EpiRes E{args.in[0], H, (float*)(ws + WS_SSQ), ws + WS_H8};
        g8::gemm_phase<g8::EpiRes, g8::DenseSched>(F.lds, F.wave, DM, S, E);
    } SEAM(3);

    if (IN(4)) {
        g8::KSplitSched S{(const char*)H, (const char*)(ws + WS_WR), F.G, (int)blockIdx.x};
        g8::EpiRouter E{(float*)(ws + WS_PART)};
        g8::gemm_phase<g8::EpiRouter, g8::KSplitSched>(F.lds, F.wave, 512, S, E);
    } SEAM(4);

    if (IN(5)) { p5_route(F, args); } SEAM(5);

    if (IN(6)) {
        const g8::MoeTab T = moe_tables(F);
        g8::UpSched S{(const char*)(ws + WS_H8), (const char*)(ws + WS_WUP), (const int*)(ws + WS_LIST), T, F.G, F.vcu};
        g8::EpiUp E{(const float*)(ws + WS_LRS), Vb  , T};
        g8::gemm_phase<g8::EpiUp, g8::UpSched, true>(F.lds, F.wave, DM, S, E, E8_W, E8_H);
    } SEAM(6);

    if (IN(7)) {
        const g8::MoeTab T = moe_tables(F);
        g8::DnSched S{(const char*)Vb, (const char*)(ws + WS_WDN), T, F.G, F.vcu};
        g8::EpiDn E{(const int*)(ws + WS_LIST), (const float*)(ws + WS_LTW), XB  , CU  , T};
        int kdff = DFF; asm volatile("" : "+s"(kdff));
        g8::gemm_phase<g8::EpiDn, g8::DnSched, true>(F.lds, F.wave, kdff, S, E, E8_W, E8_HID);
    } SEAM(7);

    if (IN(8)) { p7_combine(F); } SEAM(8);

    if (IN(9)) {
        { g8::DenseSched S; S.init(PB, PLE * 2, ws + WS_WP, PLE * 2, M, DM, F.G, (int)blockIdx.x);
          g8::EpiBf16 E{PP, DM};
          int kple = PLE; asm volatile("" : "+s"(kple));
          g8::gemm_phase<g8::EpiBf16, g8::DenseSched>(F.lds, F.wave, kple, S, E);
          asm volatile("s_waitcnt vmcnt(0)" ::: "memory"); __syncthreads(); }
        g8::DenseSched S; S.init(ws + WS_H28, DM, ws + WS_WG, DM, M, DM, F.G, (int)blockIdx.x);
        g8::EpiFinal E{H, PP, RS2, args.out};
        g8::gemm_phase<g8::EpiFinal, g8::DenseSched, true>(F.lds, F.wave, DM, S, E, E8_W, E8_H);
    }
#undef IN
#undef SEAM
}


static int mk_grid = 0;
static void launch_mk(Args a, int lo, int hi, int li, hipStream_t stream) {
    a.ph_lo = lo; a.ph_hi = hi; a.li = li; a.pad = 0;
    hipLaunchKernelGGL(mk_fwd, dim3(mk_grid), dim3(NTHR), LDS_BYTES, stream, a);
}

extern "C" void kernel_launch(void* const* d_in, const int* in_sizes, int n_in, void* d_out, int out_size, void* d_ws, size_t ws_size, hipStream_t stream) {
    if (n_in != 27 || ws_size < WS_END) { fprintf(stderr, "kernel_launch: unexpected n_in %d / ws %zu\n", n_in, ws_size); return; }
    if (mk_grid == 0) {
        int dev = 0, cus = 0;
        (void)hipGetDevice(&dev); (void)hipDeviceGetAttribute(&cus, hipDeviceAttributeMultiprocessorCount, dev);
        (void)hipFuncSetAttribute((const void*)mk_fwd, hipFuncAttributeMaxDynamicSharedMemorySize, LDS_BYTES);
        int per_cu = 0; (void)hipOccupancyMaxActiveBlocksPerMultiprocessor(&per_cu, (const void*)mk_fwd, NTHR, LDS_BYTES); (void)hipGetLastError();
        mk_grid = 256;
        if (cus != 256 || per_cu < 1) fprintf(stderr, "kernel_launch: note: %d CUs, occupancy query %d; built for 256 CUs x 1 workgroup\n", cus, per_cu);
    }
    float* out = (float*)d_out; unsigned char* ws = (unsigned char*)d_ws;
    (void)in_sizes; (void)out_size;
    (void)hipMemsetAsync(ws + WS_CTL, 0, 1 * MiB, stream);
    Args a{};
    for (int i = 0; i < 27; ++i) a.in[i] = (const float*)d_in[i];
    a.out = out; a.ws = ws;
    launch_mk(a, 0, 10, 0, stream);
}
```

```cpp
#include <hip/hip_runtime.h>
#include <cstdint>
#include <cstdio>

typedef unsigned short bf16_t;
typedef float f32x4 __attribute__((ext_vector_type(4)));

constexpr int BATCH = 4, SEQ = 4096, DM = 2048, M = BATCH * SEQ;
constexpr int NH = 8, DQK = 64, DV = 128, DATT = 1024, DCONV = 1024;
constexpr int NE = 32, NG = 4, EPG = 8, DFF = 512, PLE = 256;
constexpr float EPS = 1e-6f;
constexpr float LOG2E = 1.4426950408889634f;
constexpr float LAM_INIT = 0.2f;
constexpr int BT_N = 320;

constexpr size_t MiB = 1u << 20;
constexpr size_t WS_CTL = 0;
constexpr size_t WS_BT = 64 * 1024;
constexpr size_t WS_LAM = WS_BT + 16 * 1024;
constexpr size_t WS_CNT = 128 * 1024;
constexpr size_t WS_W = 1 * MiB;
constexpr size_t WS_A = 236 * MiB;
constexpr size_t WS_B = 300 * MiB;
constexpr size_t WS_C = 364 * MiB;
constexpr size_t WS_D = 428 * MiB;
constexpr size_t WS_E = 492 * MiB;
constexpr size_t WS_PB = 556 * MiB;
constexpr size_t WS_SM = 564 * MiB;
constexpr size_t WS_RS0 = WS_SM, WS_RS1 = WS_SM + 64 * 1024, WS_RS2 = WS_SM + 128 * 1024;
constexpr size_t WS_TE = WS_SM + 192 * 1024;
constexpr size_t WS_TW = WS_SM + 320 * 1024;
constexpr size_t WS_LIST = WS_SM + 1 * MiB;
constexpr size_t WS_END = 576 * MiB;

__device__ __forceinline__ float bf2f(bf16_t v) { return __uint_as_float((unsigned)v << 16); }
__device__ __forceinline__ bf16_t f2bf(float f) { unsigned u = __float_as_uint(f); return (bf16_t)((u + 0x7fffu + ((u >> 16) & 1u)) >> 16); }

__device__ __forceinline__ int rel_bucket(int rel) {
    int ret = rel > 0 ? 16 : 0; int n = rel < 0 ? -rel : rel;
    if (n < 8) return ret + n;
    int l = 31 - __clz(n * n) + 2; if (l > 15) l = 15;
    return ret + l;
}

__device__ __forceinline__ float block_sum(float v, float* red) {
    for (int o = 32; o > 0; o >>= 1) v += __shfl_xor(v, o);
    const int w = threadIdx.x >> 6, nw = blockDim.x >> 6;
    __syncthreads();
    if ((threadIdx.x & 63) == 0) red[w] = v;
    __syncthreads();
    float s = 0.f; for (int i = 0; i < nw; ++i) s += red[i];
    return s;
}


#define GAS __attribute__((address_space(1)))
#define LAS __attribute__((address_space(3)))
typedef short bf16x8 __attribute__((ext_vector_type(8)));
typedef unsigned u32x4 __attribute__((ext_vector_type(4)));
typedef unsigned u32x2 __attribute__((ext_vector_type(2)));
typedef float f32x16 __attribute__((ext_vector_type(16)));
typedef GAS unsigned gu32;
#define RLX_AGENT __ATOMIC_RELAXED, __HIP_MEMORY_SCOPE_AGENT

constexpr int NWAVES = 8, NTHR = 512;
constexpr int RING_BYTES = 131072;
constexpr int LCTL_OFF = 145408;
constexpr int LBT_OFF = LCTL_OFF + 128;
constexpr int LLS_OFF = LBT_OFF + 1280;
constexpr int LTAB_OFF = LCTL_OFF + 128;
constexpr int LDS_BYTES = 149504;
static_assert(LLS_OFF + 1024 <= LDS_BYTES && LTAB_OFF + (192 + 192 + 32) * 4 <= LDS_BYTES, "LDS map");

constexpr size_t WS_BAR = 256 * 1024;
constexpr size_t WS_WIN = WS_W;
constexpr size_t WS_WO = WS_WIN + 24 * MiB;
constexpr size_t WS_WG = WS_WO + 8 * MiB;
constexpr size_t WS_WP = WS_WG + 8 * MiB;
constexpr size_t WS_WUP = WS_WP + 1 * MiB;
constexpr size_t WS_WDN = WS_WUP + 128 * MiB;
constexpr size_t WS_WR = WS_WDN + 64 * MiB;
static_assert(WS_WR + 1 * MiB <= WS_A, "weight region");
constexpr size_t WS_LRS = WS_SM + 6 * MiB, WS_LTW = WS_SM + 8 * MiB;
constexpr size_t WS_SSQ = WS_SM + 4 * MiB;
constexpr size_t WS_H8 = WS_E + 32 * MiB;
constexpr size_t WS_H28 = WS_C + 32 * MiB;
constexpr size_t WS_PART = WS_E;

__device__ __forceinline__ int lane_id() { return (int)__builtin_amdgcn_mbcnt_hi(~0u, __builtin_amdgcn_mbcnt_lo(~0u, 0u)); }
__device__ __forceinline__ int lane_id_fresh() { unsigned z = 0u; asm volatile("" : "+v"(z)); return (int)__builtin_amdgcn_mbcnt_hi(~0u, __builtin_amdgcn_mbcnt_lo(~0u, z)); }
typedef float f32x2_t __attribute__((ext_vector_type(2))); typedef __bf16 bf16x2_t __attribute__((ext_vector_type(2)));
__device__ __forceinline__ unsigned cvt_pk_bf16(float lo, float hi) { const f32x2_t v = {lo, hi}; const bf16x2_t b = __builtin_convertvector(v, bf16x2_t); return __builtin_bit_cast(unsigned, b); }
typedef int v8i_t __attribute__((ext_vector_type(8)));
typedef int v4i_t __attribute__((ext_vector_type(4)));
__device__ __forceinline__ unsigned pack4_fp8(f32x4 v, float sc) {
    int w = 0;
    const float a = __builtin_amdgcn_fmed3f(v[0] * sc, -448.f, 448.f), b = __builtin_amdgcn_fmed3f(v[1] * sc, -448.f, 448.f);
    const float c = __builtin_amdgcn_fmed3f(v[2] * sc, -448.f, 448.f), d = __builtin_amdgcn_fmed3f(v[3] * sc, -448.f, 448.f);
    w = __builtin_amdgcn_cvt_pk_fp8_f32(a, b, w, false); w = __builtin_amdgcn_cvt_pk_fp8_f32(c, d, w, true);
    return (unsigned)w;
}
__device__ __forceinline__ f32x4 unpack4_fp8(unsigned w) { const int iw = (int)w;
    return (f32x4){__builtin_amdgcn_cvt_f32_fp8(iw, 0), __builtin_amdgcn_cvt_f32_fp8(iw, 1), __builtin_amdgcn_cvt_f32_fp8(iw, 2), __builtin_amdgcn_cvt_f32_fp8(iw, 3)}; }
constexpr float F8_W = 256.f, F8_H = 16.f, F8_HID = 8.f, F8_Y = 32.f;
constexpr int E8_W = 0x77777777, E8_H = 0x7b7b7b7b, E8_HID = 0x7c7c7c7c;
__device__ __forceinline__ float fast_sigmoid(float z) { return __builtin_amdgcn_rcpf(1.f + __builtin_amdgcn_exp2f(-LOG2E * z)); }

__device__ __forceinline__ u32x4 pack8(f32x4 a, f32x4 b) { u32x4 w; w.x = cvt_pk_bf16(a[0], a[1]); w.y = cvt_pk_bf16(a[2], a[3]); w.z = cvt_pk_bf16(b[0], b[1]); w.w = cvt_pk_bf16(b[2], b[3]); return w; }
__device__ __forceinline__ float dot4(f32x4 a) { return (a[0] * a[0] + a[1] * a[1]) + (a[2] * a[2] + a[3] * a[3]); }

#define XB_TMO      128
#define XB_XCNT(j)  (256  + 64 * (j))
#define XB_XSUB(j)  (1280 + 64 * (j))
#define XB_XGEN(j)  (2304 + 64 * (j))
#define XB_TOP      3328
#define XB_TOPGEN   3392
#define XCD_BAR_WORDS 3456
#define XB_SPIN_CAP (1u << 18)
__device__ __forceinline__ unsigned xb_ld(unsigned* p)              { return __hip_atomic_load(p, __ATOMIC_RELAXED, __HIP_MEMORY_SCOPE_AGENT); }
__device__ __forceinline__ unsigned xb_add(unsigned* p, unsigned v) { return __hip_atomic_fetch_add(p, v, __ATOMIC_RELAXED, __HIP_MEMORY_SCOPE_AGENT); }
__device__ __forceinline__ unsigned xb_xcc_id() { return (unsigned)__builtin_amdgcn_s_getreg((3 << 11) | 20) & 0xFu; }
#define XB_SPIN(cond, bar) do { unsigned _sp = 0; while (cond) { __builtin_amdgcn_s_sleep(1); \
    if ((++_sp & 255u) == 0u) { if (xb_ld(&(bar)[XB_TMO])) break; if (_sp > XB_SPIN_CAP) { atomicAdd(&(bar)[XB_TMO], 1u); break; } } } } while (0)
struct XcdBarrier { unsigned* bar; unsigned x; volatile LAS unsigned* st; };
__device__ __forceinline__ XcdBarrier xcd_barrier_post(unsigned* bar, volatile LAS unsigned* st) {
    XcdBarrier b; b.bar = bar; b.x = xb_xcc_id(); b.st = st;
    if (threadIdx.x == 0) (void)xb_add(&bar[XB_XCNT(b.x)], 1u);
    return b;
}
__device__ __forceinline__ void xcd_barrier_complete(unsigned* bar, unsigned x, unsigned& nloc, unsigned& nx) {
    const unsigned G = gridDim.x * gridDim.y * gridDim.z;
    unsigned sum, cnt, mine, sp = 0u;
    for (;;) {
        sum = 0u; cnt = 0u; mine = 0u;
#pragma unroll
        for (unsigned j = 0; j < 16; ++j) { const unsigned c = xb_ld(&bar[XB_XCNT(j)]); sum += c; cnt += (c > 0u) ? 1u : 0u; mine = (j == x) ? c : mine; }
        if (sum == G) break;
        __builtin_amdgcn_s_sleep(1);
        if ((++sp & 255u) == 0u) { if (xb_ld(&bar[XB_TMO])) break; if (sp > XB_SPIN_CAP) { atomicAdd(&bar[XB_TMO], 1u); break; } }
    }
    nloc = mine > 0u ? mine : 1u; nx = cnt > 0u ? cnt : 1u;
}
__device__ __forceinline__ void xcd_barrier(const XcdBarrier& b) {
    asm volatile("s_waitcnt vmcnt(0)" ::: "memory");
    __syncthreads();
    if (threadIdx.x == 0) {
        unsigned* bar = b.bar;
        __builtin_amdgcn_s_waitcnt(0);
        unsigned nloc = b.st[0], nx = b.st[1];
        if (nloc == 0u) { xcd_barrier_complete(bar, b.x, nloc, nx); b.st[0] = nloc; b.st[1] = nx; }
        const unsigned old = xb_add(&bar[XB_XSUB(b.x)], 1u);
        const unsigned gen = old / nloc;
        if (old + 1u == (gen + 1u) * nloc) {
            __builtin_amdgcn_fence(__ATOMIC_RELEASE, "agent");
            asm volatile("s_waitcnt vmcnt(0)" ::: "memory");
            const unsigned og = xb_add(&bar[XB_TOP], 1u);
            const unsigned tg = og / nx;
            if (og + 1u == (tg + 1u) * nx) xb_add(&bar[XB_TOPGEN], 1u);
            else XB_SPIN(xb_ld(&bar[XB_TOPGEN]) == tg, bar);
            __builtin_amdgcn_fence(__ATOMIC_ACQUIRE, "agent");
            xb_add(&bar[XB_XGEN(b.x)], 1u);
            asm volatile("s_waitcnt vmcnt(0)" ::: "memory");
        } else {
            XB_SPIN(xb_ld(&bar[XB_XGEN(b.x)]) == gen, bar);
            __builtin_amdgcn_fence(__ATOMIC_ACQUIRE, "agent");
            asm volatile("s_waitcnt vmcnt(0)" ::: "memory");
        }
    }
    __syncthreads();
}

namespace g8 {
constexpr int BM = 256, BK = 64, HALF = 128, HTB = HALF * BK * 2, STAGE_BYTES = 8 * HTB;
static_assert(STAGE_BYTES == RING_BYTES, "ring");
__host__ __device__ __forceinline__ int lds_byte(int r, int c) { const int st = (r >> 4) * 2 + (c >> 5), rr = r & 15, cc = c & 31, ob = rr * 64 + cc * 2; return st * 1024 + (ob ^ (((ob >> 9) & 1) << 5)); }
__host__ __device__ __forceinline__ void stage_rc(int b, int& R, int& C) { const int st = b / 1024, sb = b % 1024, swz = sb ^ (((sb >> 9) & 1) << 5); R = (st >> 1) * 16 + swz / 64; C = (st & 1) * 32 + (swz % 64) / 2; }
struct Unit { int pm, pn, e; };

struct DenseSched {
    static constexpr bool GATHER = false;
    const char* A; const char* Bt; int lda, ldb; int nM, nN, nwg, G, c;
    __device__ __forceinline__ void init(const void* A_, int lda_, const void* Bt_, int ldb_, int Mrows, int N, int G_, int c_) { A = (const char*)A_; Bt = (const char*)Bt_; lda = lda_; ldb = ldb_; nM = Mrows / BM; nN = N / BM; nwg = nM * nN; G = G_; c = c_; }
    __device__ __forceinline__ bool next(int i, Unit& u) const {
        const long L = (long)i * G + c; if (L >= nwg) return false;
        int wgid = (int)L; { const int q = nwg / 8, r = nwg % 8, xcd = wgid % 8, off = wgid / 8; wgid = (xcd < r ? xcd * (q + 1) : r * (q + 1) + (xcd - r) * q) + off; }
        const int nig = 8 * nN, gid = wgid / nig, fm = gid * 8, gsz = (nM - fm) < 8 ? (nM - fm) : 8;
        u.pm = fm + ((wgid % nig) % gsz); u.pn = (wgid % nig) / gsz; u.e = 0; return true;
    }
    __device__ __forceinline__ const char* a_base(const Unit& u) const { return A + (size_t)u.pm * BM * lda; }
    __device__ __forceinline__ const char* b_base(const Unit& u) const { return Bt + (size_t)u.pn * BM * ldb; }
    __device__ __forceinline__ unsigned a_off(const Unit&, int row, int C) const { return (unsigned)(row * lda + C * 2); }
    __device__ __forceinline__ unsigned b_off(int row, int C) const { return (unsigned)(row * ldb + C * 2); }
};

template <class Epi, class Sched, bool F8 = false>
__device__ __forceinline__ void gemm_phase(LAS unsigned char* lds, const int wid, const int K, const Sched& S, const Epi& E, const int sclW = 0, const int sclA = 0) {
    const int lane = lane_id(), tid = wid * 64 + lane, wr = wid >> 2, wc = wid & 3, fr = lane & 15, fq = lane >> 4;
    const int nt = F8 ? K / 128 : K / BK;
    int Rr[2], Cc[2];
#pragma unroll
    for (int i = 0; i < 2; ++i) stage_rc(tid * 16 + i * 8192, Rr[i], Cc[i]);
    unsigned voffB[2];
#pragma unroll
    for (int i = 0; i < 2; ++i) voffB[i] = S.b_off(Rr[i], Cc[i]);
    const size_t kstep = (size_t)(BK * 2);
    const size_t hstepB = (size_t)S.b_off(HALF, 0);
    const unsigned ldsw = (unsigned)wid * 1024u;
    const int aoff = lds_byte(wr * 64 + fr, fq * 8), boff = lds_byte(wc * 32 + fr, fq * 8);
#define G8_SA(b, h) (((b) * 2 + (h)) * HTB)
#define G8_SB(b, h) ((4 + (b) * 2 + (h)) * HTB)
#define G8_STAGE(bufoff, gbase, voff) do { _Pragma("unroll") for (int _i = 0; _i < 2; ++_i) { unsigned _o = (voff)[_i]; asm volatile("" : "+v"(_o));     \
        __builtin_amdgcn_global_load_lds((const unsigned*)((const char*)(gbase) + _o), (LAS unsigned*)(lds + (bufoff) + ldsw + _i * 8192), 16, 0, 0); } } while (0)
#define G8_LD32(p) __builtin_shufflevector(*(const LAS v4i_t*)(p), *(const LAS v4i_t*)((p) + 1024), 0, 1, 2, 3, 4, 5, 6, 7)
#define G8_LDA(dst, b, h) do { _Pragma("unroll") for (int m = 0; m < 4; ++m) dst[m] = G8_LD32(lds + G8_SA(b, h) + aoff + m * 2048); } while (0)
#define G8_LDB(dst, b, h) do { _Pragma("unroll") for (int n = 0; n < 2; ++n) dst[n] = G8_LD32(lds + G8_SB(b, h) + boff + n * 2048); } while (0)
#define G8_LO(x) __builtin_bit_cast(bf16x8, __builtin_shufflevector(x, x, 0, 1, 2, 3))
#define G8_HI(x) __builtin_bit_cast(bf16x8, __builtin_shufflevector(x, x, 4, 5, 6, 7))
#define G8_MMA(ai, bj, At, Bt) do { __builtin_amdgcn_s_setprio(1); _Pragma("unroll") for (int m = 0; m < 4; ++m) _Pragma("unroll") for (int n = 0; n < 2; ++n) { \
        if constexpr (F8) acc[ai][bj][m][n] = __builtin_amdgcn_mfma_scale_f32_16x16x128_f8f6f4(Bt[n], At[m], acc[ai][bj][m][n], 0, 0, 0, sclW, 0, sclA); \
        else { acc[ai][bj][m][n] = __builtin_amdgcn_mfma_f32_16x16x32_bf16(G8_LO(Bt[n]), G8_LO(At[m]), acc[ai][bj][m][n], 0, 0, 0); \
               acc[ai][bj][m][n] = __builtin_amdgcn_mfma_f32_16x16x32_bf16(G8_HI(Bt[n]), G8_HI(At[m]), acc[ai][bj][m][n], 0, 0, 0); } } \
        __builtin_amdgcn_s_setprio(0); } while (0)
#define G8_WAIT_V(n) asm volatile("s_waitcnt vmcnt(" #n ")" ::: "memory")
#define G8_WAIT_L(n) asm volatile("s_waitcnt lgkmcnt(" #n ")" ::: "memory")
#define G8_BAR __builtin_amdgcn_s_barrier()
#define G8_SCHED __builtin_amdgcn_sched_barrier(0)
    Unit cur, nxt; int ui = 0;
    if (!S.next(0, cur)) return;
    f32x4 acc[2][2][4][2];
#pragma unroll
    for (int a = 0; a < 2; ++a)
#pragma unroll
        for (int b = 0; b < 2; ++b)
#pragma unroll
            for (int m = 0; m < 4; ++m)
#pragma unroll
                for (int n = 0; n < 2; ++n) acc[a][b][m][n] = (f32x4){0.f, 0.f, 0.f, 0.f};
    v8i_t At[4], B0[2], B1[2];
    unsigned cvA[2][2];
#define G8_NVSLOT ((LAS u32x4*)(lds + RING_BYTES) + (lane_id_fresh() + wid * 64))
#pragma unroll
    for (int h = 0; h < 2; ++h)
#pragma unroll
        for (int i = 0; i < 2; ++i) cvA[h][i] = S.a_off(cur, h * HALF + Rr[i], Cc[i]);
    const char* cA = S.a_base(cur); const char* cB = S.b_base(cur);
    G8_STAGE(G8_SB(0, 0), cB, voffB); G8_STAGE(G8_SB(0, 1), cB + hstepB, voffB); G8_STAGE(G8_SA(0, 0), cA, cvA[0]); G8_STAGE(G8_SA(0, 1), cA, cvA[1]);
    if (wr == 1) G8_BAR;
    G8_WAIT_V(2); G8_BAR;
    G8_STAGE(G8_SB(1, 0), cB + kstep, voffB); G8_STAGE(G8_SA(1, 0), cA + kstep, cvA[0]); G8_STAGE(G8_SB(1, 1), cB + hstepB + kstep, voffB);
    G8_WAIT_V(6); G8_BAR;
    for (;;) {
        const bool has_next = S.next(ui + 1, nxt);
        const char* nA = has_next ? S.a_base(nxt) : cA; const char* nB = has_next ? S.b_base(nxt) : cB;
        if constexpr (Sched::GATHER) {
            const int t2 = lane_id_fresh() + wid * 64;
            int R0, C0, R1, C1; stage_rc(t2 * 16, R0, C0); stage_rc(t2 * 16 + 8192, R1, C1);
            u32x4 nv;
            nv.x = has_next ? S.a_off(nxt, R0, C0) : cvA[0][0]; nv.y = has_next ? S.a_off(nxt, R1, C1) : cvA[0][1];
            nv.z = has_next ? S.a_off(nxt, HALF + R0, C0) : cvA[1][0]; nv.w = has_next ? S.a_off(nxt, HALF + R1, C1) : cvA[1][1];
            *((LAS u32x4*)(lds + RING_BYTES) + t2) = nv;
        }
        asm volatile(".p2align 8" ::: "memory");
        for (int t = 0; t < nt; t += 2) {
            const bool last = (t == nt - 2);
            const char* a1 = cA + (size_t)(t + 1) * kstep;
            const char* a2 = last ? nA : cA + (size_t)(t + 2) * kstep; const char* b2 = last ? nB : cB + (size_t)(t + 2) * kstep;
            const char* a3 = a2 + kstep; const char* b3 = b2 + kstep;
            unsigned v2[2][2];
            if (Sched::GATHER && last) { const u32x4 nv = *G8_NVSLOT; v2[0][0] = nv.x; v2[0][1] = nv.y; v2[1][0] = nv.z; v2[1][1] = nv.w; }
            else { v2[0][0] = cvA[0][0]; v2[0][1] = cvA[0][1]; v2[1][0] = cvA[1][0]; v2[1][1] = cvA[1][1]; }
            G8_LDB(B0, 0, 0); G8_LDB(B1, 0, 1); G8_SCHED; G8_LDA(At, 0, 0); G8_STAGE(G8_SA(1, 1), a1, cvA[1]);
            G8_WAIT_V(8); G8_WAIT_L(0); G8_BAR; G8_MMA(0, 0, At, B0); G8_MMA(0, 1, At, B1); G8_BAR; G8_SCHED;
            G8_LDA(At, 0, 1); G8_STAGE(G8_SB(0, 0), b2, voffB); G8_STAGE(G8_SB(0, 1), b2 + hstepB, voffB); G8_STAGE(G8_SA(0, 0), a2, v2[0]);
            G8_WAIT_V(8); G8_WAIT_L(0); G8_BAR; G8_MMA(1, 0, At, B0); G8_MMA(1, 1, At, B1); G8_BAR; G8_SCHED;
            G8_LDB(B0, 1, 0); G8_LDB(B1, 1, 1); G8_SCHED; G8_LDA(At, 1, 0); G8_STAGE(G8_SA(0, 1), a2, v2[1]);
            G8_WAIT_V(8); G8_WAIT_L(0); G8_BAR; G8_MMA(0, 0, At, B0); G8_MMA(0, 1, At, B1); G8_BAR; G8_SCHED;
            G8_LDA(At, 1, 1); G8_STAGE(G8_SB(1, 0), b3, voffB); G8_STAGE(G8_SB(1, 1), b3 + hstepB, voffB); G8_STAGE(G8_SA(1, 0), a3, v2[0]);
            G8_WAIT_V(8); G8_WAIT_L(0); G8_BAR; G8_MMA(1, 0, At, B0); G8_MMA(1, 1, At, B1); G8_BAR; G8_SCHED;
        }
        if (wr == 0) G8_BAR;
        { const int lf = lane_id_fresh(); E(acc, cur, wr, wc, lf & 15, lf >> 4); }
        if (!has_next) break;
#pragma unroll
        for (int a = 0; a < 2; ++a)
#pragma unroll
            for (int b = 0; b < 2; ++b)
#pragma unroll
                for (int m = 0; m < 4; ++m)
#pragma unroll
                    for (int n = 0; n < 2; ++n) acc[a][b][m][n] = (f32x4){0.f, 0.f, 0.f, 0.f};
        cur = nxt; cA = nA; cB = nB; ++ui;
        if constexpr (Sched::GATHER) { const u32x4 nv = *G8_NVSLOT; cvA[0][0] = nv.x; cvA[0][1] = nv.y; cvA[1][0] = nv.z; cvA[1][1] = nv.w; }
        if (wr == 1) G8_BAR;
    }
    G8_WAIT_V(0);
    G8_BAR;
#undef G8_SA
#undef G8_SB
#undef G8_STAGE
#undef G8_LDA
#undef G8_LDB
#undef G8_MMA
#undef G8_NVSLOT
#undef G8_LO
#undef G8_HI
#undef G8_LD32
#undef G8_WAIT_V
#undef G8_WAIT_L
#undef G8_BAR
#undef G8_SCHED
}


struct EpiProj {
    const float* rs0; const float* g_q; const float* g_k; bf16_t *Q, *Kb, *V, *GB, *CU;
    __device__ __forceinline__ void operator()(f32x4 (&acc)[2][2][4][2], const Unit& u, int wr, int wc, int fr, int fq) const {
        const int pn = u.pn, rbase = u.pm * BM + wr * 64 + fr;
        float rsv[2][4];
#pragma unroll
        for (int ai = 0; ai < 2; ++ai)
#pragma unroll
            for (int m = 0; m < 4; ++m) rsv[ai][m] = rs0[rbase + ai * HALF + m * 16];
        if (pn < 8) {
            const bool isq = pn < 4; const float* gn = isq ? g_q : g_k; const float sc = isq ? 0.125f * LOG2E : 1.f;
            bf16_t* O = isq ? Q : Kb; const int colb = (pn & 3) * 256 + wc * 64 + fq * 8;
            f32x4 gv[2][2];
#pragma unroll
            for (int bj = 0; bj < 2; ++bj)
#pragma unroll
                for (int n = 0; n < 2; ++n) gv[bj][n] = *(const f32x4*)(gn + bj * 32 + fq * 8 + n * 4);
#pragma unroll
            for (int ai = 0; ai < 2; ++ai)
#pragma unroll
                for (int m = 0; m < 4; ++m) {
                    const int row = rbase + ai * HALF + m * 16; const float rs = rsv[ai][m];
                    float ss = 0.f;
#pragma unroll
                    for (int bj = 0; bj < 2; ++bj)
#pragma unroll
                        for (int n = 0; n < 2; ++n) { acc[ai][bj][m][n] = acc[ai][bj][m][n] * rs; ss += dot4(acc[ai][bj][m][n]); }
                    ss += __shfl_xor(ss, 16); ss += __shfl_xor(ss, 32);
                    const float r = rsqrtf(ss * (1.f / 64.f) + EPS) * sc;
#pragma unroll
                    for (int bj = 0; bj < 2; ++bj) *(u32x4*)(O + (size_t)row * 1024 + colb + bj * 32) = pack8(acc[ai][bj][m][0] * r * gv[bj][0], acc[ai][bj][m][1] * r * gv[bj][1]);
                }
        } else if (pn < 16) {
            bf16_t* O = pn < 12 ? V : GB; const int colb = (pn & 3) * 256 + wc * 32 + fq * 8;
#pragma unroll
            for (int ai = 0; ai < 2; ++ai)
#pragma unroll
                for (int m = 0; m < 4; ++m) {
                    const int row = rbase + ai * HALF + m * 16; const float rs = rsv[ai][m];
#pragma unroll
                    for (int bj = 0; bj < 2; ++bj) *(u32x4*)(O + (size_t)row * 1024 + colb + bj * 128) = pack8(acc[ai][bj][m][0] * rs, acc[ai][bj][m][1] * rs);
                }
        } else {
            const int colb = (pn - 16) * 128 + wc * 32 + fq * 8;
#pragma unroll
            for (int ai = 0; ai < 2; ++ai)
#pragma unroll
                for (int m = 0; m < 4; ++m) {
                    const int row = rbase + ai * HALF + m * 16; const float rs = rsv[ai][m], rs2 = rs * rs;
                    *(u32x4*)(CU + (size_t)row * 1024 + colb) = pack8(acc[ai][0][m][0] * acc[ai][1][m][0] * rs2, acc[ai][0][m][1] * acc[ai][1][m][1] * rs2);
                }
        }
    }
};
struct EpiBf16 {
    bf16_t* O; int ldo;
    __device__ __forceinline__ void operator()(f32x4 (&acc)[2][2][4][2], const Unit& u, int wr, int wc, int fr, int fq) const {
        const int rbase = u.pm * BM + wr * 64 + fr, colb = u.pn * BM + wc * 32 + fq * 8;
#pragma unroll
        for (int ai = 0; ai < 2; ++ai)
#pragma unroll
            for (int m = 0; m < 4; ++m) { const int row = rbase + ai * HALF + m * 16;
#pragma unroll
                for (int bj = 0; bj < 2; ++bj) *(u32x4*)(O + (size_t)row * ldo + colb + bj * 128) = pack8(acc[ai][bj][m][0], acc[ai][bj][m][1]); }
    }
};
struct EpiRes {
    const float* x; bf16_t* H; float* SSQ; unsigned char* H8;
    __device__ __forceinline__ void operator()(f32x4 (&acc)[2][2][4][2], const Unit& u, int wr, int wc, int fr, int fq) const {
        const int rbase = u.pm * BM + wr * 64 + fr, colb = u.pn * BM + wc * 32 + fq * 8;
        f32x4 xa[2][2][2][2];
#define ER_LOAD(buf, b) do { _Pragma("unroll") for (int r2 = 0; r2 < 2; ++r2) { const int row_ = rbase + ((b) >> 1) * HALF + (((b) & 1) * 2 + r2) * 16; \
            _Pragma("unroll") for (int bj = 0; bj < 2; ++bj) { const size_t o_ = (size_t)row_ * DM + colb + bj * 128; xa[buf][r2][bj][0] = *(const f32x4*)(x + o_); xa[buf][r2][bj][1] = *(const f32x4*)(x + o_ + 4); } } } while (0)
        ER_LOAD(0, 0);
#pragma unroll
        for (int b = 0; b < 4; ++b) {
            if (b == 0) ER_LOAD(1, 1); else if (b == 1) ER_LOAD(0, 2); else if (b == 2) ER_LOAD(1, 3);
#pragma unroll
            for (int r2 = 0; r2 < 2; ++r2) { const int ai = b >> 1, m = (b & 1) * 2 + r2, row = rbase + ai * HALF + m * 16; float ss = 0.f;
#pragma unroll
                for (int bj = 0; bj < 2; ++bj) { const size_t o = (size_t)row * DM + colb + bj * 128;
                    const f32x4 h0 = acc[ai][bj][m][0] + xa[b & 1][r2][bj][0], h1 = acc[ai][bj][m][1] + xa[b & 1][r2][bj][1];
                    ss += dot4(h0) + dot4(h1);
                    *(u32x4*)(H + o) = pack8(h0, h1);
                    u32x2 w8; w8.x = pack4_fp8(h0, F8_H); w8.y = pack4_fp8(h1, F8_H); *(u32x2*)(H8 + o) = w8; }
                ss += __shfl_xor(ss, 16); ss += __shfl_xor(ss, 32);
                if (fq == 0) SSQ[(size_t)row * 32 + u.pn * 4 + wc] = ss; }
        }
#undef ER_LOAD
    }
};
struct EpiRouter {
    float* PART;
    __device__ __forceinline__ void operator()(f32x4 (&acc)[2][2][4][2], const Unit& u, int wr, int wc, int fr, int fq) const {
        if (wc < 2) {
            const int rbase = u.pm * BM + wr * 64 + fr;
#pragma unroll
            for (int ai = 0; ai < 2; ++ai)
#pragma unroll
                for (int m = 0; m < 4; ++m) { const int row = rbase + ai * HALF + m * 16;
#pragma unroll
                    for (int n = 0; n < 2; ++n) *(f32x4*)(PART + ((size_t)u.e * M + row) * 64 + wc * 32 + n * 16 + fq * 4) = acc[ai][0][m][n]; }
        }
    }
};
struct KSplitSched {
    static constexpr bool GATHER = false;
    const char* A; const char* Bt; int G, c;
    __device__ __forceinline__ bool next(int i, Unit& u) const { const int L = i * G + c; if (L >= (M / BM) * 4) return false; u.pm = L >> 2; u.pn = 0; u.e = L & 3; return true; }
    __device__ __forceinline__ const char* a_base(const Unit& u) const { return A + (size_t)u.pm * BM * DM * 2 + (size_t)u.e * 512 * 2; }
    __device__ __forceinline__ const char* b_base(const Unit& u) const { return Bt + (size_t)u.e * 512 * 2; }
    __device__ __forceinline__ unsigned a_off(const Unit&, int row, int C) const { return (unsigned)(row * DM + C) * 2u; }
    __device__ __forceinline__ unsigned b_off(int row, int C) const { return (unsigned)(row * DM + C) * 2u; }
};
__device__ __forceinline__ f32x4 bf4lo(unsigned a, unsigned b) { return (f32x4){__uint_as_float(a << 16), __uint_as_float(a & 0xffff0000u), __uint_as_float(b << 16), __uint_as_float(b & 0xffff0000u)}; }
struct EpiFinal {
    const bf16_t* H2B; const bf16_t* PP; const float* rs2; float* out;
    __device__ __forceinline__ void operator()(f32x4 (&acc)[2][2][4][2], const Unit& u, int wr, int wc, int fr, int fq) const {
        const int rbase = u.pm * BM + wr * 64 + fr, colb = u.pn * BM + wc * 32 + fq * 8;
        float rsv[2][4];
#pragma unroll
        for (int ai = 0; ai < 2; ++ai)
#pragma unroll
            for (int m = 0; m < 4; ++m) rsv[ai][m] = rs2[rbase + ai * HALF + m * 16];
        u32x4 hb[2][2][2], pb[2][2][2];
#define EF_LOAD(buf, b) do { _Pragma("unroll") for (int r2 = 0; r2 < 2; ++r2) { const int row_ = rbase + ((b) >> 1) * HALF + (((b) & 1) * 2 + r2) * 16; \
            _Pragma("unroll") for (int bj = 0; bj < 2; ++bj) { const size_t o_ = (size_t)row_ * DM + colb + bj * 128; hb[buf][r2][bj] = *(const u32x4*)(H2B + o_); pb[buf][r2][bj] = *(const u32x4*)(PP + o_); } } } while (0)
        EF_LOAD(0, 0);
#pragma unroll
        for (int b = 0; b < 4; ++b) {
            if (b == 0) EF_LOAD(1, 1); else if (b == 1) EF_LOAD(0, 2); else if (b == 2) EF_LOAD(1, 3);
#pragma unroll
            for (int r2 = 0; r2 < 2; ++r2) { const int ai = b >> 1, m = (b & 1) * 2 + r2, row = rbase + ai * HALF + m * 16; const float rs = rsv[ai][m];
#pragma unroll
                for (int bj = 0; bj < 2; ++bj) { const size_t o = (size_t)row * DM + colb + bj * 128;
                    const u32x4 hv = hb[b & 1][r2][bj], pv = pb[b & 1][r2][bj];
                    const f32x4 h0 = bf4lo(hv.x, hv.y), h1 = bf4lo(hv.z, hv.w), p0 = bf4lo(pv.x, pv.y), p1 = bf4lo(pv.z, pv.w);
                    f32x4 z0 = acc[ai][bj][m][0] * rs, z1 = acc[ai][bj][m][1] * rs, o0, o1;
#pragma unroll
                    for (int j = 0; j < 4; ++j) { o0[j] = h0[j] + p0[j] * fast_sigmoid(z0[j]); o1[j] = h1[j] + p1[j] * fast_sigmoid(z1[j]); }
                    *(f32x4*)(out + o) = o0; *(f32x4*)(out + o + 4) = o1; } }
        }
#undef EF_LOAD
    }
};

struct MoeTab { const LAS int* texp; const LAS int* trow0; const LAS int* tcnt; int ntile; };
struct UpSched {
    static constexpr bool GATHER = true;
    const char* Hb; const char* Wup; const int* LIST; MoeTab T; int G, c;
    __device__ __forceinline__ bool next(int i, Unit& u) const { const int L = i * G + c; if (L >= T.ntile * 4) return false; u.pm = L >> 2; u.pn = L & 3; u.e = T.texp[u.pm]; return true; }
    __device__ __forceinline__ const char* a_base(const Unit&) const { return Hb; }
    __device__ __forceinline__ const char* b_base(const Unit& u) const { return Wup + ((size_t)u.e * 1024 + (size_t)u.pn * 256) * DM; }
    __device__ __forceinline__ unsigned a_off(const Unit& u, int row, int C) const {
        int idx = T.trow0[u.pm] + row; const int n = T.tcnt[u.e]; idx = idx < n ? idx : n - 1;
        const int slot = LIST[(size_t)u.e * M + idx]; return (unsigned)(slot >> 1) * (unsigned)DM + (unsigned)C * 2u; }
    __device__ __forceinline__ unsigned b_off(int row, int C) const { return (unsigned)(row * DM + C * 2); }
};
struct DnSched {
    static constexpr bool GATHER = false;
    const char* HID; const char* Wdn; MoeTab T; int G, c;
    __device__ __forceinline__ bool next(int i, Unit& u) const { const int L = i * G + c; if (L >= T.ntile * 8) return false; u.pm = L >> 3; u.pn = L & 7; u.e = T.texp[u.pm]; return true; }
    __device__ __forceinline__ const char* a_base(const Unit& u) const { return HID + (size_t)u.pm * 256 * DFF; }
    __device__ __forceinline__ const char* b_base(const Unit& u) const { return Wdn + ((size_t)u.e * DM + (size_t)u.pn * 256) * DFF; }
    __device__ __forceinline__ unsigned a_off(const Unit&, int row, int C) const { return (unsigned)(row * DFF + C * 2); }
    __device__ __forceinline__ unsigned b_off(int row, int C) const { return (unsigned)(row * DFF + C * 2); }
};
struct EpiUp {
    const float* LRS; bf16_t* HID; MoeTab T;
    __device__ __forceinline__ void operator()(f32x4 (&acc)[2][2][4][2], const Unit& u, int wr, int wc, int fr, int fq) const {
        const int r0 = T.trow0[u.pm], n = T.tcnt[u.e], colb = u.pn * 128 + wc * 32 + fq * 8;
        float rsv[2][4];
#pragma unroll
        for (int ai = 0; ai < 2; ++ai)
#pragma unroll
            for (int m = 0; m < 4; ++m) { const int idx = r0 + ai * HALF + wr * 64 + m * 16 + fr; rsv[ai][m] = LRS[(size_t)u.e * M + (idx < n ? idx : n - 1)]; }
#pragma unroll
        for (int ai = 0; ai < 2; ++ai)
#pragma unroll
            for (int m = 0; m < 4; ++m) {
                const int rit = ai * HALF + wr * 64 + m * 16 + fr; const float vmask = (r0 + rit < n) ? 1.f : 0.f, rs = rsv[ai][m];
                f32x4 h[2];
#pragma unroll
                for (int nn = 0; nn < 2; ++nn) { const f32x4 a = acc[ai][0][m][nn] * rs, b = acc[ai][1][m][nn] * (rs * vmask);
#pragma unroll
                    for (int j = 0; j < 4; ++j) h[nn][j] = a[j] * fast_sigmoid(a[j]) * b[j]; }
                u32x2 w8; w8.x = pack4_fp8(h[0], F8_HID); w8.y = pack4_fp8(h[1], F8_HID);
                *(u32x2*)((unsigned char*)HID + ((size_t)u.pm * 256 + rit) * DFF + colb) = w8;
            }
    }
};
struct EpiDn {
    const int* LIST; const float* LTW; bf16_t* Y0; bf16_t* Y1; MoeTab T;
    __device__ __forceinline__ void operator()(f32x4 (&acc)[2][2][4][2], const Unit& u, int wr, int wc, int fr, int fq) const {
        const int r0 = T.trow0[u.pm], n = T.tcnt[u.e], colb = u.pn * BM + wc * 32 + fq * 8;
        int slv[2][4]; float twv[2][4];
#pragma unroll
        for (int ai = 0; ai < 2; ++ai)
#pragma unroll
            for (int m = 0; m < 4; ++m) { const int idx = r0 + ai * HALF + wr * 64 + m * 16 + fr; const size_t p = (size_t)u.e * M + (idx < n ? idx : n - 1); slv[ai][m] = LIST[p]; twv[ai][m] = LTW[p]; }
#pragma unroll
        for (int ai = 0; ai < 2; ++ai)
#pragma unroll
            for (int m = 0; m < 4; ++m) {
                const int idx = r0 + ai * HALF + wr * 64 + m * 16 + fr;
                if (idx < n) { const int slot = slv[ai][m]; const float tw = twv[ai][m];
                    unsigned char* Y = (unsigned char*)((slot & 1) ? Y1 : Y0) + (size_t)(slot >> 1) * DM + colb;
#pragma unroll
                    for (int bj = 0; bj < 2; ++bj) { u32x2 w8; w8.x = pack4_fp8(acc[ai][bj][m][0] * tw, F8_Y); w8.y = pack4_fp8(acc[ai][bj][m][1] * tw, F8_Y); *(u32x2*)(Y + bj * 128) = w8; } }
            }
    }
};
}

struct Args { const float* in[27]; float* out; unsigned char* ws; int ph_lo, ph_hi, li, pad; };
struct Frame {
    LAS unsigned char* lds; volatile LAS unsigned* MISC; unsigned char* ws;
    int wave, vcu, G;
};

__device__ __forceinline__ float wave_sum(float v) {
#pragma unroll
    for (int o = 1; o < 64; o <<= 1) v += __shfl_xor(v, o);
    return v;
}

__device__ __forceinline__ void tr_item(const float* src, int ld, const float* ks, int k0, int c0, bf16_t* dst, int ldk, int d0, int d1, LAS float* scr, int lane) {
    f32x4 v[16];
#pragma unroll
    for (int i = 0; i < 16; ++i) v[i] = *(const f32x4*)(src + (size_t)(k0 + 4 * i + (lane >> 4)) * ld + c0 + (lane & 15) * 4);
    const int c8 = lane & 7;
    f32x4 g0 = (f32x4){1.f, 1.f, 1.f, 1.f}, g1 = g0;
    if (ks) { g0 = *(const f32x4*)(ks + k0 + 8 * c8); g1 = *(const f32x4*)(ks + k0 + 8 * c8 + 4); }
#pragma unroll
    for (int i = 0; i < 16; ++i) { LAS float* s = scr + (4 * i + (lane >> 4)) * 65 + (lane & 15) * 4; s[0] = v[i][0]; s[1] = v[i][1]; s[2] = v[i][2]; s[3] = v[i][3]; }
    asm volatile("s_waitcnt lgkmcnt(0)" ::: "memory");
#pragma unroll
    for (int j = 0; j < 8; ++j) { const int rr = j * 8 + (lane >> 3), c32 = rr & 31;
        const int p32 = ((c32 >> 2) & 1) * 16 + (c32 >> 3) * 4 + (c32 & 3), drow = ((rr >> 5) ? d1 : d0) + p32;
        const LAS float* s = scr + (8 * c8) * 65 + rr;
        u32x4 o; o.x = cvt_pk_bf16(s[0] * g0[0], s[65] * g0[1]); o.y = cvt_pk_bf16(s[2 * 65] * g0[2], s[3 * 65] * g0[3]); o.z = cvt_pk_bf16(s[4 * 65] * g1[0], s[5 * 65] * g1[1]); o.w = cvt_pk_bf16(s[6 * 65] * g1[2], s[7 * 65] * g1[3]);
        *(u32x4*)(dst + (size_t)drow * ldk + k0 + 8 * c8) = o; }
    asm volatile("s_waitcnt lgkmcnt(0)" ::: "memory");
}
__device__ __forceinline__ void tr_item8(const float* src, int ld, const float* ks, int k0, int c0, unsigned char* dst, int ldk, int d0, int d1, LAS float* scr, int lane) {
    f32x4 v[16];
#pragma unroll
    for (int i = 0; i < 16; ++i) v[i] = *(const f32x4*)(src + (size_t)(k0 + 4 * i + (lane >> 4)) * ld + c0 + (lane & 15) * 4);
    const int c8 = lane & 7;
    f32x4 g0 = (f32x4){1.f, 1.f, 1.f, 1.f}, g1 = g0;
    if (ks) { g0 = *(const f32x4*)(ks + k0 + 8 * c8); g1 = *(const f32x4*)(ks + k0 + 8 * c8 + 4); }
#pragma unroll
    for (int i = 0; i < 16; ++i) { LAS float* s = scr + (4 * i + (lane >> 4)) * 65 + (lane & 15) * 4; s[0] = v[i][0]; s[1] = v[i][1]; s[2] = v[i][2]; s[3] = v[i][3]; }
    asm volatile("s_waitcnt lgkmcnt(0)" ::: "memory");
#pragma unroll
    for (int j = 0; j < 8; ++j) { const int rr = j * 8 + (lane >> 3), c32 = rr & 31;
        const int p32 = ((c32 >> 2) & 1) * 16 + (c32 >> 3) * 4 + (c32 & 3), drow = ((rr >> 5) ? d1 : d0) + p32;
        const LAS float* s = scr + (8 * c8) * 65 + rr;
        u32x2 o; o.x = pack4_fp8((f32x4){s[0], s[65], s[2 * 65], s[3 * 65]} * g0, F8_W); o.y = pack4_fp8((f32x4){s[4 * 65], s[5 * 65], s[6 * 65], s[7 * 65]} * g1, F8_W);
        *(u32x2*)(dst + (size_t)drow * ldk + k0 + 8 * c8) = o; }
    asm volatile("s_waitcnt lgkmcnt(0)" ::: "memory");
}
__device__ __forceinline__ int map_in(int c) {
    if (c < 2048) { const int w = c & 255; return (c & ~255) + ((w >> 5) & 1) * 128 + (w >> 6) * 32; }
    if (c < 4096) return c;
    const int ch = (c - 4096) & 1023; return (16 + (ch >> 7)) * 256 + ((ch >> 5) & 3) * 32 + (c >= 5120 ? 128 : 0);
}

__device__ __forceinline__ void prep_row(const float* x, const float* p, bf16_t* XB, float* RS0, bf16_t* PB, int row, int lane) {
    const GAS f32x4* xr = (const GAS f32x4*)(x + (size_t)row * DM) + lane;
    f32x4 v[8]; float s = 0.f;
#pragma unroll
    for (int j = 0; j < 8; ++j) v[j] = xr[64 * j];
    const f32x4 pv = *((const GAS f32x4*)(p + (size_t)row * PLE) + lane);
#pragma unroll
    for (int j = 0; j < 8; ++j) s += dot4(v[j]);
    s = wave_sum(s);
    GAS u32x2* o = (GAS u32x2*)(XB + (size_t)row * DM) + lane;
#pragma unroll
    for (int j = 0; j < 8; ++j) { u32x2 w; w.x = cvt_pk_bf16(v[j][0], v[j][1]); w.y = cvt_pk_bf16(v[j][2], v[j][3]); o[64 * j] = w; }
    if (lane == 0) RS0[row] = rsqrtf(s * (1.f / DM) + EPS);
    u32x2 w; w.x = cvt_pk_bf16(pv[0], pv[1]); w.y = cvt_pk_bf16(pv[2], pv[3]);
    *((GAS u32x2*)(PB + (size_t)row * PLE) + lane) = w;
}

__device__ __forceinline__ void p0_prologue(Frame& F, const Args& a) {
    unsigned char* ws = F.ws; const int lane = lane_id(), tid = F.wave * 64 + lane;
    const float* w_in = a.in[4]; const float* g_mix = a.in[3]; const float* w_o = a.in[15]; const float* g_ffn = a.in[16];
    const float* w1 = a.in[21]; const float* w3 = a.in[22]; const float* w2 = a.in[23]; const float* g_ple = a.in[24]; const float* w_gate = a.in[25]; const float* w_proj = a.in[26];
    if (blockIdx.x == 0 && tid < 256) {
        LAS float* red = (LAS float*)(F.lds + LCTL_OFF + 128);
        const float* rel_bias = a.in[2]; const int t = tid;
        float gq = 0.f, gk = 0.f, rb = fabsf(rel_bias[t]);
        if (t < 64) { gq = fabsf(a.in[5][t]); gk = fabsf(a.in[6][t]); }
        for (int o = 32; o > 0; o >>= 1) { gq = fmaxf(gq, __shfl_xor(gq, o)); gk = fmaxf(gk, __shfl_xor(gk, o)); rb = fmaxf(rb, __shfl_xor(rb, o)); }
        if ((t & 63) == 0) { red[t >> 6] = rb; if (t == 0) { red[8] = gq; red[9] = gk; } }
    }
    __syncthreads();
    if (blockIdx.x == 0 && tid < 256) {
        LAS float* red = (LAS float*)(F.lds + LCTL_OFF + 128);
        const float* rel_bias = a.in[2]; const int t = tid;
        const float rbm = fmaxf(fmaxf(red[0], red[1]), fmaxf(red[2], red[3]));
        const float m0 = 8.f * red[8] * red[9] + rbm;
        float* BT = (float*)(ws + WS_BT);
        for (int i = t; i < NH * BT_N; i += 256) { const int h = i / BT_N, idx = i % BT_N, rel = idx - 255; BT[i] = (rel_bias[rel_bucket(rel) * NH + h] - m0) * LOG2E; }
        if (t < 64) {
            float x1 = a.in[7][t] * a.in[8][t], x2 = a.in[9][t] * a.in[10][t];
            for (int o = 32; o > 0; o >>= 1) { x1 += __shfl_xor(x1, o); x2 += __shfl_xor(x2, o); }
            if (t == 0) ((float*)(ws + WS_LAM))[0] = expf(x1) - expf(x2) + LAM_INIT;
        }
    }
    __syncthreads();
    const int gw = F.vcu * NWAVES + F.wave, NGW = F.G * NWAVES;
    for (int m = gw; m < M; m += NGW) prep_row(a.in[0], a.in[1], (bf16_t*)(ws + WS_A), (float*)(ws + WS_RS0), (bf16_t*)(ws + WS_PB), m, lane);
    { const float* w_group = a.in[17]; const float* w_expert = a.in[19]; bf16_t* WR = (bf16_t*)(ws + WS_WR);
      for (int i = (F.vcu * NWAVES + F.wave) * 64 + lane; i < 256 * (DM / 8); i += F.G * NTHR) { const int pr = i / (DM / 8), k8 = (i % (DM / 8)) * 8;
          float v[8];
#pragma unroll
          for (int q = 0; q < 8; ++q) { const int k = k8 + q; v[q] = pr < 4 ? g_ffn[k] * w_group[k * 4 + pr] : pr < 36 ? g_ffn[k] * w_expert[k * 32 + pr - 4] : 0.f; }
          u32x4 o; o.x = cvt_pk_bf16(v[0], v[1]); o.y = cvt_pk_bf16(v[2], v[3]); o.z = cvt_pk_bf16(v[4], v[5]); o.w = cvt_pk_bf16(v[6], v[7]);
          *(u32x4*)(WR + (size_t)pr * DM + k8) = o; } }
    LAS float* scr = (LAS float*)(F.lds + F.wave * 16640);
    constexpr int I_IN = 32 * 96, I_O = 32 * 32, I_G = 32 * 32, I_P = 4 * 32, I_UP = 32 * 512, I_DN = 32 * 256;
    constexpr int NITEMS = I_IN + I_O + I_G + I_P + I_UP + I_DN;
    for (int it = gw; it < NITEMS; it += NGW) {
        int r = it;
        if (r < I_IN) { const int kb = r / 96, cb = r % 96, c0 = cb * 64; tr_item(w_in, 6144, g_mix, kb * 64, c0, (bf16_t*)(ws + WS_WIN), DM, map_in(c0), map_in(c0 + 32), scr, lane); continue; } r -= I_IN;
        if (r < I_O) { const int kb = r / 32, c0 = (r % 32) * 64; tr_item(w_o, DM, nullptr, kb * 64, c0, (bf16_t*)(ws + WS_WO), DM, c0, c0 + 32, scr, lane); continue; } r -= I_O;
        if (r < I_G) { const int kb = r / 32, c0 = (r % 32) * 64; tr_item8(w_gate, DM, g_ple, kb * 64, c0, ws + WS_WG, DM, c0, c0 + 32, scr, lane); continue; } r -= I_G;
        if (r < I_P) { const int kb = r / 32, c0 = (r % 32) * 64; tr_item(w_proj, DM, nullptr, kb * 64, c0, (bf16_t*)(ws + WS_WP), PLE, c0, c0 + 32, scr, lane); continue; } r -= I_P;
        if (r < I_UP) { const int e = r / 512, q = r % 512, which = q / 256, q2 = q % 256, kb = q2 / 8, c0 = (q2 % 8) * 64;
            const float* src = (which ? w3 : w1) + (size_t)e * DM * DFF;
            const int d0 = (c0 >> 7) * 256 + ((c0 >> 5) & 3) * 32 + which * 128, d1 = ((c0 + 32) >> 7) * 256 + (((c0 + 32) >> 5) & 3) * 32 + which * 128;
            tr_item8(src, DFF, g_ffn, kb * 64, c0, ws + WS_WUP + (size_t)e * 1024 * DM, DM, d0, d1, scr, lane); continue; } r -= I_UP;
        { const int e = r / 256, q = r % 256, kb = q / 32, c0 = (q % 32) * 64;
            tr_item8(w2 + (size_t)e * DFF * DM, DM, nullptr, kb * 64, c0, ws + WS_WDN + (size_t)e * DM * DFF, DFF, c0, c0 + 32, scr, lane); }
    }
}


namespace att {
typedef short v4i16_t __attribute__((ext_vector_type(4)));
constexpr int SLOT = 32768, STG_STRIDE = 132, STG_BYTES = 32 * STG_STRIDE * 4;
static_assert(4 * SLOT <= RING_BYTES && 8 * STG_BYTES <= LCTL_OFF, "attention LDS");
__device__ __forceinline__ void glds16(const void* gsrc, unsigned lds_dst) { unsigned keep;
    asm volatile("s_mov_b32 %0, m0\n\ts_mov_b32 m0, %2\n\ts_nop 0\n\tglobal_load_lds_dwordx4 %1, off\n\ts_mov_b32 m0, %0" : "=&s"(keep) : "v"(gsrc), "s"(lds_dst) : "memory"); }
__device__ __forceinline__ v4i16_t vtr(const LAS unsigned char* p) { return __builtin_amdgcn_ds_read_tr16_b64_v4i16((LAS v4i16_t*)p); }
__device__ __forceinline__ int crow(int r, int hi) { return (r & 3) + 8 * (r >> 2) + 4 * hi; }

__device__ __forceinline__ void attn_unit(int b, int h, int qb, const bf16_t* Q, const bf16_t* K, const bf16_t* V, bf16_t* AO, const float* g_subln, float lam, LAS unsigned char* lds, int wid) {
    const int lane = lane_id(), r32 = lane & 31, hi = lane >> 5;
    const int pair = wid >> 1, comp = wid & 1;
    const long rowbase = (long)b * SEQ; const int q0 = qb * 128, myrow0 = q0 + pair * 32;
    const int cw = myrow0 >> 6;
    const int NT = (q0 >> 6) + 2;
    const LAS float* bt = (const LAS float*)(lds + LBT_OFF);
    const float ffar = __builtin_amdgcn_exp2f(bt[0]);
    const bf16_t* ksrc = K + (size_t)(rowbase + 8 * wid + (lane >> 3)) * 1024 + h * 128 + (((lane & 7) ^ (((8 * wid + (lane >> 3)) >> 1) & 7)) * 8);
    const bf16_t* vsrc = V + (size_t)(rowbase + 16 * (wid & 3) + (lane >> 2)) * 1024 + h * 128 + (wid >> 2) * 32 + (lane & 3) * 8;
    const unsigned lds0 = (unsigned)(size_t)lds;
    const unsigned kdst = lds0 + wid * 1024, vdst = lds0 + 16384 + (wid >> 2) * 4096 + (wid & 3) * 1024;
#define ATT_DMA(t, sl) do { const size_t go_ = (size_t)(t) * 65536; const unsigned so_ = (unsigned)(sl); \
        glds16(ksrc + go_, (unsigned)__builtin_amdgcn_readfirstlane(kdst + so_)); glds16(ksrc + go_ + 64, (unsigned)__builtin_amdgcn_readfirstlane(kdst + so_ + 8192)); \
        glds16(vsrc + go_, (unsigned)__builtin_amdgcn_readfirstlane(vdst + so_)); glds16(vsrc + go_ + 64, (unsigned)__builtin_amdgcn_readfirstlane(vdst + so_ + 8192)); } while (0)
    f32x16 o[4];
#pragma unroll
    for (int d = 0; d < 4; ++d)
#pragma unroll
        for (int r = 0; r < 16; ++r) o[d][r] = 0.f;
    float l = 0.f;
    ATT_DMA(0, 0); ATT_DMA(1, SLOT);
    bf16x8 qr[4];
#pragma unroll
    for (int d0 = 0; d0 < 4; ++d0) qr[d0] = *(const bf16x8*)(Q + (size_t)(rowbase + myrow0 + r32) * 1024 + h * 128 + comp * 64 + d0 * 16 + hi * 8);
    asm volatile("" :: "v"(qr[0]), "v"(qr[1]), "v"(qr[2]), "v"(qr[3]));
    int sl_cur = 0, sl_prev = 3 * SLOT, sl_nn = 2 * SLOT;
    int kofs[4];
#pragma unroll
    for (int d0 = 0; d0 < 4; ++d0) kofs[d0] = comp * 8192 + r32 * 128 + (((2 * d0 + hi) ^ ((r32 >> 1) & 7)) * 16);
    const int vofs = 16384 + ((lane >> 4) & 1) * 32 + (lane & 3) * 8 + (4 * hi + ((lane & 15) >> 2)) * 64;
    const bool grpY = wid >= 4;
    u32x4 pw[4];
#define ATT_SGB(mask, n) __builtin_amdgcn_sched_group_barrier(mask, n, 0)
    f32x16 p1;
#define ATT_QKEXP(t, slot) do { const LAS unsigned char* sb = lds + (slot); f32x16 p0; \
        bf16x8 kf[4][2]; \
        _Pragma("unroll") for (int d0 = 0; d0 < 4; ++d0) { kf[d0][0] = *(const LAS bf16x8*)(sb + kofs[d0]); kf[d0][1] = *(const LAS bf16x8*)(sb + kofs[d0] + 4096); } \
        if ((t) == cw - 2 && (t) > 0) l *= ffar; \
        if ((t) >= cw - 2) { const int base = 64 * (t) + 4 * hi - (myrow0 + r32) + 255; \
            _Pragma("unroll") for (int r = 0; r < 16; ++r) { p0[r] = bt[base + (r & 3) + 8 * (r >> 2)]; p1[r] = bt[base + 32 + (r & 3) + 8 * (r >> 2)]; } \
            _Pragma("unroll") for (int d0 = 0; d0 < 4; ++d0) { \
                p0 = __builtin_amdgcn_mfma_f32_32x32x16_bf16(kf[d0][0], qr[d0], p0, 0, 0, 0); p1 = __builtin_amdgcn_mfma_f32_32x32x16_bf16(kf[d0][1], qr[d0], p1, 0, 0, 0); } } \
        else { const f32x16 z16 = {0.f, 0.f, 0.f, 0.f, 0.f, 0.f, 0.f, 0.f, 0.f, 0.f, 0.f, 0.f, 0.f, 0.f, 0.f, 0.f};     \
            p0 = __builtin_amdgcn_mfma_f32_32x32x16_bf16(kf[0][0], qr[0], z16, 0, 0, 0); p1 = __builtin_amdgcn_mfma_f32_32x32x16_bf16(kf[0][1], qr[0], z16, 0, 0, 0); \
            _Pragma("unroll") for (int d0 = 1; d0 < 4; ++d0) { \
                p0 = __builtin_amdgcn_mfma_f32_32x32x16_bf16(kf[d0][0], qr[d0], p0, 0, 0, 0); p1 = __builtin_amdgcn_mfma_f32_32x32x16_bf16(kf[d0][1], qr[d0], p1, 0, 0, 0); } } \
        float sacc = 0.f; \
        _Pragma("unroll") for (int r = 0; r < 16; ++r) { p0[r] = __builtin_amdgcn_exp2f(p0[r]); sacc += p0[r]; } \
        l += sacc; \
        _Pragma("unroll") for (int i = 0; i < 4; ++i) { pw[0][i] = cvt_pk_bf16(p0[2 * i], p0[2 * i + 1]); pw[1][i] = cvt_pk_bf16(p0[8 + 2 * i], p0[9 + 2 * i]); } } while (0)
#define ATT_VLD2(dst, db, k0) do { _Pragma("unroll") for (int kk = 0; kk < 2; ++kk) { \
            const v4i16_t lo = vtr(sb + vofs + (db) * 4096 + ((k0) + kk) * 1024), hh = vtr(sb + vofs + (db) * 4096 + ((k0) + kk) * 1024 + 512); \
            dst[(db) * 2 + kk] = (bf16x8){lo[0], lo[1], lo[2], lo[3], hh[0], hh[1], hh[2], hh[3]}; } } while (0)
#define ATT_PV(t, slot) do { const LAS unsigned char* sb = lds + (slot); bf16x8 h1[8], h2[8]; \
        if ((t) == cw - 2 && (t) > 0) { _Pragma("unroll") for (int db = 0; db < 4; ++db) o[db] = o[db] * ffar; } \
        _Pragma("unroll") for (int db = 0; db < 4; ++db) ATT_VLD2(h1, db, 0); \
        _Pragma("unroll") for (int db = 0; db < 4; ++db) ATT_VLD2(h2, db, 2); \
        _Pragma("unroll") for (int db = 0; db < 4; ++db) { o[db] = __builtin_amdgcn_mfma_f32_32x32x16_bf16(__builtin_bit_cast(bf16x8, pw[0]), h1[db * 2], o[db], 0, 0, 0); \
                                                         o[db] = __builtin_amdgcn_mfma_f32_32x32x16_bf16(__builtin_bit_cast(bf16x8, pw[1]), h1[db * 2 + 1], o[db], 0, 0, 0); } \
        float sacc = 0.f; \
        _Pragma("unroll") for (int r = 0; r < 16; ++r) { p1[r] = __builtin_amdgcn_exp2f(p1[r]); sacc += p1[r]; } \
        l += sacc; \
        _Pragma("unroll") for (int i = 0; i < 4; ++i) { pw[2][i] = cvt_pk_bf16(p1[2 * i], p1[2 * i + 1]); pw[3][i] = cvt_pk_bf16(p1[8 + 2 * i], p1[9 + 2 * i]); } \
        _Pragma("unroll") for (int db = 0; db < 4; ++db) { o[db] = __builtin_amdgcn_mfma_f32_32x32x16_bf16(__builtin_bit_cast(bf16x8, pw[2]), h2[db * 2], o[db], 0, 0, 0); \
                                                         o[db] = __builtin_amdgcn_mfma_f32_32x32x16_bf16(__builtin_bit_cast(bf16x8, pw[3]), h2[db * 2 + 1], o[db], 0, 0, 0); } } while (0)
#define ATT_WAIT_A(s_) do { if ((s_) + 1 < NT) asm volatile("s_waitcnt vmcnt(4) lgkmcnt(0)\n\ts_barrier" ::: "memory"); else asm volatile("s_waitcnt vmcnt(0) lgkmcnt(0)\n\ts_barrier" ::: "memory"); } while (0)
#define ATT_BAR_B() asm volatile("s_waitcnt lgkmcnt(0)\n\ts_barrier" ::: "memory")
    asm volatile(".p2align 8" ::: "memory");
    if (!grpY) {
        for (int s = 0; s <= NT; ++s) {
            ATT_WAIT_A(s);
            if (s < NT && s <= cw) ATT_QKEXP(s, sl_cur);
            ATT_BAR_B();
            if (s + 2 < NT) ATT_DMA(s + 2, sl_nn);
            if (s < NT && s <= cw) ATT_PV(s, sl_cur);
            sl_prev = sl_cur; sl_cur = (sl_cur == 3 * SLOT) ? 0 : sl_cur + SLOT; sl_nn = (sl_nn == 3 * SLOT) ? 0 : sl_nn + SLOT;
        }
    } else {
        for (int s = 0; s <= NT; ++s) {
            ATT_WAIT_A(s);
            if (s >= 1 && s - 1 <= cw) ATT_PV(s - 1, sl_prev);
            ATT_BAR_B();
            if (s + 2 < NT) ATT_DMA(s + 2, sl_nn);
            if (s < NT && s <= cw) ATT_QKEXP(s, sl_cur);
            sl_prev = sl_cur; sl_cur = (sl_cur == 3 * SLOT) ? 0 : sl_cur + SLOT; sl_nn = (sl_nn == 3 * SLOT) ? 0 : sl_nn + SLOT;
        }
    }
#undef ATT_WAIT_A
#undef ATT_BAR_B
#undef ATT_QKEXP
#undef ATT_PV
#undef ATT_VLD2
#undef ATT_SGB
#undef ATT_DMA
    l += __shfl_xor(l, 32);
    asm volatile("s_waitcnt vmcnt(0) lgkmcnt(0)\n\ts_barrier" ::: "memory");
    {   LAS float* st = (LAS float*)(lds + wid * STG_BYTES);
#pragma unroll
        for (int db = 0; db < 4; ++db)
#pragma unroll
            for (int r = 0; r < 16; ++r) st[crow(r, hi) * STG_STRIDE + db * 32 + r32] = o[db][r];
        if (hi == 0) ((LAS float*)(lds + LLS_OFF))[wid * 32 + r32] = l;
    }
    asm volatile("s_waitcnt lgkmcnt(0)\n\ts_barrier" ::: "memory");
    {   const int rsel = comp * 16 + (lane >> 2), quarter = lane & 3;
        const LAS float* s1 = (const LAS float*)(lds + (pair * 2) * STG_BYTES) + rsel * STG_STRIDE + quarter * 32;
        const LAS float* s2 = (const LAS float*)(lds + (pair * 2 + 1) * STG_BYTES) + rsel * STG_STRIDE + quarter * 32;
        const LAS float* ls = (const LAS float*)(lds + LLS_OFF);
        const float i1 = 1.f / ls[(pair * 2) * 32 + rsel], i2 = lam / ls[(pair * 2 + 1) * 32 + rsel];
        f32x4 v[8]; float ss = 0.f;
#pragma unroll
        for (int c = 0; c < 8; ++c) { v[c] = *(const LAS f32x4*)(s1 + c * 4) * i1 - *(const LAS f32x4*)(s2 + c * 4) * i2; ss += dot4(v[c]); }
        ss += __shfl_xor(ss, 1); ss += __shfl_xor(ss, 2);
        const float rstd = rsqrtf(ss * (1.f / 128.f) + EPS) * (1.f - LAM_INIT);
        bf16_t* op = AO + (size_t)(rowbase + myrow0 + rsel - comp * 16 + comp * 16) * DM + h * 128 + quarter * 32;
#pragma unroll
        for (int c = 0; c < 4; ++c) { const f32x4 g0 = *(const f32x4*)(g_subln + quarter * 32 + c * 8), g1 = *(const f32x4*)(g_subln + quarter * 32 + c * 8 + 4);
            *(u32x4*)(op + c * 8) = pack8(v[2 * c] * rstd * g0, v[2 * c + 1] * rstd * g1); }
    }
    asm volatile("s_waitcnt lgkmcnt(0)\n\ts_barrier" ::: "memory");
}
}

__device__ __forceinline__ void p2_conv(Frame& F, const Args& a) {
    unsigned char* ws = F.ws; const int lane = lane_id(), c0 = lane * 16;
    const bf16_t* CU = (const bf16_t*)(ws + WS_D); const bf16_t* GB = (const bf16_t*)(ws + WS_C) + (size_t)M * 1024; bf16_t* AO = (bf16_t*)(ws + WS_A);
    const float* conv_w = a.in[12]; const float* conv_b = a.in[13]; const float* g_conv = a.in[14];
    f32x4 w0[4], w1[4], w2[4], cb[4], gc[4];
#pragma unroll
    for (int i = 0; i < 4; ++i) { w0[i] = *(const f32x4*)(conv_w + c0 + i * 4); w1[i] = *(const f32x4*)(conv_w + 1024 + c0 + i * 4); w2[i] = *(const f32x4*)(conv_w + 2048 + c0 + i * 4);
        cb[i] = *(const f32x4*)(conv_b + c0 + i * 4); gc[i] = *(const f32x4*)(g_conv + c0 + i * 4); }
    const int gw = F.vcu * NWAVES + F.wave, NGW = F.G * NWAVES;
    for (int row = gw; row < M; row += NGW) {
        const int s = row & (SEQ - 1);
        const u32x4 zz = (u32x4){0u, 0u, 0u, 0u};
        u32x4 x0[2], x1[2], x2[2], gb[2];
#pragma unroll
        for (int i = 0; i < 2; ++i) { x0[i] = *(const u32x4*)(CU + (size_t)row * 1024 + c0 + i * 8); gb[i] = *(const u32x4*)(GB + (size_t)row * 1024 + c0 + i * 8);
            x1[i] = s >= 1 ? *(const u32x4*)(CU + (size_t)(row - 1) * 1024 + c0 + i * 8) : zz; x2[i] = s >= 2 ? *(const u32x4*)(CU + (size_t)(row - 2) * 1024 + c0 + i * 8) : zz; }
        f32x4 z[4]; float ss = 0.f;
#pragma unroll
        for (int i = 0; i < 4; ++i) { const int q = i >> 1;
            const f32x4 a0 = (i & 1) ? g8::bf4lo(x0[q].z, x0[q].w) : g8::bf4lo(x0[q].x, x0[q].y), a1 = (i & 1) ? g8::bf4lo(x1[q].z, x1[q].w) : g8::bf4lo(x1[q].x, x1[q].y);
            const f32x4 a2 = (i & 1) ? g8::bf4lo(x2[q].z, x2[q].w) : g8::bf4lo(x2[q].x, x2[q].y), g = (i & 1) ? g8::bf4lo(gb[q].z, gb[q].w) : g8::bf4lo(gb[q].x, gb[q].y);
            z[i] = g * (w2[i] * a0 + w1[i] * a1 + w0[i] * a2 + cb[i]); ss += dot4(z[i]); }
        ss += __shfl_xor(ss, 1); ss += __shfl_xor(ss, 2); ss += __shfl_xor(ss, 4);
        const float r = rsqrtf(ss * (1.f / 128.f) + EPS);
        *(u32x4*)(AO + (size_t)row * DM + 1024 + c0) = pack8(z[0] * r * gc[0], z[1] * r * gc[1]);
        *(u32x4*)(AO + (size_t)row * DM + 1024 + c0 + 8) = pack8(z[2] * r * gc[2], z[3] * r * gc[3]);
    }
}
__device__ __forceinline__ void p2_attention(Frame& F, const Args& a) {
    unsigned char* ws = F.ws; const int tid = F.wave * 64 + lane_id();
    const bf16_t* Qb = (const bf16_t*)(ws + WS_B); const bf16_t* Kb = Qb + (size_t)M * 1024; const bf16_t* Vb = (const bf16_t*)(ws + WS_C); bf16_t* AO = (bf16_t*)(ws + WS_A);
    const int bh = F.vcu >> 3, j = F.vcu & 7, b = bh >> 3, h = bh & 7;
    if (bh >= BATCH * NH) return;
    const float lam = ((const float*)(ws + WS_LAM))[0];
    { LAS float* bt = (LAS float*)(F.lds + LBT_OFF); const float* BT = (const float*)(ws + WS_BT) + h * BT_N; if (tid < BT_N) bt[tid] = BT[tid]; }
    asm volatile("s_waitcnt vmcnt(0) lgkmcnt(0)\n\ts_barrier" ::: "memory");
    for (int i = 0; i < 4; ++i) { const int qb = (i == 0) ? 31 - j : (i == 1) ? 16 + j : (i == 2) ? 15 - j : j;
        att::attn_unit(b, h, qb, Qb, Kb, Vb, AO, a.in[11], lam, F.lds, F.wave); }
}

__device__ __forceinline__ void p5_route(Frame& F, const Args& a) {
    unsigned char* ws = F.ws; const int lane = lane_id();
    const float* PART = (const float*)(ws + WS_PART); const float* SSQ = (const float*)(ws + WS_SSQ);
    const float* b_group = a.in[18]; const float* b_expert = a.in[20];
    float* RS1 = (float*)(ws + WS_RS1); int* TE = (int*)(ws + WS_TE); float* TW = (float*)(ws + WS_TW); unsigned* CNT = (unsigned*)(ws + WS_CNT); int* LIST = (int*)(ws + WS_LIST);
    for (int row = (F.vcu * NWAVES + F.wave) * 64 + lane; row < M; row += F.G * NTHR) {
        float ss = 0.f;
#pragma unroll
        for (int i = 0; i < 8; ++i) { const f32x4 v = *(const f32x4*)(SSQ + (size_t)row * 32 + i * 4); ss += (v[0] + v[1]) + (v[2] + v[3]); }
        const float rs = rsqrtf(ss * (1.f / DM) + EPS);
        f32x4 gl = (f32x4){0.f, 0.f, 0.f, 0.f};
#pragma unroll
        for (int ks = 0; ks < 4; ++ks) gl = gl + *(const f32x4*)(PART + ((size_t)ks * M + row) * 64);
        int gi = 0; float gm = -1e30f; float glv[4];
#pragma unroll
        for (int g = 0; g < 4; ++g) { glv[g] = gl[g] * rs + b_group[g]; if (glv[g] > gm) { gm = glv[g]; gi = g; } }
        float den = 0.f;
#pragma unroll
        for (int g = 0; g < 4; ++g) den += expf(glv[g] - gm);
        const float pg = 1.f / den;
        f32x4 e0 = (f32x4){0.f, 0.f, 0.f, 0.f}, e1 = e0;
#pragma unroll
        for (int ks = 0; ks < 4; ++ks) { const float* pp = PART + ((size_t)ks * M + row) * 64 + 4 + gi * 8; e0 = e0 + *(const f32x4*)pp; e1 = e1 + *(const f32x4*)(pp + 4); }
        float v0 = -1e30f, v1 = -1e30f; int i0 = 0, i1 = 0;
#pragma unroll
        for (int e = 0; e < 8; ++e) { const float v = (e < 4 ? e0[e & 3] : e1[e & 3]) * rs + b_expert[gi * 8 + e];
            if (v > v0) { v1 = v0; i1 = i0; v0 = v; i0 = e; } else if (v > v1) { v1 = v; i1 = e; } }
        const float ex = expf(v1 - v0), w0 = pg / (1.f + ex), w1 = pg * ex / (1.f + ex);
        const int x0 = gi * 8 + i0, x1 = gi * 8 + i1;
        RS1[row] = rs; TE[row * 2] = x0; TE[row * 2 + 1] = x1; TW[row * 2] = w0; TW[row * 2 + 1] = w1;
        float* LRS = (float*)(ws + WS_LRS); float* LTW = (float*)(ws + WS_LTW);
        const unsigned p0 = atomicAdd(&CNT[x0], 1u); LIST[(size_t)x0 * M + p0] = row * 2; LRS[(size_t)x0 * M + p0] = rs; LTW[(size_t)x0 * M + p0] = w0;
        const unsigned p1 = atomicAdd(&CNT[x1], 1u); LIST[(size_t)x1 * M + p1] = row * 2 + 1; LRS[(size_t)x1 * M + p1] = rs; LTW[(size_t)x1 * M + p1] = w1;
    }
}
__device__ __forceinline__ g8::MoeTab moe_tables(Frame& F) {
    LAS int* tab = (LAS int*)(F.lds + LTAB_OFF); const int tid = F.wave * 64 + lane_id();
    const unsigned* CNT = (const unsigned*)(F.ws + WS_CNT);
    __syncthreads();
    if (tid < 32) tab[384 + tid] = (int)__hip_atomic_load(CNT + tid, __ATOMIC_RELAXED, __HIP_MEMORY_SCOPE_AGENT);
    __syncthreads();
    if (tid == 0) { int nt = 0;
        for (int e = 0; e < NE; ++e) { const int n = tab[384 + e]; for (int r = 0; r < n && nt < 192; r += 256) { tab[nt] = e; tab[192 + nt] = r; ++nt; } }
        tab[416] = nt; }
    __syncthreads();
    g8::MoeTab T; T.texp = tab; T.trow0 = tab + 192; T.tcnt = tab + 384; T.ntile = tab[416];
    return T;
}
__device__ __forceinline__ void p7_combine(Frame& F) {
    unsigned char* ws = F.ws;
    bf16_t* H = (bf16_t*)(ws + WS_B); const bf16_t* Y0 = (const bf16_t*)(ws + WS_A); const bf16_t* Y1 = (const bf16_t*)(ws + WS_D); float* RS2 = (float*)(ws + WS_RS2); unsigned char* H28 = ws + WS_H28;
    const int gw = F.vcu * NWAVES + F.wave, NGW = F.G * NWAVES, lane = lane_id();
    for (int row = gw; row < M; row += NGW) {
        float ss = 0.f;
#pragma unroll
        for (int j = 0; j < 4; ++j) { const size_t o = (size_t)row * DM + j * 512 + lane * 8;
            const u32x4 hv = *(const u32x4*)(H + o); const u32x2 y0 = *(const u32x2*)((const unsigned char*)Y0 + o), y1 = *(const u32x2*)((const unsigned char*)Y1 + o);
            const f32x4 a = g8::bf4lo(hv.x, hv.y) + (unpack4_fp8(y0.x) + unpack4_fp8(y1.x)) * (1.f / F8_Y), b = g8::bf4lo(hv.z, hv.w) + (unpack4_fp8(y0.y) + unpack4_fp8(y1.y)) * (1.f / F8_Y);
            ss += dot4(a) + dot4(b);
            *(u32x4*)(H + o) = pack8(a, b);
            u32x2 w8; w8.x = pack4_fp8(a, F8_H); w8.y = pack4_fp8(b, F8_H); *(u32x2*)(H28 + o) = w8; }
        ss = wave_sum(ss);
        if (lane == 0) RS2[row] = rsqrtf(ss * (1.f / DM) + EPS);
    }
}

__global__ void __launch_bounds__(NTHR, 2) mk_fwd(Args args) {
    extern __shared__ __attribute__((aligned(16))) unsigned char lds_raw[];
    Frame F;
    F.lds = (LAS unsigned char*)lds_raw; F.MISC = (volatile LAS unsigned*)(F.lds + LCTL_OFF); F.ws = args.ws;
    F.wave = __builtin_amdgcn_readfirstlane(threadIdx.x >> 6);
    F.G = gridDim.x; { const int bx = blockIdx.x; F.vcu = (F.G % 8 == 0) ? (bx % 8) * (F.G / 8) + bx / 8 : bx; }
    unsigned char* ws = args.ws;
    if (threadIdx.x < 32) F.MISC[threadIdx.x] = 0u;
    __syncthreads();
    XcdBarrier bar = xcd_barrier_post((unsigned*)(ws + WS_BAR) + args.li * XCD_BAR_WORDS, F.MISC + 8);
    const int lo = args.ph_lo, hi = args.ph_hi;
#define IN(k) (lo <= (k) && (k) < hi)
#define SEAM(k) do { if (IN(k) && IN((k) + 1)) xcd_barrier(bar); } while (0)

    bf16_t* XB = (bf16_t*)(ws + WS_A); bf16_t* AO = XB;
    bf16_t* Qb = (bf16_t*)(ws + WS_B); bf16_t* Kb = Qb + (size_t)M * 1024; bf16_t* H = Qb;
    bf16_t* Vb = (bf16_t*)(ws + WS_C); bf16_t* GB = Vb + (size_t)M * 1024;
    bf16_t* CU = (bf16_t*)(ws + WS_D);
    bf16_t* PP = (bf16_t*)(ws + WS_E); bf16_t* PB = (bf16_t*)(ws + WS_PB);
    float* RS0 = (float*)(ws + WS_RS0); float* RS2 = (float*)(ws + WS_RS2);

    if (IN(0)) { p0_prologue(F, args); } SEAM(0);

    if (IN(1)) {
        g8::DenseSched S; S.init(XB, DM * 2, ws + WS_WIN, DM * 2, M, 6144, F.G, (int)blockIdx.x);
        g8::EpiProj E{RS0, args.in[5], args.in[6], Qb, Kb, Vb, GB, CU};
        g8::gemm_phase<g8::EpiProj, g8::DenseSched>(F.lds, F.wave, DM, S, E);
    } SEAM(1);

    if (IN(2)) { p2_conv(F, args); p2_attention(F, args); } SEAM(2);

    if (IN(3)) {
        g8::DenseSched S; S.init(AO, DM * 2, ws + WS_WO, DM * 2, M, DM, F.G, (int)blockIdx.x);
        g8::EpiRes E{args.in[0], H, (float*)(ws + WS_SSQ), ws + WS_H8};
        g8::gemm_phase<g8::EpiRes, g8::DenseSched>(F.lds, F.wave, DM, S, E);
    } SEAM(3);

    if (IN(4)) {
        g8::KSplitSched S{(const char*)H, (const char*)(ws + WS_WR), F.G, (int)blockIdx.x};
        g8::EpiRouter E{(float*)(ws + WS_PART)};
        g8::gemm_phase<g8::EpiRouter, g8::KSplitSched>(F.lds, F.wave, 512, S, E);
    } SEAM(4);

    if (IN(5)) { p5_route(F, args); } SEAM(5);

    if (IN(6)) {
        const g8::MoeTab T = moe_tables(F);
        g8::UpSched S{(const char*)(ws + WS_H8), (const char*)(ws + WS_WUP), (const int*)(ws + WS_LIST), T, F.G, F.vcu};
        g8::EpiUp E{(const float*)(ws + WS_LRS), Vb  , T};
        g8::gemm_phase<g8::EpiUp, g8::UpSched, true>(F.lds, F.wave, DM, S, E, E8_W, E8_H);
    } SEAM(6);

    if (IN(7)) {
        const g8::MoeTab T = moe_tables(F);
        g8::DnSched S{(const char*)Vb, (const char*)(ws + WS_WDN), T, F.G, F.vcu};
        g8::EpiDn E{(const int*)(ws + WS_LIST), (const float*)(ws + WS_LTW), XB  , CU  , T};
        int kdff = DFF; asm volatile("" : "+s"(kdff));
        g8::gemm_phase<g8::EpiDn, g8::DnSched, true>(F.lds, F.wave, kdff, S, E, E8_W, E8_HID);
    } SEAM(7);

    if (IN(8)) { p7_combine(F); } SEAM(8);

    if (IN(9)) {
        { g8::DenseSched S; S.init(PB, PLE * 2, ws + WS_WP, PLE * 2, M, DM, F.G, (int)blockIdx.x);
          g8::EpiBf16 E{PP, DM};
          int kple = PLE; asm volatile("" : "+s"(kple));
          g8::gemm_phase<g8::EpiBf16, g8::DenseSched>(F.lds, F.wave, kple, S, E);
          asm volatile("s_waitcnt vmcnt(0)" ::: "memory"); __syncthreads(); }
        g8::DenseSched S; S.init(ws + WS_H28, DM, ws + WS_WG, DM, M, DM, F.G, (int)blockIdx.x);
        g8::EpiFinal E{H, PP, RS2, args.out};
        g8::gemm_phase<g8::EpiFinal, g8::DenseSched, true>(F.lds, F.wave, DM, S, E, E8_W, E8_H);
    }
#undef IN
#undef SEAM
}


static int mk_grid = 0;
static void launch_mk(Args a, int lo, int hi, int li, hipStream_t stream) {
    a.ph_lo = lo; a.ph_hi = hi; a.li = li; a.pad = 0;
    hipLaunchKernelGGL(mk_fwd, dim3(mk_grid), dim3(NTHR), LDS_BYTES, stream, a);
}

extern "C" void kernel_launch(void* const* d_in, const int* in_sizes, int n_in, void* d_out, int out_size, void* d_ws, size_t ws_size, hipStream_t stream) {
    if (n_in != 27 || ws_size < WS_END) { fprintf(stderr, "kernel_launch: unexpected n_in %d / ws %zu\n", n_in, ws_size); return; }
    if (mk_grid == 0) {
        int dev = 0, cus = 0;
        (void)hipGetDevice(&dev); (void)hipDeviceGetAttribute(&cus, hipDeviceAttributeMultiprocessorCount, dev);
        (void)hipFuncSetAttribute((const void*)mk_fwd, hipFuncAttributeMaxDynamicSharedMemorySize, LDS_BYTES);
        int per_cu = 0; (void)hipOccupancyMaxActiveBlocksPerMultiprocessor(&per_cu, (const void*)mk_fwd, NTHR, LDS_BYTES); (void)hipGetLastError();
        mk_grid = 256;
        if (cus != 256 || per_cu < 1) fprintf(stderr, "kernel_launch: note: %d CUs, occupancy query %d; built for 256 CUs x 1 workgroup\n", cus, per_cu);
    }
    float* out = (float*)d_out; unsigned char* ws = (unsigned char*)d_ws;
    (void)in_sizes; (void)out_size;
    (void)hipMemsetAsync(ws + WS_CTL, 0, 1 * MiB, stream);
    Args a{};
    for (int i = 0; i < 27; ++i) a.in[i] = (const float*)d_in[i];
    a.out = out; a.ws = ws;
    launch_mk(a, 0, 10, 0, stream);
}
```

```cpp
#include <hip/hip_runtime.h>
#include <cstdint>
#include <cstdio>

typedef unsigned short bf16_t;
typedef float f32x4 __attribute__((ext_vector_type(4)));

constexpr int BATCH = 4, SEQ = 4096, DM = 2048, M = BATCH * SEQ;
constexpr int NH = 8, DQK = 64, DV = 128, DATT = 1024, DCONV = 1024;
constexpr int NE = 32, NG = 4, EPG = 8, DFF = 512, PLE = 256;
constexpr float EPS = 1e-6f;
constexpr float LOG2E = 1.4426950408889634f;
constexpr float LAM_INIT = 0.2f;
constexpr int BT_N = 320;

constexpr size_t MiB = 1u << 20;
constexpr size_t WS_CTL = 0;
constexpr size_t WS_BT = 64 * 1024;
constexpr size_t WS_LAM = WS_BT + 16 * 1024;
constexpr size_t WS_CNT = 128 * 1024;
constexpr size_t WS_W = 1 * MiB;
constexpr size_t WS_A = 236 * MiB;
constexpr size_t WS_B = 300 * MiB;
constexpr size_t WS_C = 364 * MiB;
constexpr size_t WS_D = 428 * MiB;
constexpr size_t WS_E = 492 * MiB;
constexpr size_t WS_PB = 556 * MiB;
constexpr size_t WS_SM = 564 * MiB;
constexpr size_t WS_RS0 = WS_SM, WS_RS1 = WS_SM + 64 * 1024, WS_RS2 = WS_SM + 128 * 1024;
constexpr size_t WS_TE = WS_SM + 192 * 1024;
constexpr size_t WS_TW = WS_SM + 320 * 1024;
constexpr size_t WS_LIST = WS_SM + 1 * MiB;
constexpr size_t WS_END = 576 * MiB;

__device__ __forceinline__ float bf2f(bf16_t v) { return __uint_as_float((unsigned)v << 16); }
__device__ __forceinline__ bf16_t f2bf(float f) { unsigned u = __float_as_uint(f); return (bf16_t)((u + 0x7fffu + ((u >> 16) & 1u)) >> 16); }

__device__ __forceinline__ int rel_bucket(int rel) {
    int ret = rel > 0 ? 16 : 0; int n = rel < 0 ? -rel : rel;
    if (n < 8) return ret + n;
    int l = 31 - __clz(n * n) + 2; if (l > 15) l = 15;
    return ret + l;
}

__device__ __forceinline__ float block_sum(float v, float* red) {
    for (int o = 32; o > 0; o >>= 1) v += __shfl_xor(v, o);
    const int w = threadIdx.x >> 6, nw = blockDim.x >> 6;
    __syncthreads();
    if ((threadIdx.x & 63) == 0) red[w] = v;
    __syncthreads();
    float s = 0.f; for (int i = 0; i < nw; ++i) s += red[i];
    return s;
}


#define GAS __attribute__((address_space(1)))
#define LAS __attribute__((address_space(3)))
typedef short bf16x8 __attribute__((ext_vector_type(8)));
typedef unsigned u32x4 __attribute__((ext_vector_type(4)));
typedef unsigned u32x2 __attribute__((ext_vector_type(2)));
typedef float f32x16 __attribute__((ext_vector_type(16)));
typedef GAS unsigned gu32;
#define RLX_AGENT __ATOMIC_RELAXED, __HIP_MEMORY_SCOPE_AGENT

constexpr int NWAVES = 8, NTHR = 512;
constexpr int RING_BYTES = 131072;
constexpr int LCTL_OFF = 145408;
constexpr int LBT_OFF = LCTL_OFF + 128;
constexpr int LLS_OFF = LBT_OFF + 1280;
constexpr int LTAB_OFF = LCTL_OFF + 128;
constexpr int LDS_BYTES = 149504;
static_assert(LLS_OFF + 1024 <= LDS_BYTES && LTAB_OFF + (192 + 192 + 32) * 4 <= LDS_BYTES, "LDS map");

constexpr size_t WS_BAR = 256 * 1024;
constexpr size_t WS_WIN = WS_W;
constexpr size_t WS_WO = WS_WIN + 24 * MiB;
constexpr size_t WS_WG = WS_WO + 8 * MiB;
constexpr size_t WS_WP = WS_WG + 8 * MiB;
constexpr size_t WS_WUP = WS_WP + 1 * MiB;
constexpr size_t WS_WDN = WS_WUP + 128 * MiB;
constexpr size_t WS_WR = WS_WDN + 64 * MiB;
static_assert(WS_WR + 1 * MiB <= WS_A, "weight region");
constexpr size_t WS_LRS = WS_SM + 6 * MiB, WS_LTW = WS_SM + 8 * MiB;
constexpr size_t WS_SSQ = WS_SM + 4 * MiB;
constexpr size_t WS_H8 = WS_E + 32 * MiB;
constexpr size_t WS_H28 = WS_C + 32 * MiB;
constexpr size_t WS_PART = WS_E;

__device__ __forceinline__ int lane_id() { return (int)__builtin_amdgcn_mbcnt_hi(~0u, __builtin_amdgcn_mbcnt_lo(~0u, 0u)); }
__device__ __forceinline__ int lane_id_fresh() { unsigned z = 0u; asm volatile("" : "+v"(z)); return (int)__builtin_amdgcn_mbcnt_hi(~0u, __builtin_amdgcn_mbcnt_lo(~0u, z)); }
typedef float f32x2_t __attribute__((ext_vector_type(2))); typedef __bf16 bf16x2_t __attribute__((ext_vector_type(2)));
__device__ __forceinline__ unsigned cvt_pk_bf16(float lo, float hi) { const f32x2_t v = {lo, hi}; const bf16x2_t b = __builtin_convertvector(v, bf16x2_t); return __builtin_bit_cast(unsigned, b); }
typedef int v8i_t __attribute__((ext_vector_type(8)));
typedef int v4i_t __attribute__((ext_vector_type(4)));
__device__ __forceinline__ unsigned pack4_fp8(f32x4 v, float sc) {
    int w = 0;
    const float a = __builtin_amdgcn_fmed3f(v[0] * sc, -448.f, 448.f), b = __builtin_amdgcn_fmed3f(v[1] * sc, -448.f, 448.f);
    const float c = __builtin_amdgcn_fmed3f(v[2] * sc, -448.f, 448.f), d = __builtin_amdgcn_fmed3f(v[3] * sc, -448.f, 448.f);
    w = __builtin_amdgcn_cvt_pk_fp8_f32(a, b, w, false); w = __builtin_amdgcn_cvt_pk_fp8_f32(c, d, w, true);
    return (unsigned)w;
}
__device__ __forceinline__ f32x4 unpack4_fp8(unsigned w) { const int iw = (int)w;
    return (f32x4){__builtin_amdgcn_cvt_f32_fp8(iw, 0), __builtin_amdgcn_cvt_f32_fp8(iw, 1), __builtin_amdgcn_cvt_f32_fp8(iw, 2), __builtin_amdgcn_cvt_f32_fp8(iw, 3)}; }
constexpr float F8_W = 256.f, F8_H = 16.f, F8_HID = 8.f, F8_Y = 32.f;
constexpr int E8_W = 0x77777777, E8_H = 0x7b7b7b7b, E8_HID = 0x7c7c7c7c;
__device__ __forceinline__ float fast_sigmoid(float z) { return __builtin_amdgcn_rcpf(1.f + __builtin_amdgcn_exp2f(-LOG2E * z)); }

__device__ __forceinline__ u32x4 pack8(f32x4 a, f32x4 b) { u32x4 w; w.x = cvt_pk_bf16(a[0], a[1]); w.y = cvt_pk_bf16(a[2], a[3]); w.z = cvt_pk_bf16(b[0], b[1]); w.w = cvt_pk_bf16(b[2], b[3]); return w; }
__device__ __forceinline__ float dot4(f32x4 a) { return (a[0] * a[0] + a[1] * a[1]) + (a[2] * a[2] + a[3] * a[3]); }

#define XB_TMO      128
#define XB_XCNT(j)  (256  + 64 * (j))
#define XB_XSUB(j)  (1280 + 64 * (j))
#define XB_XGEN(j)  (2304 + 64 * (j))
#define XB_TOP      3328
#define XB_TOPGEN   3392
#define XCD_BAR_WORDS 3456
#define XB_SPIN_CAP (1u << 18)
__device__ __forceinline__ unsigned xb_ld(unsigned* p)              { return __hip_atomic_load(p, __ATOMIC_RELAXED, __HIP_MEMORY_SCOPE_AGENT); }
__device__ __forceinline__ unsigned xb_add(unsigned* p, unsigned v) { return __hip_atomic_fetch_add(p, v, __ATOMIC_RELAXED, __HIP_MEMORY_SCOPE_AGENT); }
__device__ __forceinline__ unsigned xb_xcc_id() { return (unsigned)__builtin_amdgcn_s_getreg((3 << 11) | 20) & 0xFu; }
#define XB_SPIN(cond, bar) do { unsigned _sp = 0; while (cond) { __builtin_amdgcn_s_sleep(1); \
    if ((++_sp & 255u) == 0u) { if (xb_ld(&(bar)[XB_TMO])) break; if (_sp > XB_SPIN_CAP) { atomicAdd(&(bar)[XB_TMO], 1u); break; } } } } while (0)
struct XcdBarrier { unsigned* bar; unsigned x; volatile LAS unsigned* st; };
__device__ __forceinline__ XcdBarrier xcd_barrier_post(unsigned* bar, volatile LAS unsigned* st) {
    XcdBarrier b; b.bar = bar; b.x = xb_xcc_id(); b.st = st;
    if (threadIdx.x == 0) (void)xb_add(&bar[XB_XCNT(b.x)], 1u);
    return b;
}
__device__ __forceinline__ void xcd_barrier_complete(unsigned* bar, unsigned x, unsigned& nloc, unsigned& nx) {
    const unsigned G = gridDim.x * gridDim.y * gridDim.z;
    unsigned sum, cnt, mine, sp = 0u;
    for (;;) {
        sum = 0u; cnt = 0u; mine = 0u;
#pragma unroll
        for (unsigned j = 0; j < 16; ++j) { const unsigned c = xb_ld(&bar[XB_XCNT(j)]); sum += c; cnt += (c > 0u) ? 1u : 0u; mine = (j == x) ? c : mine; }
        if (sum == G) break;
        __builtin_amdgcn_s_sleep(1);
        if ((++sp & 255u) == 0u) { if (xb_ld(&bar[XB_TMO])) break; if (sp > XB_SPIN_CAP) { atomicAdd(&bar[XB_TMO], 1u); break; } }
    }
    nloc = mine > 0u ? mine : 1u; nx = cnt > 0u ? cnt : 1u;
}
__device__ __forceinline__ void xcd_barrier(const XcdBarrier& b) {
    asm volatile("s_waitcnt vmcnt(0)" ::: "memory");
    __syncthreads();
    if (threadIdx.x == 0) {
        unsigned* bar = b.bar;
        __builtin_amdgcn_s_waitcnt(0);
        unsigned nloc = b.st[0], nx = b.st[1];
        if (nloc == 0u) { xcd_barrier_complete(bar, b.x, nloc, nx); b.st[0] = nloc; b.st[1] = nx; }
        const unsigned old = xb_add(&bar[XB_XSUB(b.x)], 1u);
        const unsigned gen = old / nloc;
        if (old + 1u == (gen + 1u) * nloc) {
            __builtin_amdgcn_fence(__ATOMIC_RELEASE, "agent");
            asm volatile("s_waitcnt vmcnt(0)" ::: "memory");
            const unsigned og = xb_add(&bar[XB_TOP], 1u);
            const unsigned tg = og / nx;
            if (og + 1u == (tg + 1u) * nx) xb_add(&bar[XB_TOPGEN], 1u);
            else XB_SPIN(xb_ld(&bar[XB_TOPGEN]) == tg, bar);
            __builtin_amdgcn_fence(__ATOMIC_ACQUIRE, "agent");
            xb_add(&bar[XB_XGEN(b.x)], 1u);
            asm volatile("s_waitcnt vmcnt(0)" ::: "memory");
        } else {
            XB_SPIN(xb_ld(&bar[XB_XGEN(b.x)]) == gen, bar);
            __builtin_amdgcn_fence(__ATOMIC_ACQUIRE, "agent");
            asm volatile("s_waitcnt vmcnt(0)" ::: "memory");
        }
    }
    __syncthreads();
}

namespace g8 {
constexpr int BM = 256, BK = 64, HALF = 128, HTB = HALF * BK * 2, STAGE_BYTES = 8 * HTB;
static_assert(STAGE_BYTES == RING_BYTES, "ring");
__host__ __device__ __forceinline__ int lds_byte(int r, int c) { const int st = (r >> 4) * 2 + (c >> 5), rr = r & 15, cc = c & 31, ob = rr * 64 + cc * 2; return st * 1024 + (ob ^ (((ob >> 9) & 1) << 5)); }
__host__ __device__ __forceinline__ void stage_rc(int b, int& R, int& C) { const int st = b / 1024, sb = b % 1024, swz = sb ^ (((sb >> 9) & 1) << 5); R = (st >> 1) * 16 + swz / 64; C = (st & 1) * 32 + (swz % 64) / 2; }
struct Unit { int pm, pn, e; };

struct DenseSched {
    static constexpr bool GATHER = false;
    const char* A; const char* Bt; int lda, ldb; int nM, nN, nwg, G, c;
    __device__ __forceinline__ void init(const void* A_, int lda_, const void* Bt_, int ldb_, int Mrows, int N, int G_, int c_) { A = (const char*)A_; Bt = (const char*)Bt_; lda = lda_; ldb = ldb_; nM = Mrows / BM; nN = N / BM; nwg = nM * nN; G = G_; c = c_; }
    __device__ __forceinline__ bool next(int i, Unit& u) const {
        const long L = (long)i * G + c; if (L >= nwg) return false;
        int wgid = (int)L; { const int q = nwg / 8, r = nwg % 8, xcd = wgid % 8, off = wgid / 8; wgid = (xcd < r ? xcd * (q + 1) : r * (q + 1) + (xcd - r) * q) + off; }
        const int nig = 8 * nN, gid = wgid / nig, fm = gid * 8, gsz = (nM - fm) < 8 ? (nM - fm) : 8;
        u.pm = fm + ((wgid % nig) % gsz); u.pn = (wgid % nig) / gsz; u.e = 0; return true;
    }
    __device__ __forceinline__ const char* a_base(const Unit& u) const { return A + (size_t)u.pm * BM * lda; }
    __device__ __forceinline__ const char* b_base(const Unit& u) const { return Bt + (size_t)u.pn * BM * ldb; }
    __device__ __forceinline__ unsigned a_off(const Unit&, int row, int C) const { return (unsigned)(row * lda + C * 2); }
    __device__ __forceinline__ unsigned b_off(int row, int C) const { return (unsigned)(row * ldb + C * 2); }
};

template <class Epi, class Sched, bool F8 = false>
__device__ __forceinline__ void gemm_phase(LAS unsigned char* lds, const int wid, const int K, const Sched& S, const Epi& E, const int sclW = 0, const int sclA = 0) {
    const int lane = lane_id(), tid = wid * 64 + lane, wr = wid >> 2, wc = wid & 3, fr = lane & 15, fq = lane >> 4;
    const int nt = F8 ? K / 128 : K / BK;
    int Rr[2], Cc[2];
#pragma unroll
    for (int i = 0; i < 2; ++i) stage_rc(tid * 16 + i * 8192, Rr[i], Cc[i]);
    unsigned voffB[2];
#pragma unroll
    for (int i = 0; i < 2; ++i) voffB[i] = S.b_off(Rr[i], Cc[i]);
    const size_t kstep = (size_t)(BK * 2);
    const size_t hstepB = (size_t)S.b_off(HALF, 0);
    const unsigned ldsw = (unsigned)wid * 1024u;
    const int aoff = lds_byte(wr * 64 + fr, fq * 8), boff = lds_byte(wc * 32 + fr, fq * 8);
#define G8_SA(b, h) (((b) * 2 + (h)) * HTB)
#define G8_SB(b, h) ((4 + (b) * 2 + (h)) * HTB)
#define G8_STAGE(bufoff, gbase, voff) do { _Pragma("unroll") for (int _i = 0; _i < 2; ++_i) { unsigned _o = (voff)[_i]; asm volatile("" : "+v"(_o));     \
        __builtin_amdgcn_global_load_lds((const unsigned*)((const char*)(gbase) + _o), (LAS unsigned*)(lds + (bufoff) + ldsw + _i * 8192), 16, 0, 0); } } while (0)
#define G8_LD32(p) __builtin_shufflevector(*(const LAS v4i_t*)(p), *(const LAS v4i_t*)((p) + 1024), 0, 1, 2, 3, 4, 5, 6, 7)
#define G8_LDA(dst, b, h) do { _Pragma("unroll") for (int m = 0; m < 4; ++m) dst[m] = G8_LD32(lds + G8_SA(b, h) + aoff + m * 2048); } while (0)
#define G8_LDB(dst, b, h) do { _Pragma("unroll") for (int n = 0; n < 2; ++n) dst[n] = G8_LD32(lds + G8_SB(b, h) + boff + n * 2048); } while (0)
#define G8_LO(x) __builtin_bit_cast(bf16x8, __builtin_shufflevector(x, x, 0, 1, 2, 3))
#define G8_HI(x) __builtin_bit_cast(bf16x8, __builtin_shufflevector(x, x, 4, 5, 6, 7))
#define G8_MMA(ai, bj, At, Bt) do { __builtin_amdgcn_s_setprio(1); _Pragma("unroll") for (int m = 0; m < 4; ++m) _Pragma("unroll") for (int n = 0; n < 2; ++n) { \
        if constexpr (F8) acc[ai][bj][m][n] = __builtin_amdgcn_mfma_scale_f32_16x16x128_f8f6f4(Bt[n], At[m], acc[ai][bj][m][n], 0, 0, 0, sclW, 0, sclA); \
        else { acc[ai][bj][m][n] = __builtin_amdgcn_mfma_f32_16x16x32_bf16(G8_LO(Bt[n]), G8_LO(At[m]), acc[ai][bj][m][n], 0, 0, 0); \
               acc[ai][bj][m][n] = __builtin_amdgcn_mfma_f32_16x16x32_bf16(G8_HI(Bt[n]), G8_HI(At[m]), acc[ai][bj][m][n], 0, 0, 0); } } \
        __builtin_amdgcn_s_setprio(0); } while (0)
#define G8_WAIT_V(n) asm volatile("s_waitcnt vmcnt(" #n ")" ::: "memory")
#define G8_WAIT_L(n) asm volatile("s_waitcnt lgkmcnt(" #n ")" ::: "memory")
#define G8_BAR __builtin_amdgcn_s_barrier()
#define G8_SCHED __builtin_amdgcn_sched_barrier(0)
    Unit cur, nxt; int ui = 0;
    if (!S.next(0, cur)) return;
    f32x4 acc[2][2][4][2];
#pragma unroll
    for (int a = 0; a < 2; ++a)
#pragma unroll
        for (int b = 0; b < 2; ++b)
#pragma unroll
            for (int m = 0; m < 4; ++m)
#pragma unroll
                for (int n = 0; n < 2; ++n) acc[a][b][m][n] = (f32x4){0.f, 0.f, 0.f, 0.f};
    v8i_t At[4], B0[2], B1[2];
    unsigned cvA[2][2];
#define G8_NVSLOT ((LAS u32x4*)(lds + RING_BYTES) + (lane_id_fresh() + wid * 64))
#pragma unroll
    for (int h = 0; h < 2; ++h)
#pragma unroll
        for (int i = 0; i < 2; ++i) cvA[h][i] = S.a_off(cur, h * HALF + Rr[i], Cc[i]);
    const char* cA = S.a_base(cur); const char* cB = S.b_base(cur);
    G8_STAGE(G8_SB(0, 0), cB, voffB); G8_STAGE(G8_SB(0, 1), cB + hstepB, voffB); G8_STAGE(G8_SA(0, 0), cA, cvA[0]); G8_STAGE(G8_SA(0, 1), cA, cvA[1]);
    if (wr == 1) G8_BAR;
    G8_WAIT_V(2); G8_BAR;
    G8_STAGE(G8_SB(1, 0), cB + kstep, voffB); G8_STAGE(G8_SA(1, 0), cA + kstep, cvA[0]); G8_STAGE(G8_SB(1, 1), cB + hstepB + kstep, voffB);
    G8_WAIT_V(6); G8_BAR;
    LAS unsigned char* const metab = lds + RING_BYTES + 8192;
    for (;;) {
        E.meta_issue(cur, metab + (ui & 1) * 2048, wid);
        const bool has_next = S.next(ui + 1, nxt);
        const char* nA = has_next ? S.a_base(nxt) : cA; const char* nB = has_next ? S.b_base(nxt) : cB;
        if constexpr (Sched::GATHER) {
            const int t2 = lane_id_fresh() + wid * 64;
            int R0, C0, R1, C1; stage_rc(t2 * 16, R0, C0); stage_rc(t2 * 16 + 8192, R1, C1);
            u32x4 nv;
            nv.x = has_next ? S.a_off(nxt, R0, C0) : cvA[0][0]; nv.y = has_next ? S.a_off(nxt, R1, C1) : cvA[0][1];
            nv.z = has_next ? S.a_off(nxt, HALF + R0, C0) : cvA[1][0]; nv.w = has_next ? S.a_off(nxt, HALF + R1, C1) : cvA[1][1];
            *((LAS u32x4*)(lds + RING_BYTES) + t2) = nv;
        }
        asm volatile(".p2align 8" ::: "memory");
        for (int t = 0; t < nt; t += 2) {
            const bool last = (t == nt - 2);
            const char* a1 = cA + (size_t)(t + 1) * kstep;
            const char* a2 = last ? nA : cA + (size_t)(t + 2) * kstep; const char* b2 = last ? nB : cB + (size_t)(t + 2) * kstep;
            const char* a3 = a2 + kstep; const char* b3 = b2 + kstep;
            unsigned v2[2][2];
            if (Sched::GATHER && last) { const u32x4 nv = *G8_NVSLOT; v2[0][0] = nv.x; v2[0][1] = nv.y; v2[1][0] = nv.z; v2[1][1] = nv.w; }
            else { v2[0][0] = cvA[0][0]; v2[0][1] = cvA[0][1]; v2[1][0] = cvA[1][0]; v2[1][1] = cvA[1][1]; }
            G8_LDB(B0, 0, 0); G8_LDB(B1, 0, 1); G8_SCHED; G8_LDA(At, 0, 0); G8_STAGE(G8_SA(1, 1), a1, cvA[1]);
            G8_WAIT_V(8); G8_WAIT_L(0); G8_BAR; G8_MMA(0, 0, At, B0); G8_MMA(0, 1, At, B1); G8_BAR; G8_SCHED;
            G8_LDA(At, 0, 1); G8_STAGE(G8_SB(0, 0), b2, voffB); G8_STAGE(G8_SB(0, 1), b2 + hstepB, voffB); G8_STAGE(G8_SA(0, 0), a2, v2[0]);
            G8_WAIT_V(8); G8_WAIT_L(0); G8_BAR; G8_MMA(1, 0, At, B0); G8_MMA(1, 1, At, B1); G8_BAR; G8_SCHED;
            G8_LDB(B0, 1, 0); G8_LDB(B1, 1, 1); G8_SCHED; G8_LDA(At, 1, 0); G8_STAGE(G8_SA(0, 1), a2, v2[1]);
            G8_WAIT_V(8); G8_WAIT_L(0); G8_BAR; G8_MMA(0, 0, At, B0); G8_MMA(0, 1, At, B1); G8_BAR; G8_SCHED;
            G8_LDA(At, 1, 1); G8_STAGE(G8_SB(1, 0), b3, voffB); G8_STAGE(G8_SB(1, 1), b3 + hstepB, voffB); G8_STAGE(G8_SA(1, 0), a3, v2[0]);
            G8_WAIT_V(8); G8_WAIT_L(0); G8_BAR; G8_MMA(1, 0, At, B0); G8_MMA(1, 1, At, B1); G8_BAR; G8_SCHED;
        }
        if (wr == 0) G8_BAR;
        { const int lf = lane_id_fresh(); E(acc, cur, wr, wc, lf & 15, lf >> 4, (const LAS float*)(metab + (ui & 1) * 2048)); }
        if (!has_next) break;
#pragma unroll
        for (int a = 0; a < 2; ++a)
#pragma unroll
            for (int b = 0; b < 2; ++b)
#pragma unroll
                for (int m = 0; m < 4; ++m)
#pragma unroll
                    for (int n = 0; n < 2; ++n) acc[a][b][m][n] = (f32x4){0.f, 0.f, 0.f, 0.f};
        cur = nxt; cA = nA; cB = nB; ++ui;
        if constexpr (Sched::GATHER) { const u32x4 nv = *G8_NVSLOT; cvA[0][0] = nv.x; cvA[0][1] = nv.y; cvA[1][0] = nv.z; cvA[1][1] = nv.w; }
        if (wr == 1) G8_BAR;
    }
    G8_WAIT_V(0);
    G8_BAR;
#undef G8_SA
#undef G8_SB
#undef G8_STAGE
#undef G8_LDA
#undef G8_LDB
#undef G8_MMA
#undef G8_NVSLOT
#undef G8_LO
#undef G8_HI
#undef G8_LD32
#undef G8_WAIT_V
#undef G8_WAIT_L
#undef G8_BAR
#undef G8_SCHED
}

#define G8_META_DMA(srcptr, mbuf, col, wid) do { if ((wid) < 4) __builtin_amdgcn_global_load_lds((const unsigned*)(srcptr), (LAS unsigned*)((mbuf) + (col) * 1024 + (wid) * 256), 4, 0, 0); } while (0)

struct EpiProj {
    const float* rs0; const float* g_q; const float* g_k; bf16_t *Q, *Kb, *V, *GB, *CU;
    __device__ __forceinline__ void meta_issue(const Unit& u, LAS unsigned char* mb, int wid) const { G8_META_DMA(rs0 + u.pm * BM + wid * 64 + lane_id_fresh(), mb, 0, wid); }
    __device__ __forceinline__ void operator()(f32x4 (&acc)[2][2][4][2], const Unit& u, int wr, int wc, int fr, int fq, const LAS float* meta) const {
        const int pn = u.pn, rbase = u.pm * BM + wr * 64 + fr;
        float rsv[2][4];
#pragma unroll
        for (int ai = 0; ai < 2; ++ai)
#pragma unroll
            for (int m = 0; m < 4; ++m) rsv[ai][m] = meta[ai * HALF + wr * 64 + m * 16 + fr];
        if (pn < 8) {
            const bool isq = pn < 4; const float* gn = isq ? g_q : g_k; const float sc = isq ? 0.125f * LOG2E : 1.f;
            bf16_t* O = isq ? Q : Kb; const int colb = (pn & 3) * 256 + wc * 64 + fq * 8;
            f32x4 gv[2][2];
#pragma unroll
            for (int bj = 0; bj < 2; ++bj)
#pragma unroll
                for (int n = 0; n < 2; ++n) gv[bj][n] = *(const f32x4*)(gn + bj * 32 + fq * 8 + n * 4);
#pragma unroll
            for (int ai = 0; ai < 2; ++ai)
#pragma unroll
                for (int m = 0; m < 4; ++m) {
                    const int row = rbase + ai * HALF + m * 16; const float rs = rsv[ai][m];
                    float ss = 0.f;
#pragma unroll
                    for (int bj = 0; bj < 2; ++bj)
#pragma unroll
                        for (int n = 0; n < 2; ++n) { acc[ai][bj][m][n] = acc[ai][bj][m][n] * rs; ss += dot4(acc[ai][bj][m][n]); }
                    ss += __shfl_xor(ss, 16); ss += __shfl_xor(ss, 32);
                    const float r = rsqrtf(ss * (1.f / 64.f) + EPS) * sc;
#pragma unroll
                    for (int bj = 0; bj < 2; ++bj) *(u32x4*)(O + (size_t)row * 1024 + colb + bj * 32) = pack8(acc[ai][bj][m][0] * r * gv[bj][0], acc[ai][bj][m][1] * r * gv[bj][1]);
                }
        } else if (pn < 16) {
            bf16_t* O = pn < 12 ? V : GB; const int colb = (pn & 3) * 256 + wc * 32 + fq * 8;
#pragma unroll
            for (int ai = 0; ai < 2; ++ai)
#pragma unroll
                for (int m = 0; m < 4; ++m) {
                    const int row = rbase + ai * HALF + m * 16; const float rs = rsv[ai][m];
#pragma unroll
                    for (int bj = 0; bj < 2; ++bj) *(u32x4*)(O + (size_t)row * 1024 + colb + bj * 128) = pack8(acc[ai][bj][m][0] * rs, acc[ai][bj][m][1] * rs);
                }
        } else {
            const int colb = (pn - 16) * 128 + wc * 32 + fq * 8;
#pragma unroll
            for (int ai = 0; ai < 2; ++ai)
#pragma unroll
                for (int m = 0; m < 4; ++m) {
                    const int row = rbase + ai * HALF + m * 16; const float rs = rsv[ai][m], rs2 = rs * rs;
                    *(u32x4*)(CU + (size_t)row * 1024 + colb) = pack8(acc[ai][0][m][0] * acc[ai][1][m][0] * rs2, acc[ai][0][m][1] * acc[ai][1][m][1] * rs2);
                }
        }
    }
};
struct EpiBf16 {
    bf16_t* O; int ldo;
    __device__ __forceinline__ void meta_issue(const Unit&, LAS unsigned char*, int) const {}
    __device__ __forceinline__ void operator()(f32x4 (&acc)[2][2][4][2], const Unit& u, int wr, int wc, int fr, int fq, const LAS float* meta) const {
        const int rbase = u.pm * BM + wr * 64 + fr, colb = u.pn * BM + wc * 32 + fq * 8;
#pragma unroll
        for (int ai = 0; ai < 2; ++ai)
#pragma unroll
            for (int m = 0; m < 4; ++m) { const int row = rbase + ai * HALF + m * 16;
#pragma unroll
                for (int bj = 0; bj < 2; ++bj) *(u32x4*)(O + (size_t)row * ldo + colb + bj * 128) = pack8(acc[ai][bj][m][0], acc[ai][bj][m][1]); }
    }
};
struct EpiRes {
    __device__ __forceinline__ void meta_issue(const Unit&, LAS unsigned char*, int) const {}
    const float* x; bf16_t* H; float* SSQ; unsigned char* H8;
    __device__ __forceinline__ void operator()(f32x4 (&acc)[2][2][4][2], const Unit& u, int wr, int wc, int fr, int fq, const LAS float* meta) const {
        const int rbase = u.pm * BM + wr * 64 + fr, colb = u.pn * BM + wc * 32 + fq * 8;
        f32x4 xa[2][2][2][2];
#define ER_LOAD(buf, b) do { _Pragma("unroll") for (int r2 = 0; r2 < 2; ++r2) { const int row_ = rbase + ((b) >> 1) * HALF + (((b) & 1) * 2 + r2) * 16; \
            _Pragma("unroll") for (int bj = 0; bj < 2; ++bj) { const size_t o_ = (size_t)row_ * DM + colb + bj * 128; xa[buf][r2][bj][0] = *(const f32x4*)(x + o_); xa[buf][r2][bj][1] = *(const f32x4*)(x + o_ + 4); } } } while (0)
        ER_LOAD(0, 0);
#pragma unroll
        for (int b = 0; b < 4; ++b) {
            if (b == 0) ER_LOAD(1, 1); else if (b == 1) ER_LOAD(0, 2); else if (b == 2) ER_LOAD(1, 3);
#pragma unroll
            for (int r2 = 0; r2 < 2; ++r2) { const int ai = b >> 1, m = (b & 1) * 2 + r2, row = rbase + ai * HALF + m * 16; float ss = 0.f;
#pragma unroll
                for (int bj = 0; bj < 2; ++bj) { const size_t o = (size_t)row * DM + colb + bj * 128;
                    const f32x4 h0 = acc[ai][bj][m][0] + xa[b & 1][r2][bj][0], h1 = acc[ai][bj][m][1] + xa[b & 1][r2][bj][1];
                    ss += dot4(h0) + dot4(h1);
                    *(u32x4*)(H + o) = pack8(h0, h1);
                    u32x2 w8; w8.x = pack4_fp8(h0, F8_H); w8.y = pack4_fp8(h1, F8_H); *(u32x2*)(H8 + o) = w8; }
                ss += __shfl_xor(ss, 16); ss += __shfl_xor(ss, 32);
                if (fq == 0) SSQ[(size_t)row * 32 + u.pn * 4 + wc] = ss; }
        }
#undef ER_LOAD
    }
};
struct EpiRouter {
    float* PART;
    __device__ __forceinline__ void meta_issue(const Unit&, LAS unsigned char*, int) const {}
    __device__ __forceinline__ void operator()(f32x4 (&acc)[2][2][4][2], const Unit& u, int wr, int wc, int fr, int fq, const LAS float* meta) const {
        if (wc < 2) {
            const int rbase = u.pm * BM + wr * 64 + fr;
#pragma unroll
            for (int ai = 0; ai < 2; ++ai)
#pragma unroll
                for (int m = 0; m < 4; ++m) { const int row = rbase + ai * HALF + m * 16;
#pragma unroll
                    for (int n = 0; n < 2; ++n) *(f32x4*)(PART + ((size_t)u.e * M + row) * 64 + wc * 32 + n * 16 + fq * 4) = acc[ai][0][m][n]; }
        }
    }
};
struct KSplitSched {
    static constexpr bool GATHER = false;
    const char* A; const char* Bt; int G, c;
    __device__ __forceinline__ bool next(int i, Unit& u) const { const int L = i * G + c; if (L >= (M / BM) * 4) return false; u.pm = L >> 2; u.pn = 0; u.e = L & 3; return true; }
    __device__ __forceinline__ const char* a_base(const Unit& u) const { return A + (size_t)u.pm * BM * DM * 2 + (size_t)u.e * 512 * 2; }
    __device__ __forceinline__ const char* b_base(const Unit& u) const { return Bt + (size_t)u.e * 512 * 2; }
    __device__ __forceinline__ unsigned a_off(const Unit&, int row, int C) const { return (unsigned)(row * DM + C) * 2u; }
    __device__ __forceinline__ unsigned b_off(int row, int C) const { return (unsigned)(row * DM + C) * 2u; }
};
__device__ __forceinline__ f32x4 bf4lo(unsigned a, unsigned b) { return (f32x4){__uint_as_float(a << 16), __uint_as_float(a & 0xffff0000u), __uint_as_float(b << 16), __uint_as_float(b & 0xffff0000u)}; }
struct EpiFinal {
    const bf16_t* H2B; const bf16_t* PP; const float* rs2; float* out;
    __device__ __forceinline__ void meta_issue(const Unit& u, LAS unsigned char* mb, int wid) const { G8_META_DMA(rs2 + u.pm * BM + wid * 64 + lane_id_fresh(), mb, 0, wid); }
    __device__ __forceinline__ void operator()(f32x4 (&acc)[2][2][4][2], const Unit& u, int wr, int wc, int fr, int fq, const LAS float* meta) const {
        const int rbase = u.pm * BM + wr * 64 + fr, colb = u.pn * BM + wc * 32 + fq * 8;
        float rsv[2][4];
#pragma unroll
        for (int ai = 0; ai < 2; ++ai)
#pragma unroll
            for (int m = 0; m < 4; ++m) rsv[ai][m] = meta[ai * HALF + wr * 64 + m * 16 + fr];
        u32x4 hb[2][2][2], pb[2][2][2];
#define EF_LOAD(buf, b) do { _Pragma("unroll") for (int r2 = 0; r2 < 2; ++r2) { const int row_ = rbase + ((b) >> 1) * HALF + (((b) & 1) * 2 + r2) * 16; \
            _Pragma("unroll") for (int bj = 0; bj < 2; ++bj) { const size_t o_ = (size_t)row_ * DM + colb + bj * 128; hb[buf][r2][bj] = *(const u32x4*)(H2B + o_); pb[buf][r2][bj] = *(const u32x4*)(PP + o_); } } } while (0)
        EF_LOAD(0, 0);
#pragma unroll
        for (int b = 0; b < 4; ++b) {
            if (b == 0) EF_LOAD(1, 1); else if (b == 1) EF_LOAD(0, 2); else if (b == 2) EF_LOAD(1, 3);
#pragma unroll
            for (int r2 = 0; r2 < 2; ++r2) { const int ai = b >> 1, m = (b & 1) * 2 + r2, row = rbase + ai * HALF + m * 16; const float rs = rsv[ai][m];
#pragma unroll
                for (int bj = 0; bj < 2; ++bj) { const size_t o = (size_t)row * DM + colb + bj * 128;
                    const u32x4 hv = hb[b & 1][r2][bj], pv = pb[b & 1][r2][bj];
                    const f32x4 h0 = bf4lo(hv.x, hv.y), h1 = bf4lo(hv.z, hv.w), p0 = bf4lo(pv.x, pv.y), p1 = bf4lo(pv.z, pv.w);
                    f32x4 z0 = acc[ai][bj][m][0] * rs, z1 = acc[ai][bj][m][1] * rs, o0, o1;
#pragma unroll
                    for (int j = 0; j < 4; ++j) { o0[j] = h0[j] + p0[j] * fast_sigmoid(z0[j]); o1[j] = h1[j] + p1[j] * fast_sigmoid(z1[j]); }
                    *(f32x4*)(out + o) = o0; *(f32x4*)(out + o + 4) = o1; } }
        }
#undef EF_LOAD
    }
};

struct MoeTab { const LAS int* texp; const LAS int* trow0; const LAS int* tcnt; int ntile; };
struct UpSched {
    static constexpr bool GATHER = true;
    const char* Hb; const char* Wup; const int* LIST; MoeTab T; int G, c;
    __device__ __forceinline__ bool next(int i, Unit& u) const { const int L = i * G + c; if (L >= T.ntile * 4) return false; u.pm = L >> 2; u.pn = L & 3; u.e = T.texp[u.pm]; return true; }
    __device__ __forceinline__ const char* a_base(const Unit&) const { return Hb; }
    __device__ __forceinline__ const char* b_base(const Unit& u) const { return Wup + ((size_t)u.e * 1024 + (size_t)u.pn * 256) * DM; }
    __device__ __forceinline__ unsigned a_off(const Unit& u, int row, int C) const {
        int idx = T.trow0[u.pm] + row; const int n = T.tcnt[u.e]; idx = idx < n ? idx : n - 1;
        const int slot = LIST[(size_t)u.e * M + idx]; return (unsigned)(slot >> 1) * (unsigned)DM + (unsigned)C * 2u; }
    __device__ __forceinline__ unsigned b_off(int row, int C) const { return (unsigned)(row * DM + C * 2); }
};
struct DnSched {
    static constexpr bool GATHER = false;
    const char* HID; const char* Wdn; MoeTab T; int G, c;
    __device__ __forceinline__ bool next(int i, Unit& u) const { const int L = i * G + c; if (L >= T.ntile * 8) return false; u.pm = L >> 3; u.pn = L & 7; u.e = T.texp[u.pm]; return true; }
    __device__ __forceinline__ const char* a_base(const Unit& u) const { return HID + (size_t)u.pm * 256 * DFF; }
    __device__ __forceinline__ const char* b_base(const Unit& u) const { return Wdn + ((size_t)u.e * DM + (size_t)u.pn * 256) * DFF; }
    __device__ __forceinline__ unsigned a_off(const Unit&, int row, int C) const { return (unsigned)(row * DFF + C * 2); }
    __device__ __forceinline__ unsigned b_off(int row, int C) const { return (unsigned)(row * DFF + C * 2); }
};
struct EpiUp {
    const float* LRS; bf16_t* HID; MoeTab T;
    __device__ __forceinline__ void meta_issue(const Unit& u, LAS unsigned char* mb, int wid) const { const int n = T.tcnt[u.e]; int idx = T.trow0[u.pm] + wid * 64 + lane_id_fresh(); idx = idx < n ? idx : n - 1;
        G8_META_DMA(LRS + (size_t)u.e * M + idx, mb, 0, wid); }
    __device__ __forceinline__ void operator()(f32x4 (&acc)[2][2][4][2], const Unit& u, int wr, int wc, int fr, int fq, const LAS float* meta) const {
        const int r0 = T.trow0[u.pm], n = T.tcnt[u.e], colb = u.pn * 128 + wc * 32 + fq * 8;
        float rsv[2][4];
#pragma unroll
        for (int ai = 0; ai < 2; ++ai)
#pragma unroll
            for (int m = 0; m < 4; ++m) rsv[ai][m] = meta[ai * HALF + wr * 64 + m * 16 + fr];
#pragma unroll
        for (int ai = 0; ai < 2; ++ai)
#pragma unroll
            for (int m = 0; m < 4; ++m) {
                const int rit = ai * HALF + wr * 64 + m * 16 + fr; const float vmask = (r0 + rit < n) ? 1.f : 0.f, rs = rsv[ai][m];
                f32x4 h[2];
#pragma unroll
                for (int nn = 0; nn < 2; ++nn) { const f32x4 a = acc[ai][0][m][nn] * rs, b = acc[ai][1][m][nn] * (rs * vmask);
#pragma unroll
                    for (int j = 0; j < 4; ++j) h[nn][j] = a[j] * fast_sigmoid(a[j]) * b[j]; }
                u32x2 w8; w8.x = pack4_fp8(h[0], F8_HID); w8.y = pack4_fp8(h[1], F8_HID);
                *(u32x2*)((unsigned char*)HID + ((size_t)u.pm * 256 + rit) * DFF + colb) = w8;
            }
    }
};
struct EpiDn {
    const int* LIST; const float* LTW; bf16_t* Y0; bf16_t* Y1; MoeTab T;
    __device__ __forceinline__ void meta_issue(const Unit& u, LAS unsigned char* mb, int wid) const { const int n = T.tcnt[u.e]; int idx = T.trow0[u.pm] + wid * 64 + lane_id_fresh(); idx = idx < n ? idx : n - 1;
        G8_META_DMA(LIST + (size_t)u.e * M + idx, mb, 0, wid); G8_META_DMA(LTW + (size_t)u.e * M + idx, mb, 1, wid); }
    __device__ __forceinline__ void operator()(f32x4 (&acc)[2][2][4][2], const Unit& u, int wr, int wc, int fr, int fq, const LAS float* meta) const {
        const int r0 = T.trow0[u.pm], n = T.tcnt[u.e], colb = u.pn * BM + wc * 32 + fq * 8;
        int slv[2][4]; float twv[2][4];
#pragma unroll
        for (int ai = 0; ai < 2; ++ai)
#pragma unroll
            for (int m = 0; m < 4; ++m) { const int rit = ai * HALF + wr * 64 + m * 16 + fr; slv[ai][m] = ((const LAS int*)meta)[rit]; twv[ai][m] = meta[256 + rit]; }
#pragma unroll
        for (int ai = 0; ai < 2; ++ai)
#pragma unroll
            for (int m = 0; m < 4; ++m) {
                const int idx = r0 + ai * HALF + wr * 64 + m * 16 + fr;
                if (idx < n) { const int slot = slv[ai][m]; const float tw = twv[ai][m];
                    unsigned char* Y = (unsigned char*)((slot & 1) ? Y1 : Y0) + (size_t)(slot >> 1) * DM + colb;
#pragma unroll
                    for (int bj = 0; bj < 2; ++bj) { u32x2 w8; w8.x = pack4_fp8(acc[ai][bj][m][0] * tw, F8_Y); w8.y = pack4_fp8(acc[ai][bj][m][1] * tw, F8_Y); *(u32x2*)(Y + bj * 128) = w8; } }
            }
    }
};
}

struct Args { const float* in[27]; float* out; unsigned char* ws; int ph_lo, ph_hi, li, pad; };
struct Frame {
    LAS unsigned char* lds; volatile LAS unsigned* MISC; unsigned char* ws;
    int wave, vcu, G;
};

__device__ __forceinline__ float wave_sum(float v) {
#pragma unroll
    for (int o = 1; o < 64; o <<= 1) v += __shfl_xor(v, o);
    return v;
}

__device__ __forceinline__ void tr_item(const float* src, int ld, const float* ks, int k0, int c0, bf16_t* dst, int ldk, int d0, int d1, LAS float* scr, int lane) {
    f32x4 v[16];
#pragma unroll
    for (int i = 0; i < 16; ++i) v[i] = *(const f32x4*)(src + (size_t)(k0 + 4 * i + (lane >> 4)) * ld + c0 + (lane & 15) * 4);
    const int c8 = lane & 7;
    f32x4 g0 = (f32x4){1.f, 1.f, 1.f, 1.f}, g1 = g0;
    if (ks) { g0 = *(const f32x4*)(ks + k0 + 8 * c8); g1 = *(const f32x4*)(ks + k0 + 8 * c8 + 4); }
#pragma unroll
    for (int i = 0; i < 16; ++i) { LAS float* s = scr + (4 * i + (lane >> 4)) * 65 + (lane & 15) * 4; s[0] = v[i][0]; s[1] = v[i][1]; s[2] = v[i][2]; s[3] = v[i][3]; }
    asm volatile("s_waitcnt lgkmcnt(0)" ::: "memory");
#pragma unroll
    for (int j = 0; j < 8; ++j) { const int rr = j * 8 + (lane >> 3), c32 = rr & 31;
        const int p32 = ((c32 >> 2) & 1) * 16 + (c32 >> 3) * 4 + (c32 & 3), drow = ((rr >> 5) ? d1 : d0) + p32;
        const LAS float* s = scr + (8 * c8) * 65 + rr;
        u32x4 o; o.x = cvt_pk_bf16(s[0] * g0[0], s[65] * g0[1]); o.y = cvt_pk_bf16(s[2 * 65] * g0[2], s[3 * 65] * g0[3]); o.z = cvt_pk_bf16(s[4 * 65] * g1[0], s[5 * 65] * g1[1]); o.w = cvt_pk_bf16(s[6 * 65] * g1[2], s[7 * 65] * g1[3]);
        *(u32x4*)(dst + (size_t)drow * ldk + k0 + 8 * c8) = o; }
    asm volatile("s_waitcnt lgkmcnt(0)" ::: "memory");
}
__device__ __forceinline__ void tr_item8(const float* src, int ld, const float* ks, int k0, int c0, unsigned char* dst, int ldk, int d0, int d1, LAS float* scr, int lane) {
    f32x4 v[16];
#pragma unroll
    for (int i = 0; i < 16; ++i) v[i] = *(const f32x4*)(src + (size_t)(k0 + 4 * i + (lane >> 4)) * ld + c0 + (lane & 15) * 4);
    const int c8 = lane & 7;
    f32x4 g0 = (f32x4){1.f, 1.f, 1.f, 1.f}, g1 = g0;
    if (ks) { g0 = *(const f32x4*)(ks + k0 + 8 * c8); g1 = *(const f32x4*)(ks + k0 + 8 * c8 + 4); }
#pragma unroll
    for (int i = 0; i < 16; ++i) { LAS float* s = scr + (4 * i + (lane >> 4)) * 65 + (lane & 15) * 4; s[0] = v[i][0]; s[1] = v[i][1]; s[2] = v[i][2]; s[3] = v[i][3]; }
    asm volatile("s_waitcnt lgkmcnt(0)" ::: "memory");
#pragma unroll
    for (int j = 0; j < 8; ++j) { const int rr = j * 8 + (lane >> 3), c32 = rr & 31;
        const int p32 = ((c32 >> 2) & 1) * 16 + (c32 >> 3) * 4 + (c32 & 3), drow = ((rr >> 5) ? d1 : d0) + p32;
        const LAS float* s = scr + (8 * c8) * 65 + rr;
        u32x2 o; o.x = pack4_fp8((f32x4){s[0], s[65], s[2 * 65], s[3 * 65]} * g0, F8_W); o.y = pack4_fp8((f32x4){s[4 * 65], s[5 * 65], s[6 * 65], s[7 * 65]} * g1, F8_W);
        *(u32x2*)(dst + (size_t)drow * ldk + k0 + 8 * c8) = o; }
    asm volatile("s_waitcnt lgkmcnt(0)" ::: "memory");
}
__device__ __forceinline__ int map_in(int c) {
    if (c < 2048) { const int w = c & 255; return (c & ~255) + ((w >> 5) & 1) * 128 + (w >> 6) * 32; }
    if (c < 4096) return c;
    const int ch = (c - 4096) & 1023; return (16 + (ch >> 7)) * 256 + ((ch >> 5) & 3) * 32 + (c >= 5120 ? 128 : 0);
}

__device__ __forceinline__ void prep_row(const float* x, const float* p, bf16_t* XB, float* RS0, bf16_t* PB, int row, int lane) {
    const GAS f32x4* xr = (const GAS f32x4*)(x + (size_t)row * DM) + lane;
    f32x4 v[8]; float s = 0.f;
#pragma unroll
    for (int j = 0; j < 8; ++j) v[j] = xr[64 * j];
    const f32x4 pv = *((const GAS f32x4*)(p + (size_t)row * PLE) + lane);
#pragma unroll
    for (int j = 0; j < 8; ++j) s += dot4(v[j]);
    s = wave_sum(s);
    GAS u32x2* o = (GAS u32x2*)(XB + (size_t)row * DM) + lane;
#pragma unroll
    for (int j = 0; j < 8; ++j) { u32x2 w; w.x = cvt_pk_bf16(v[j][0], v[j][1]); w.y = cvt_pk_bf16(v[j][2], v[j][3]); o[64 * j] = w; }
    if (lane == 0) RS0[row] = rsqrtf(s * (1.f / DM) + EPS);
    u32x2 w; w.x = cvt_pk_bf16(pv[0], pv[1]); w.y = cvt_pk_bf16(pv[2], pv[3]);
    *((GAS u32x2*)(PB + (size_t)row * PLE) + lane) = w;
}

__device__ __forceinline__ void p0_prologue(Frame& F, const Args& a) {
    unsigned char* ws = F.ws; const int lane = lane_id(), tid = F.wave * 64 + lane;
    const float* w_in = a.in[4]; const float* g_mix = a.in[3]; const float* w_o = a.in[15]; const float* g_ffn = a.in[16];
    const float* w1 = a.in[21]; const float* w3 = a.in[22]; const float* w2 = a.in[23]; const float* g_ple = a.in[24]; const float* w_gate = a.in[25]; const float* w_proj = a.in[26];
    if (blockIdx.x == 0 && tid < 256) {
        LAS float* red = (LAS float*)(F.lds + LCTL_OFF + 128);
        const float* rel_bias = a.in[2]; const int t = tid;
        float gq = 0.f, gk = 0.f, rb = fabsf(rel_bias[t]);
        if (t < 64) { gq = fabsf(a.in[5][t]); gk = fabsf(a.in[6][t]); }
        for (int o = 32; o > 0; o >>= 1) { gq = fmaxf(gq, __shfl_xor(gq, o)); gk = fmaxf(gk, __shfl_xor(gk, o)); rb = fmaxf(rb, __shfl_xor(rb, o)); }
        if ((t & 63) == 0) { red[t >> 6] = rb; if (t == 0) { red[8] = gq; red[9] = gk; } }
    }
    __syncthreads();
    if (blockIdx.x == 0 && tid < 256) {
        LAS float* red = (LAS float*)(F.lds + LCTL_OFF + 128);
        const float* rel_bias = a.in[2]; const int t = tid;
        const float rbm = fmaxf(fmaxf(red[0], red[1]), fmaxf(red[2], red[3]));
        const float m0 = 8.f * red[8] * red[9] + rbm;
        float* BT = (float*)(ws + WS_BT);
        for (int i = t; i < NH * BT_N; i += 256) { const int h = i / BT_N, idx = i % BT_N, rel = idx - 255; BT[i] = (rel_bias[rel_bucket(rel) * NH + h] - m0) * LOG2E; }
        if (t < 64) {
            float x1 = a.in[7][t] * a.in[8][t], x2 = a.in[9][t] * a.in[10][t];
            for (int o = 32; o > 0; o >>= 1) { x1 += __shfl_xor(x1, o); x2 += __shfl_xor(x2, o); }
            if (t == 0) ((float*)(ws + WS_LAM))[0] = expf(x1) - expf(x2) + LAM_INIT;
        }
    }
    __syncthreads();
    const int gw = F.vcu * NWAVES + F.wave, NGW = F.G * NWAVES;
    for (int m = gw; m < M; m += NGW) prep_row(a.in[0], a.in[1], (bf16_t*)(ws + WS_A), (float*)(ws + WS_RS0), (bf16_t*)(ws + WS_PB), m, lane);
    { const float* w_group = a.in[17]; const float* w_expert = a.in[19]; bf16_t* WR = (bf16_t*)(ws + WS_WR);
      for (int i = (F.vcu * NWAVES + F.wave) * 64 + lane; i < 256 * (DM / 8); i += F.G * NTHR) { const int pr = i / (DM / 8), k8 = (i % (DM / 8)) * 8;
          float v[8];
#pragma unroll
          for (int q = 0; q < 8; ++q) { const int k = k8 + q; v[q] = pr < 4 ? g_ffn[k] * w_group[k * 4 + pr] : pr < 36 ? g_ffn[k] * w_expert[k * 32 + pr - 4] : 0.f; }
          u32x4 o; o.x = cvt_pk_bf16(v[0], v[1]); o.y = cvt_pk_bf16(v[2], v[3]); o.z = cvt_pk_bf16(v[4], v[5]); o.w = cvt_pk_bf16(v[6], v[7]);
          *(u32x4*)(WR + (size_t)pr * DM + k8) = o; } }
    LAS float* scr = (LAS float*)(F.lds + F.wave * 16640);
    constexpr int I_IN = 32 * 96, I_O = 32 * 32, I_G = 32 * 32, I_P = 4 * 32, I_UP = 32 * 512, I_DN = 32 * 256;
    constexpr int NITEMS = I_IN + I_O + I_G + I_P + I_UP + I_DN;
    for (int it = gw; it < NITEMS; it += NGW) {
        int r = it;
        if (r < I_IN) { const int kb = r / 96, cb = r % 96, c0 = cb * 64; tr_item(w_in, 6144, g_mix, kb * 64, c0, (bf16_t*)(ws + WS_WIN), DM, map_in(c0), map_in(c0 + 32), scr, lane); continue; } r -= I_IN;
        if (r < I_O) { const int kb = r / 32, c0 = (r % 32) * 64; tr_item(w_o, DM, nullptr, kb * 64, c0, (bf16_t*)(ws + WS_WO), DM, c0, c0 + 32, scr, lane); continue; } r -= I_O;
        if (r < I_G) { const int kb = r / 32, c0 = (r % 32) * 64; tr_item8(w_gate, DM, g_ple, kb * 64, c0, ws + WS_WG, DM, c0, c0 + 32, scr, lane); continue; } r -= I_G;
        if (r < I_P) { const int kb = r / 32, c0 = (r % 32) * 64; tr_item(w_proj, DM, nullptr, kb * 64, c0, (bf16_t*)(ws + WS_WP), PLE, c0, c0 + 32, scr, lane); continue; } r -= I_P;
        if (r < I_UP) { const int e = r / 512, q = r % 512, which = q / 256, q2 = q % 256, kb = q2 / 8, c0 = (q2 % 8) * 64;
            const float* src = (which ? w3 : w1) + (size_t)e * DM * DFF;
            const int d0 = (c0 >> 7) * 256 + ((c0 >> 5) & 3) * 32 + which * 128, d1 = ((c0 + 32) >> 7) * 256 + (((c0 + 32) >> 5) & 3) * 32 + which * 128;
            tr_item8(src, DFF, g_ffn, kb * 64, c0, ws + WS_WUP + (size_t)e * 1024 * DM, DM, d0, d1, scr, lane); continue; } r -= I_UP;
        { const int e = r / 256, q = r % 256, kb = q / 32, c0 = (q % 32) * 64;
            tr_item8(w2 + (size_t)e * DFF * DM, DM, nullptr, kb * 64, c0, ws + WS_WDN + (size_t)e * DM * DFF, DFF, c0, c0 + 32, scr, lane); }
    }
}


namespace att {
typedef short v4i16_t __attribute__((ext_vector_type(4)));
constexpr int SLOT = 32768, STG_STRIDE = 132, STG_BYTES = 32 * STG_STRIDE * 4;
static_assert(4 * SLOT <= RING_BYTES && 8 * STG_BYTES <= LCTL_OFF, "attention LDS");
__device__ __forceinline__ void glds16(const void* gsrc, unsigned lds_dst) { unsigned keep;
    asm volatile("s_mov_b32 %0, m0\n\ts_mov_b32 m0, %2\n\ts_nop 0\n\tglobal_load_lds_dwordx4 %1, off\n\ts_mov_b32 m0, %0" : "=&s"(keep) : "v"(gsrc), "s"(lds_dst) : "memory"); }
__device__ __forceinline__ v4i16_t vtr(const LAS unsigned char* p) { return __builtin_amdgcn_ds_read_tr16_b64_v4i16((LAS v4i16_t*)p); }
__device__ __forceinline__ int crow(int r, int hi) { return (r & 3) + 8 * (r >> 2) + 4 * hi; }

__device__ __forceinline__ void attn_unit(int b, int h, int qb, const bf16_t* Q, const bf16_t* K, const bf16_t* V, bf16_t* AO, const float* g_subln, float lam, LAS unsigned char* lds, int wid) {
    const int lane = lane_id(), r32 = lane & 31, hi = lane >> 5;
    const int pair = wid >> 1, comp = wid & 1;
    const long rowbase = (long)b * SEQ; const int q0 = qb * 128, myrow0 = q0 + pair * 32;
    const int cw = myrow0 >> 6;
    const int NT = (q0 >> 6) + 2;
    const LAS float* bt = (const LAS float*)(lds + LBT_OFF);
    const float ffar = __builtin_amdgcn_exp2f(bt[0]);
    const bf16_t* ksrc = K + (size_t)(rowbase + 8 * wid + (lane >> 3)) * 1024 + h * 128 + (((lane & 7) ^ (((8 * wid + (lane >> 3)) >> 1) & 7)) * 8);
    const bf16_t* vsrc = V + (size_t)(rowbase + 16 * (wid & 3) + (lane >> 2)) * 1024 + h * 128 + (wid >> 2) * 32 + (lane & 3) * 8;
    const unsigned lds0 = (unsigned)(size_t)lds;
    const unsigned kdst = lds0 + wid * 1024, vdst = lds0 + 16384 + (wid >> 2) * 4096 + (wid & 3) * 1024;
#define ATT_DMA(t, sl) do { const size_t go_ = (size_t)(t) * 65536; const unsigned so_ = (unsigned)(sl); \
        glds16(ksrc + go_, (unsigned)__builtin_amdgcn_readfirstlane(kdst + so_)); glds16(ksrc + go_ + 64, (unsigned)__builtin_amdgcn_readfirstlane(kdst + so_ + 8192)); \
        glds16(vsrc + go_, (unsigned)__builtin_amdgcn_readfirstlane(vdst + so_)); glds16(vsrc + go_ + 64, (unsigned)__builtin_amdgcn_readfirstlane(vdst + so_ + 8192)); } while (0)
    f32x16 o[4];
#pragma unroll
    for (int d = 0; d < 4; ++d)
#pragma unroll
        for (int r = 0; r < 16; ++r) o[d][r] = 0.f;
    float l = 0.f;
    ATT_DMA(0, 0); ATT_DMA(1, SLOT);
    bf16x8 qr[4];
#pragma unroll
    for (int d0 = 0; d0 < 4; ++d0) qr[d0] = *(const bf16x8*)(Q + (size_t)(rowbase + myrow0 + r32) * 1024 + h * 128 + comp * 64 + d0 * 16 + hi * 8);
    asm volatile("" :: "v"(qr[0]), "v"(qr[1]), "v"(qr[2]), "v"(qr[3]));
    int sl_cur = 0, sl_prev = 3 * SLOT, sl_nn = 2 * SLOT;
    int kofs[4];
#pragma unroll
    for (int d0 = 0; d0 < 4; ++d0) kofs[d0] = comp * 8192 + r32 * 128 + (((2 * d0 + hi) ^ ((r32 >> 1) & 7)) * 16);
    const int vofs = 16384 + ((lane >> 4) & 1) * 32 + (lane & 3) * 8 + (4 * hi + ((lane & 15) >> 2)) * 64;
    const bool grpY = wid >= 4;
    u32x4 pw[4];
#define ATT_SGB(mask, n) __builtin_amdgcn_sched_group_barrier(mask, n, 0)
    f32x16 p1;
#define ATT_QKEXP(t, slot) do { const LAS unsigned char* sb = lds + (slot); f32x16 p0; \
        bf16x8 kf[4][2]; \
        _Pragma("unroll") for (int d0 = 0; d0 < 4; ++d0) { kf[d0][0] = *(const LAS bf16x8*)(sb + kofs[d0]); kf[d0][1] = *(const LAS bf16x8*)(sb + kofs[d0] + 4096); } \
        if ((t) == cw - 2 && (t) > 0) l *= ffar; \
        if ((t) >= cw - 2) { const int base = 64 * (t) + 4 * hi - (myrow0 + r32) + 255; \
            _Pragma("unroll") for (int r = 0; r < 16; ++r) { p0[r] = bt[base + (r & 3) + 8 * (r >> 2)]; p1[r] = bt[base + 32 + (r & 3) + 8 * (r >> 2)]; } \
            _Pragma("unroll") for (int d0 = 0; d0 < 4; ++d0) { \
                p0 = __builtin_amdgcn_mfma_f32_32x32x16_bf16(kf[d0][0], qr[d0], p0, 0, 0, 0); p1 = __builtin_amdgcn_mfma_f32_32x32x16_bf16(kf[d0][1], qr[d0], p1, 0, 0, 0); } } \
        else { const f32x16 z16 = {0.f, 0.f, 0.f, 0.f, 0.f, 0.f, 0.f, 0.f, 0.f, 0.f, 0.f, 0.f, 0.f, 0.f, 0.f, 0.f};     \
            p0 = __builtin_amdgcn_mfma_f32_32x32x16_bf16(kf[0][0], qr[0], z16, 0, 0, 0); p1 = __builtin_amdgcn_mfma_f32_32x32x16_bf16(kf[0][1], qr[0], z16, 0, 0, 0); \
            _Pragma("unroll") for (int d0 = 1; d0 < 4; ++d0) { \
                p0 = __builtin_amdgcn_mfma_f32_32x32x16_bf16(kf[d0][0], qr[d0], p0, 0, 0, 0); p1 = __builtin_amdgcn_mfma_f32_32x32x16_bf16(kf[d0][1], qr[d0], p1, 0, 0, 0); } } \
        float sacc = 0.f; \
        _Pragma("unroll") for (int r = 0; r < 16; ++r) { p0[r] = __builtin_amdgcn_exp2f(p0[r]); sacc += p0[r]; } \
        l += sacc; \
        _Pragma("unroll") for (int i = 0; i < 4; ++i) { pw[0][i] = cvt_pk_bf16(p0[2 * i], p0[2 * i + 1]); pw[1][i] = cvt_pk_bf16(p0[8 + 2 * i], p0[9 + 2 * i]); } } while (0)
#define ATT_VLD2(dst, db, k0) do { _Pragma("unroll") for (int kk = 0; kk < 2; ++kk) { \
            const v4i16_t lo = vtr(sb + vofs + (db) * 4096 + ((k0) + kk) * 1024), hh = vtr(sb + vofs + (db) * 4096 + ((k0) + kk) * 1024 + 512); \
            dst[(db) * 2 + kk] = (bf16x8){lo[0], lo[1], lo[2], lo[3], hh[0], hh[1], hh[2], hh[3]}; } } while (0)
#define ATT_PV(t, slot) do { const LAS unsigned char* sb = lds + (slot); bf16x8 h1[8], h2[8]; \
        if ((t) == cw - 2 && (t) > 0) { _Pragma("unroll") for (int db = 0; db < 4; ++db) o[db] = o[db] * ffar; } \
        _Pragma("unroll") for (int db = 0; db < 4; ++db) ATT_VLD2(h1, db, 0); \
        _Pragma("unroll") for (int db = 0; db < 4; ++db) ATT_VLD2(h2, db, 2); \
        _Pragma("unroll") for (int db = 0; db < 4; ++db) { o[db] = __builtin_amdgcn_mfma_f32_32x32x16_bf16(__builtin_bit_cast(bf16x8, pw[0]), h1[db * 2], o[db], 0, 0, 0); \
                                                         o[db] = __builtin_amdgcn_mfma_f32_32x32x16_bf16(__builtin_bit_cast(bf16x8, pw[1]), h1[db * 2 + 1], o[db], 0, 0, 0); } \
        float sacc = 0.f; \
        _Pragma("unroll") for (int r = 0; r < 16; ++r) { p1[r] = __builtin_amdgcn_exp2f(p1[r]); sacc += p1[r]; } \
        l += sacc; \
        _Pragma("unroll") for (int i = 0; i < 4; ++i) { pw[2][i] = cvt_pk_bf16(p1[2 * i], p1[2 * i + 1]); pw[3][i] = cvt_pk_bf16(p1[8 + 2 * i], p1[9 + 2 * i]); } \
        _Pragma("unroll") for (int db = 0; db < 4; ++db) { o[db] = __builtin_amdgcn_mfma_f32_32x32x16_bf16(__builtin_bit_cast(bf16x8, pw[2]), h2[db * 2], o[db], 0, 0, 0); \
                                                         o[db] = __builtin_amdgcn_mfma_f32_32x32x16_bf16(__builtin_bit_cast(bf16x8, pw[3]), h2[db * 2 + 1], o[db], 0, 0, 0); } } while (0)
#define ATT_WAIT_A(s_) do { if ((s_) + 1 < NT) asm volatile("s_waitcnt vmcnt(4) lgkmcnt(0)\n\ts_barrier" ::: "memory"); else asm volatile("s_waitcnt vmcnt(0) lgkmcnt(0)\n\ts_barrier" ::: "memory"); } while (0)
#define ATT_BAR_B() asm volatile("s_waitcnt lgkmcnt(0)\n\ts_barrier" ::: "memory")
    asm volatile(".p2align 8" ::: "memory");
    if (!grpY) {
        for (int s = 0; s <= NT; ++s) {
            ATT_WAIT_A(s);
            if (s < NT && s <= cw) ATT_QKEXP(s, sl_cur);
            ATT_BAR_B();
            if (s + 2 < NT) ATT_DMA(s + 2, sl_nn);
            if (s < NT && s <= cw) ATT_PV(s, sl_cur);
            sl_prev = sl_cur; sl_cur = (sl_cur == 3 * SLOT) ? 0 : sl_cur + SLOT; sl_nn = (sl_nn == 3 * SLOT) ? 0 : sl_nn + SLOT;
        }
    } else {
        for (int s = 0; s <= NT; ++s) {
            ATT_WAIT_A(s);
            if (s >= 1 && s - 1 <= cw) ATT_PV(s - 1, sl_prev);
            ATT_BAR_B();
            if (s + 2 < NT) ATT_DMA(s + 2, sl_nn);
            if (s < NT && s <= cw) ATT_QKEXP(s, sl_cur);
            sl_prev = sl_cur; sl_cur = (sl_cur == 3 * SLOT) ? 0 : sl_cur + SLOT; sl_nn = (sl_nn == 3 * SLOT) ? 0 : sl_nn + SLOT;
        }
    }
#undef ATT_WAIT_A
#undef ATT_BAR_B
#undef ATT_QKEXP
#undef ATT_PV
#undef ATT_VLD2
#undef ATT_SGB
#undef ATT_DMA
    l += __shfl_xor(l, 32);
    asm volatile("s_waitcnt vmcnt(0) lgkmcnt(0)\n\ts_barrier" ::: "memory");
    {   LAS float* st = (LAS float*)(lds + wid * STG_BYTES);
#pragma unroll
        for (int db = 0; db < 4; ++db)
#pragma unroll
            for (int r = 0; r < 16; ++r) st[crow(r, hi) * STG_STRIDE + db * 32 + r32] = o[db][r];
        if (hi == 0) ((LAS float*)(lds + LLS_OFF))[wid * 32 + r32] = l;
    }
    asm volatile("s_waitcnt lgkmcnt(0)\n\ts_barrier" ::: "memory");
    {   const int rsel = comp * 16 + (lane >> 2), quarter = lane & 3;
        const LAS float* s1 = (const LAS float*)(lds + (pair * 2) * STG_BYTES) + rsel * STG_STRIDE + quarter * 32;
        const LAS float* s2 = (const LAS float*)(lds + (pair * 2 + 1) * STG_BYTES) + rsel * STG_STRIDE + quarter * 32;
        const LAS float* ls = (const LAS float*)(lds + LLS_OFF);
        const float i1 = 1.f / ls[(pair * 2) * 32 + rsel], i2 = lam / ls[(pair * 2 + 1) * 32 + rsel];
        f32x4 v[8]; float ss = 0.f;
#pragma unroll
        for (int c = 0; c < 8; ++c) { v[c] = *(const LAS f32x4*)(s1 + c * 4) * i1 - *(const LAS f32x4*)(s2 + c * 4) * i2; ss += dot4(v[c]); }
        ss += __shfl_xor(ss, 1); ss += __shfl_xor(ss, 2);
        const float rstd = rsqrtf(ss * (1.f / 128.f) + EPS) * (1.f - LAM_INIT);
        bf16_t* op = AO + (size_t)(rowbase + myrow0 + rsel - comp * 16 + comp * 16) * DM + h * 128 + quarter * 32;
#pragma unroll
        for (int c = 0; c < 4; ++c) { const f32x4 g0 = *(const f32x4*)(g_subln + quarter * 32 + c * 8), g1 = *(const f32x4*)(g_subln + quarter * 32 + c * 8 + 4);
            *(u32x4*)(op + c * 8) = pack8(v[2 * c] * rstd * g0, v[2 * c + 1] * rstd * g1); }
    }
    asm volatile("s_waitcnt lgkmcnt(0)\n\ts_barrier" ::: "memory");
}
}

__device__ __forceinline__ void p2_conv(Frame& F, const Args& a) {
    unsigned char* ws = F.ws; const int lane = lane_id(), c0 = lane * 16;
    const bf16_t* CU = (const bf16_t*)(ws + WS_D); const bf16_t* GB = (const bf16_t*)(ws + WS_C) + (size_t)M * 1024; bf16_t* AO = (bf16_t*)(ws + WS_A);
    const float* conv_w = a.in[12]; const float* conv_b = a.in[13]; const float* g_conv = a.in[14];
    f32x4 w0[4], w1[4], w2[4], cb[4], gc[4];
#pragma unroll
    for (int i = 0; i < 4; ++i) { w0[i] = *(const f32x4*)(conv_w + c0 + i * 4); w1[i] = *(const f32x4*)(conv_w + 1024 + c0 + i * 4); w2[i] = *(const f32x4*)(conv_w + 2048 + c0 + i * 4);
        cb[i] = *(const f32x4*)(conv_b + c0 + i * 4); gc[i] = *(const f32x4*)(g_conv + c0 + i * 4); }
    const int gw = F.vcu * NWAVES + F.wave, NGW = F.G * NWAVES;
    for (int row = gw; row < M; row += NGW) {
        const int s = row & (SEQ - 1);
        const u32x4 zz = (u32x4){0u, 0u, 0u, 0u};
        u32x4 x0[2], x1[2], x2[2], gb[2];
#pragma unroll
        for (int i = 0; i < 2; ++i) { x0[i] = *(const u32x4*)(CU + (size_t)row * 1024 + c0 + i * 8); gb[i] = *(const u32x4*)(GB + (size_t)row * 1024 + c0 + i * 8);
            x1[i] = s >= 1 ? *(const u32x4*)(CU + (size_t)(row - 1) * 1024 + c0 + i * 8) : zz; x2[i] = s >= 2 ? *(const u32x4*)(CU + (size_t)(row - 2) * 1024 + c0 + i * 8) : zz; }
        f32x4 z[4]; float ss = 0.f;
#pragma unroll
        for (int i = 0; i < 4; ++i) { const int q = i >> 1;
            const f32x4 a0 = (i & 1) ? g8::bf4lo(x0[q].z, x0[q].w) : g8::bf4lo(x0[q].x, x0[q].y), a1 = (i & 1) ? g8::bf4lo(x1[q].z, x1[q].w) : g8::bf4lo(x1[q].x, x1[q].y);
            const f32x4 a2 = (i & 1) ? g8::bf4lo(x2[q].z, x2[q].w) : g8::bf4lo(x2[q].x, x2[q].y), g = (i & 1) ? g8::bf4lo(gb[q].z, gb[q].w) : g8::bf4lo(gb[q].x, gb[q].y);
            z[i] = g * (w2[i] * a0 + w1[i] * a1 + w0[i] * a2 + cb[i]); ss += dot4(z[i]); }
        ss += __shfl_xor(ss, 1); ss += __shfl_xor(ss, 2); ss += __shfl_xor(ss, 4);
        const float r = rsqrtf(ss * (1.f / 128.f) + EPS);
        *(u32x4*)(AO + (size_t)row * DM + 1024 + c0) = pack8(z[0] * r * gc[0], z[1] * r * gc[1]);
        *(u32x4*)(AO + (size_t)row * DM + 1024 + c0 + 8) = pack8(z[2] * r * gc[2], z[3] * r * gc[3]);
    }
}
__device__ __forceinline__ void p2_attention(Frame& F, const Args& a) {
    unsigned char* ws = F.ws; const int tid = F.wave * 64 + lane_id();
    const bf16_t* Qb = (const bf16_t*)(ws + WS_B); const bf16_t* Kb = Qb + (size_t)M * 1024; const bf16_t* Vb = (const bf16_t*)(ws + WS_C); bf16_t* AO = (bf16_t*)(ws + WS_A);
    const int bh = F.vcu >> 3, j = F.vcu & 7, b = bh >> 3, h = bh & 7;
    if (bh >= BATCH * NH) return;
    const float lam = ((const float*)(ws + WS_LAM))[0];
    { LAS float* bt = (LAS float*)(F.lds + LBT_OFF); const float* BT = (const float*)(ws + WS_BT) + h * BT_N; if (tid < BT_N) bt[tid] = BT[tid]; }
    asm volatile("s_waitcnt vmcnt(0) lgkmcnt(0)\n\ts_barrier" ::: "memory");
    for (int i = 0; i < 4; ++i) { const int qb = (i == 0) ? 31 - j : (i == 1) ? 16 + j : (i == 2) ? 15 - j : j;
        att::attn_unit(b, h, qb, Qb, Kb, Vb, AO, a.in[11], lam, F.lds, F.wave); }
}

__device__ __forceinline__ void p5_route(Frame& F, const Args& a) {
    unsigned char* ws = F.ws; const int lane = lane_id();
    const float* PART = (const float*)(ws + WS_PART); const float* SSQ = (const float*)(ws + WS_SSQ);
    const float* b_group = a.in[18]; const float* b_expert = a.in[20];
    float* RS1 = (float*)(ws + WS_RS1); int* TE = (int*)(ws + WS_TE); float* TW = (float*)(ws + WS_TW); unsigned* CNT = (unsigned*)(ws + WS_CNT); int* LIST = (int*)(ws + WS_LIST);
    for (int row = (F.vcu * NWAVES + F.wave) * 64 + lane; row < M; row += F.G * NTHR) {
        float ss = 0.f;
#pragma unroll
        for (int i = 0; i < 8; ++i) { const f32x4 v = *(const f32x4*)(SSQ + (size_t)row * 32 + i * 4); ss += (v[0] + v[1]) + (v[2] + v[3]); }
        const float rs = rsqrtf(ss * (1.f / DM) + EPS);
        f32x4 gl = (f32x4){0.f, 0.f, 0.f, 0.f};
#pragma unroll
        for (int ks = 0; ks < 4; ++ks) gl = gl + *(const f32x4*)(PART + ((size_t)ks * M + row) * 64);
        int gi = 0; float gm = -1e30f; float glv[4];
#pragma unroll
        for (int g = 0; g < 4; ++g) { glv[g] = gl[g] * rs + b_group[g]; if (glv[g] > gm) { gm = glv[g]; gi = g; } }
        float den = 0.f;
#pragma unroll
        for (int g = 0; g < 4; ++g) den += expf(glv[g] - gm);
        const float pg = 1.f / den;
        f32x4 e0 = (f32x4){0.f, 0.f, 0.f, 0.f}, e1 = e0;
#pragma unroll
        for (int ks = 0; ks < 4; ++ks) { const float* pp = PART + ((size_t)ks * M + row) * 64 + 4 + gi * 8; e0 = e0 + *(const f32x4*)pp; e1 = e1 + *(const f32x4*)(pp + 4); }
        float v0 = -1e30f, v1 = -1e30f; int i0 = 0, i1 = 0;
#pragma unroll
        for (int e = 0; e < 8; ++e) { const float v = (e < 4 ? e0[e & 3] : e1[e & 3]) * rs + b_expert[gi * 8 + e];
            if (v > v0) { v1 = v0; i1 = i0; v0 = v; i0 = e; } else if (v > v1) { v1 = v; i1 = e; } }
        const float ex = expf(v1 - v0), w0 = pg / (1.f + ex), w1 = pg * ex / (1.f + ex);
        const int x0 = gi * 8 + i0, x1 = gi * 8 + i1;
        RS1[row] = rs; TE[row * 2] = x0; TE[row * 2 + 1] = x1; TW[row * 2] = w0; TW[row * 2 + 1] = w1;
        float* LRS = (float*)(ws + WS_LRS); float* LTW = (float*)(ws + WS_LTW);
        const unsigned p0 = atomicAdd(&CNT[x0], 1u); LIST[(size_t)x0 * M + p0] = row * 2; LRS[(size_t)x0 * M + p0] = rs; LTW[(size_t)x0 * M + p0] = w0;
        const unsigned p1 = atomicAdd(&CNT[x1], 1u); LIST[(size_t)x1 * M + p1] = row * 2 + 1; LRS[(size_t)x1 * M + p1] = rs; LTW[(size_t)x1 * M + p1] = w1;
    }
}
__device__ __forceinline__ g8::MoeTab moe_tables(Frame& F) {
    LAS int* tab = (LAS int*)(F.lds + LTAB_OFF); const int tid = F.wave * 64 + lane_id();
    const unsigned* CNT = (const unsigned*)(F.ws + WS_CNT);
    __syncthreads();
    if (tid < 32) tab[384 + tid] = (int)__hip_atomic_load(CNT + tid, __ATOMIC_RELAXED, __HIP_MEMORY_SCOPE_AGENT);
    __syncthreads();
    if (tid == 0) { int nt = 0;
        for (int e = 0; e < NE; ++e) { const int n = tab[384 + e]; for (int r = 0; r < n && nt < 192; r += 256) { tab[nt] = e; tab[192 + nt] = r; ++nt; } }
        tab[416] = nt; }
    __syncthreads();
    g8::MoeTab T; T.texp = tab; T.trow0 = tab + 192; T.tcnt = tab + 384; T.ntile = tab[416];
    return T;
}
__device__ __forceinline__ void p7_combine(Frame& F) {
    unsigned char* ws = F.ws;
    bf16_t* H = (bf16_t*)(ws + WS_B); const bf16_t* Y0 = (const bf16_t*)(ws + WS_A); const bf16_t* Y1 = (const bf16_t*)(ws + WS_D); float* RS2 = (float*)(ws + WS_RS2); unsigned char* H28 = ws + WS_H28;
    const int gw = F.vcu * NWAVES + F.wave, NGW = F.G * NWAVES, lane = lane_id();
    for (int row = gw; row < M; row += NGW) {
        float ss = 0.f;
#pragma unroll
        for (int j = 0; j < 4; ++j) { const size_t o = (size_t)row * DM + j * 512 + lane * 8;
            const u32x4 hv = *(const u32x4*)(H + o); const u32x2 y0 = *(const u32x2*)((const unsigned char*)Y0 + o), y1 = *(const u32x2*)((const unsigned char*)Y1 + o);
            const f32x4 a = g8::bf4lo(hv.x, hv.y) + (unpack4_fp8(y0.x) + unpack4_fp8(y1.x)) * (1.f / F8_Y), b = g8::bf4lo(hv.z, hv.w) + (unpack4_fp8(y0.y) + unpack4_fp8(y1.y)) * (1.f / F8_Y);
            ss += dot4(a) + dot4(b);
            *(u32x4*)(H + o) = pack8(a, b);
            u32x2 w8; w8.x = pack4_fp8(a, F8_H); w8.y = pack4_fp8(b, F8_H); *(u32x2*)(H28 + o) = w8; }
        ss = wave_sum(ss);
        if (lane == 0) RS2[row] = rsqrtf(ss * (1.f / DM) + EPS);
    }
}

__global__ void __launch_bounds__(NTHR, 2) mk_fwd(Args args) {
    extern __shared__ __attribute__((aligned(16))) unsigned char lds_raw[];
    Frame F;
    F.lds = (LAS unsigned char*)lds_raw; F.MISC = (volatile LAS unsigned*)(F.lds + LCTL_OFF); F.ws = args.ws;
    F.wave = __builtin_amdgcn_readfirstlane(threadIdx.x >> 6);
    F.G = gridDim.x; { const int bx = blockIdx.x; F.vcu = (F.G % 8 == 0) ? (bx % 8) * (F.G / 8) + bx / 8 : bx; }
    unsigned char* ws = args.ws;
    if (threadIdx.x < 32) F.MISC[threadIdx.x] = 0u;
    __syncthreads();
    XcdBarrier bar = xcd_barrier_post((unsigned*)(ws + WS_BAR) + args.li * XCD_BAR_WORDS, F.MISC + 8);
    const int lo = args.ph_lo, hi = args.ph_hi;
#define IN(k) (lo <= (k) && (k) < hi)
#define SEAM(k) do { if (IN(k) && IN((k) + 1)) xcd_barrier(bar); } while (0)

    bf16_t* XB = (bf16_t*)(ws + WS_A); bf16_t* AO = XB;
    bf16_t* Qb = (bf16_t*)(ws + WS_B); bf16_t* Kb = Qb + (size_t)M * 1024; bf16_t* H = Qb;
    bf16_t* Vb = (bf16_t*)(ws + WS_C); bf16_t* GB = Vb + (size_t)M * 1024;
    bf16_t* CU = (bf16_t*)(ws + WS_D);
    bf16_t* PP = (bf16_t*)(ws + WS_E); bf16_t* PB = (bf16_t*)(ws + WS_PB);
    float* RS0 = (float*)(ws + WS_RS0); float* RS2 = (float*)(ws + WS_RS2);

    if (IN(0)) { p0_prologue(F, args); } SEAM(0);

    if (IN(1)) {
        g8::DenseSched S; S.init(XB, DM * 2, ws + WS_WIN, DM * 2, M, 6144, F.G, (int)blockIdx.x);
        g8::EpiProj E{RS0, args.in[5], args.in[6], Qb, Kb, Vb, GB, CU};
        g8::gemm_phase<g8::EpiProj, g8::DenseSched>(F.lds, F.wave, DM, S, E);
    } SEAM(1);

    if (IN(2)) { p2_conv(F, args); p2_attention(F, args); } SEAM(2);

    if (IN(3)) {
        g8::DenseSched S; S.init(AO, DM * 2, ws + WS_WO, DM * 2, M, DM, F.G, (int)blockIdx.x);
        g8::EpiRes E{args.in[0], H, (float*)(ws + WS_SSQ), ws + WS_H8};
        g8::gemm_phase<g8::EpiRes, g8::DenseSched>(F.lds, F.wave, DM, S, E);
    } SEAM(3);

    if (IN(4)) {
        g8::KSplitSched S{(const char*)H, (const char*)(ws + WS_WR), F.G, (int)blockIdx.x};
        g8::EpiRouter E{(float*)(ws + WS_PART)};
        g8::gemm_phase<g8::EpiRouter, g8::KSplitSched>(F.lds, F.wave, 512, S, E);
    } SEAM(4);

    if (IN(5)) { p5_route(F, args); } SEAM(5);

    if (IN(6)) {
        const g8::MoeTab T = moe_tables(F);
        g8::UpSched S{(const char*)(ws + WS_H8), (const char*)(ws + WS_WUP), (const int*)(ws + WS_LIST), T, F.G, F.vcu};
        g8::EpiUp E{(const float*)(ws + WS_LRS), Vb  , T};
        g8::gemm_phase<g8::EpiUp, g8::UpSched, true>(F.lds, F.wave, DM, S, E, E8_W, E8_H);
    } SEAM(6);

    if (IN(7)) {
        const g8::MoeTab T = moe_tables(F);
        g8::DnSched S{(const char*)Vb, (const char*)(ws + WS_WDN), T, F.G, F.vcu};
        g8::EpiDn E{(const int*)(ws + WS_LIST), (const float*)(ws + WS_LTW), XB  , CU  , T};
        int kdff = DFF; asm volatile("" : "+s"(kdff));
        g8::gemm_phase<g8::EpiDn, g8::DnSched, true>(F.lds, F.wave, kdff, S, E, E8_W, E8_HID);
    } SEAM(7);

    if (IN(8)) { p7_combine(F); } SEAM(8);

    if (IN(9)) {
        { g8::DenseSched S; S.init(PB, PLE * 2, ws + WS_WP, PLE * 2, M, DM, F.G, (int)blockIdx.x);
          g8::EpiBf16 E{PP, DM};
          int kple = PLE; asm volatile("" : "+s"(kple));
          g8::gemm_phase<g8::EpiBf16, g8::DenseSched>(F.lds, F.wave, kple, S, E);
          asm volatile("s_waitcnt vmcnt(0)" ::: "memory"); __syncthreads(); }
        g8::DenseSched S; S.init(ws + WS_H28, DM, ws + WS_WG, DM, M, DM, F.G, (int)blockIdx.x);
        g8::EpiFinal E{H, PP, RS2, args.out};
        g8::gemm_phase<g8::EpiFinal, g8::DenseSched, true>(F.lds, F.wave, DM, S, E, E8_W, E8_H);
    }
#undef IN
#undef SEAM
}


static int mk_grid = 0;
static void launch_mk(Args a, int lo, int hi, int li, hipStream_t stream) {
    a.ph_lo = lo; a.ph_hi = hi; a.li = li; a.pad = 0;
    hipLaunchKernelGGL(mk_fwd, dim3(mk_grid), dim3(NTHR), LDS_BYTES, stream, a);
}

extern "C" void kernel_launch(void* const* d_in, const int* in_sizes, int n_in, void* d_out, int out_size, void* d_ws, size_t ws_size, hipStream_t stream) {
    if (n_in != 27 || ws_size < WS_END) { fprintf(stderr, "kernel_launch: unexpected n_in %d / ws %zu\n", n_in, ws_size); return; }
    if (mk_grid == 0) {
        int dev = 0, cus = 0;
        (void)hipGetDevice(&dev); (void)hipDeviceGetAttribute(&cus, hipDeviceAttributeMultiprocessorCount, dev);
        (void)hipFuncSetAttribute((const void*)mk_fwd, hipFuncAttributeMaxDynamicSharedMemorySize, LDS_BYTES);
        int per_cu = 0; (void)hipOccupancyMaxActiveBlocksPerMultiprocessor(&per_cu, (const void*)mk_fwd, NTHR, LDS_BYTES); (void)hipGetLastError();
        mk_grid = 256;
        if (cus != 256 || per_cu < 1) fprintf(stderr, "kernel_launch: note: %d CUs, occupancy query %d; built for 256 CUs x 1 workgroup\n", cus, per_cu);
    }
    float* out = (float*)d_out; unsigned char* ws = (unsigned char*)d_ws;
    (void)in_sizes; (void)out_size;
    (void)hipMemsetAsync(ws + WS_CTL, 0, 1 * MiB, stream);
    Args a{};
    for (int i = 0; i < 27; ++i) a.in[i] = (const float*)d_in[i];
    a.out = out; a.ws = ws;
    launch_mk(a, 0, 10, 0, stream);
}
```

```cpp
#include <hip/hip_runtime.h>
#include <cstdint>
#include <cstdio>

typedef unsigned short bf16_t;
typedef float f32x4 __attribute__((ext_vector_type(4)));

constexpr int BATCH = 4, SEQ = 4096, DM = 2048, M = BATCH * SEQ;
constexpr int NH = 8, DQK = 64, DV = 128, DATT = 1024, DCONV = 1024;
constexpr int NE = 32, NG = 4, EPG = 8, DFF = 512, PLE = 256;
constexpr float EPS = 1e-6f;
constexpr float LOG2E = 1.4426950408889634f;
constexpr float LAM_INIT = 0.2f;
constexpr int BT_N = 320;

constexpr size_t MiB = 1u << 20;
constexpr size_t WS_CTL = 0;
constexpr size_t WS_BT = 64 * 1024;
constexpr size_t WS_LAM = WS_BT + 16 * 1024;
constexpr size_t WS_CNT = 128 * 1024;
constexpr size_t WS_W = 1 * MiB;
constexpr size_t WS_A = 236 * MiB;
constexpr size_t WS_B = 300 * MiB;
constexpr size_t WS_C = 364 * MiB;
constexpr size_t WS_D = 428 * MiB;
constexpr size_t WS_E = 492 * MiB;
constexpr size_t WS_PB = 556 * MiB;
constexpr size_t WS_SM = 564 * MiB;
constexpr size_t WS_RS0 = WS_SM, WS_RS1 = WS_SM + 64 * 1024, WS_RS2 = WS_SM + 128 * 1024;
constexpr size_t WS_TE = WS_SM + 192 * 1024;
constexpr size_t WS_TW = WS_SM + 320 * 1024;
constexpr size_t WS_LIST = WS_SM + 1 * MiB;
constexpr size_t WS_END = 576 * MiB;

__device__ __forceinline__ float bf2f(bf16_t v) { return __uint_as_float((unsigned)v << 16); }
__device__ __forceinline__ bf16_t f2bf(float f) { unsigned u = __float_as_uint(f); return (bf16_t)((u + 0x7fffu + ((u >> 16) & 1u)) >> 16); }

__device__ __forceinline__ int rel_bucket(int rel) {
    int ret = rel > 0 ? 16 : 0; int n = rel < 0 ? -rel : rel;
    if (n < 8) return ret + n;
    int l = 31 - __clz(n * n) + 2; if (l > 15) l = 15;
    return ret + l;
}

__device__ __forceinline__ float block_sum(float v, float* red) {
    for (int o = 32; o > 0; o >>= 1) v += __shfl_xor(v, o);
    const int w = threadIdx.x >> 6, nw = blockDim.x >> 6;
    __syncthreads();
    if ((threadIdx.x & 63) == 0) red[w] = v;
    __syncthreads();
    float s = 0.f; for (int i = 0; i < nw; ++i) s += red[i];
    return s;
}


#define GAS __attribute__((address_space(1)))
#define LAS __attribute__((address_space(3)))
typedef short bf16x8 __attribute__((ext_vector_type(8)));
typedef unsigned u32x4 __attribute__((ext_vector_type(4)));
typedef unsigned u32x2 __attribute__((ext_vector_type(2)));
typedef float f32x16 __attribute__((ext_vector_type(16)));
typedef GAS unsigned gu32;
#define RLX_AGENT __ATOMIC_RELAXED, __HIP_MEMORY_SCOPE_AGENT

constexpr int NWAVES = 8, NTHR = 512;
constexpr int RING_BYTES = 131072;
constexpr int LCTL_OFF = 145408;
constexpr int LBT_OFF = LCTL_OFF + 128;
constexpr int LLS_OFF = LBT_OFF + 1280;
constexpr int LTAB_OFF = LCTL_OFF + 128;
constexpr int LDS_BYTES = 149504;
static_assert(LLS_OFF + 1024 <= LDS_BYTES && LTAB_OFF + (192 + 192 + 32) * 4 <= LDS_BYTES, "LDS map");

constexpr size_t WS_BAR = 256 * 1024;
constexpr size_t WS_WIN = WS_W;
constexpr size_t WS_WO = WS_WIN + 24 * MiB;
constexpr size_t WS_WG = WS_WO + 8 * MiB;
constexpr size_t WS_WP = WS_WG + 8 * MiB;
constexpr size_t WS_WUP = WS_WP + 1 * MiB;
constexpr size_t WS_WDN = WS_WUP + 128 * MiB;
constexpr size_t WS_WR = WS_WDN + 64 * MiB;
constexpr size_t WS_AO = WS_WUP + 64 * MiB;
static_assert(WS_WR + 1 * MiB <= WS_A, "weight region");
constexpr size_t WS_LRS = WS_SM + 6 * MiB, WS_LTW = WS_SM + 8 * MiB;
constexpr size_t WS_SSQ = WS_SM + 4 * MiB;
constexpr size_t WS_H8 = WS_E + 32 * MiB;
constexpr size_t WS_H28 = WS_C + 32 * MiB;
constexpr size_t WS_PART = WS_E;

__device__ __forceinline__ int lane_id() { return (int)__builtin_amdgcn_mbcnt_hi(~0u, __builtin_amdgcn_mbcnt_lo(~0u, 0u)); }
__device__ __forceinline__ int lane_id_fresh() { unsigned z = 0u; asm volatile("" : "+v"(z)); return (int)__builtin_amdgcn_mbcnt_hi(~0u, __builtin_amdgcn_mbcnt_lo(~0u, z)); }
typedef float f32x2_t __attribute__((ext_vector_type(2))); typedef __bf16 bf16x2_t __attribute__((ext_vector_type(2)));
__device__ __forceinline__ unsigned cvt_pk_bf16(float lo, float hi) { const f32x2_t v = {lo, hi}; const bf16x2_t b = __builtin_convertvector(v, bf16x2_t); return __builtin_bit_cast(unsigned, b); }
typedef int v8i_t __attribute__((ext_vector_type(8)));
typedef int v4i_t __attribute__((ext_vector_type(4)));
__device__ __forceinline__ unsigned pack4_fp8(f32x4 v, float sc) {
    int w = 0;
    const float a = __builtin_amdgcn_fmed3f(v[0] * sc, -448.f, 448.f), b = __builtin_amdgcn_fmed3f(v[1] * sc, -448.f, 448.f);
    const float c = __builtin_amdgcn_fmed3f(v[2] * sc, -448.f, 448.f), d = __builtin_amdgcn_fmed3f(v[3] * sc, -448.f, 448.f);
    w = __builtin_amdgcn_cvt_pk_fp8_f32(a, b, w, false); w = __builtin_amdgcn_cvt_pk_fp8_f32(c, d, w, true);
    return (unsigned)w;
}
__device__ __forceinline__ f32x4 unpack4_fp8(unsigned w) { const int iw = (int)w;
    return (f32x4){__builtin_amdgcn_cvt_f32_fp8(iw, 0), __builtin_amdgcn_cvt_f32_fp8(iw, 1), __builtin_amdgcn_cvt_f32_fp8(iw, 2), __builtin_amdgcn_cvt_f32_fp8(iw, 3)}; }
constexpr float F8_W = 256.f, F8_H = 16.f, F8_HID = 8.f, F8_Y = 32.f;
constexpr int E8_W = 0x77777777, E8_H = 0x7b7b7b7b, E8_HID = 0x7c7c7c7c;
__device__ __forceinline__ float fast_sigmoid(float z) { return __builtin_amdgcn_rcpf(1.f + __builtin_amdgcn_exp2f(-LOG2E * z)); }

__device__ __forceinline__ u32x4 pack8(f32x4 a, f32x4 b) { u32x4 w; w.x = cvt_pk_bf16(a[0], a[1]); w.y = cvt_pk_bf16(a[2], a[3]); w.z = cvt_pk_bf16(b[0], b[1]); w.w = cvt_pk_bf16(b[2], b[3]); return w; }
__device__ __forceinline__ float dot4(f32x4 a) { return (a[0] * a[0] + a[1] * a[1]) + (a[2] * a[2] + a[3] * a[3]); }

#define XB_TMO      128
#define XB_XCNT(j)  (256  + 64 * (j))
#define XB_XSUB(j)  (1280 + 64 * (j))
#define XB_XGEN(j)  (2304 + 64 * (j))
#define XB_TOP      3328
#define XB_TOPGEN   3392
#define XCD_BAR_WORDS 3456
#define XB_SPIN_CAP (1u << 18)
__device__ __forceinline__ unsigned xb_ld(unsigned* p)              { return __hip_atomic_load(p, __ATOMIC_RELAXED, __HIP_MEMORY_SCOPE_AGENT); }
__device__ __forceinline__ unsigned xb_add(unsigned* p, unsigned v) { return __hip_atomic_fetch_add(p, v, __ATOMIC_RELAXED, __HIP_MEMORY_SCOPE_AGENT); }
__device__ __forceinline__ unsigned xb_xcc_id() { return (unsigned)__builtin_amdgcn_s_getreg((3 << 11) | 20) & 0xFu; }
#define XB_SPIN(cond, bar) do { unsigned _sp = 0; while (cond) { __builtin_amdgcn_s_sleep(1); \
    if ((++_sp & 255u) == 0u) { if (xb_ld(&(bar)[XB_TMO])) break; if (_sp > XB_SPIN_CAP) { atomicAdd(&(bar)[XB_TMO], 1u); break; } } } } while (0)
struct XcdBarrier { unsigned* bar; unsigned x; volatile LAS unsigned* st; };
__device__ __forceinline__ XcdBarrier xcd_barrier_post(unsigned* bar, volatile LAS unsigned* st) {
    XcdBarrier b; b.bar = bar; b.x = xb_xcc_id(); b.st = st;
    if (threadIdx.x == 0) (void)xb_add(&bar[XB_XCNT(b.x)], 1u);
    return b;
}
__device__ __forceinline__ void xcd_barrier_complete(unsigned* bar, unsigned x, unsigned& nloc, unsigned& nx) {
    const unsigned G = gridDim.x * gridDim.y * gridDim.z;
    unsigned sum, cnt, mine, sp = 0u;
    for (;;) {
        sum = 0u; cnt = 0u; mine = 0u;
#pragma unroll
        for (unsigned j = 0; j < 16; ++j) { const unsigned c = xb_ld(&bar[XB_XCNT(j)]); sum += c; cnt += (c > 0u) ? 1u : 0u; mine = (j == x) ? c : mine; }
        if (sum == G) break;
        __builtin_amdgcn_s_sleep(1);
        if ((++sp & 255u) == 0u) { if (xb_ld(&bar[XB_TMO])) break; if (sp > XB_SPIN_CAP) { atomicAdd(&bar[XB_TMO], 1u); break; } }
    }
    nloc = mine > 0u ? mine : 1u; nx = cnt > 0u ? cnt : 1u;
}
__device__ __forceinline__ void xcd_barrier(const XcdBarrier& b) {
    asm volatile("s_waitcnt vmcnt(0)" ::: "memory");
    __syncthreads();
    if (threadIdx.x == 0) {
        unsigned* bar = b.bar;
        __builtin_amdgcn_s_waitcnt(0);
        unsigned nloc = b.st[0], nx = b.st[1];
        if (nloc == 0u) { xcd_barrier_complete(bar, b.x, nloc, nx); b.st[0] = nloc; b.st[1] = nx; }
        const unsigned old = xb_add(&bar[XB_XSUB(b.x)], 1u);
        const unsigned gen = old / nloc;
        if (old + 1u == (gen + 1u) * nloc) {
            __builtin_amdgcn_fence(__ATOMIC_RELEASE, "agent");
            asm volatile("s_waitcnt vmcnt(0)" ::: "memory");
            const unsigned og = xb_add(&bar[XB_TOP], 1u);
            const unsigned tg = og / nx;
            if (og + 1u == (tg + 1u) * nx) xb_add(&bar[XB_TOPGEN], 1u);
            else XB_SPIN(xb_ld(&bar[XB_TOPGEN]) == tg, bar);
            __builtin_amdgcn_fence(__ATOMIC_ACQUIRE, "agent");
            xb_add(&bar[XB_XGEN(b.x)], 1u);
            asm volatile("s_waitcnt vmcnt(0)" ::: "memory");
        } else {
            XB_SPIN(xb_ld(&bar[XB_XGEN(b.x)]) == gen, bar);
            __builtin_amdgcn_fence(__ATOMIC_ACQUIRE, "agent");
            asm volatile("s_waitcnt vmcnt(0)" ::: "memory");
        }
    }
    __syncthreads();
}

namespace g8 {
constexpr int BM = 256, BK = 64, HALF = 128, HTB = HALF * BK * 2, STAGE_BYTES = 8 * HTB;
static_assert(STAGE_BYTES == RING_BYTES, "ring");
__host__ __device__ __forceinline__ int lds_byte(int r, int c) { const int st = (r >> 4) * 2 + (c >> 5), rr = r & 15, cc = c & 31, ob = rr * 64 + cc * 2; return st * 1024 + (ob ^ (((ob >> 9) & 1) << 5)); }
__host__ __device__ __forceinline__ void stage_rc(int b, int& R, int& C) { const int st = b / 1024, sb = b % 1024, swz = sb ^ (((sb >> 9) & 1) << 5); R = (st >> 1) * 16 + swz / 64; C = (st & 1) * 32 + (swz % 64) / 2; }
struct Unit { int pm, pn, e; };

struct DenseSched {
    static constexpr bool GATHER = false;
    const char* A; const char* Bt; int lda, ldb; int nM, nN, nwg, G, c;
    __device__ __forceinline__ void init(const void* A_, int lda_, const void* Bt_, int ldb_, int Mrows, int N, int G_, int c_) { A = (const char*)A_; Bt = (const char*)Bt_; lda = lda_; ldb = ldb_; nM = Mrows / BM; nN = N / BM; nwg = nM * nN; G = G_; c = c_; }
    __device__ __forceinline__ bool next(int i, Unit& u) const {
        const long L = (long)i * G + c; if (L >= nwg) return false;
        int wgid = (int)L; { const int q = nwg / 8, r = nwg % 8, xcd = wgid % 8, off = wgid / 8; wgid = (xcd < r ? xcd * (q + 1) : r * (q + 1) + (xcd - r) * q) + off; }
        const int nig = 8 * nN, gid = wgid / nig, fm = gid * 8, gsz = (nM - fm) < 8 ? (nM - fm) : 8;
        u.pm = fm + ((wgid % nig) % gsz); u.pn = (wgid % nig) / gsz; u.e = 0; return true;
    }
    __device__ __forceinline__ const char* a_base(const Unit& u) const { return A + (size_t)u.pm * BM * lda; }
    __device__ __forceinline__ const char* b_base(const Unit& u) const { return Bt + (size_t)u.pn * BM * ldb; }
    __device__ __forceinline__ unsigned a_off(const Unit&, int row, int C) const { return (unsigned)(row * lda + C * 2); }
    __device__ __forceinline__ unsigned b_off(int row, int C) const { return (unsigned)(row * ldb + C * 2); }
};

template <class Epi, class Sched, bool F8 = false>
__device__ __forceinline__ void gemm_phase(LAS unsigned char* lds, const int wid, const int K, const Sched& S, const Epi& E, const int sclW = 0, const int sclA = 0) {
    const int lane = lane_id(), tid = wid * 64 + lane, wr = wid >> 2, wc = wid & 3, fr = lane & 15, fq = lane >> 4;
    const int nt = F8 ? K / 128 : K / BK;
    int Rr[2], Cc[2];
#pragma unroll
    for (int i = 0; i < 2; ++i) stage_rc(tid * 16 + i * 8192, Rr[i], Cc[i]);
    unsigned voffB[2];
#pragma unroll
    for (int i = 0; i < 2; ++i) voffB[i] = S.b_off(Rr[i], Cc[i]);
    const size_t kstep = (size_t)(BK * 2);
    const size_t hstepB = (size_t)S.b_off(HALF, 0);
    const unsigned ldsw = (unsigned)wid * 1024u;
    const int aoff = lds_byte(wr * 64 + fr, fq * 8), boff = lds_byte(wc * 32 + fr, fq * 8);
#define G8_SA(b, h) (((b) * 2 + (h)) * HTB)
#define G8_SB(b, h) ((4 + (b) * 2 + (h)) * HTB)
#define G8_STAGE(bufoff, gbase, voff) do { _Pragma("unroll") for (int _i = 0; _i < 2; ++_i) { unsigned _o = (voff)[_i]; asm volatile("" : "+v"(_o));     \
        __builtin_amdgcn_global_load_lds((const unsigned*)((const char*)(gbase) + _o), (LAS unsigned*)(lds + (bufoff) + ldsw + _i * 8192), 16, 0, 0); } } while (0)
#define G8_LD32(p) __builtin_shufflevector(*(const LAS v4i_t*)(p), *(const LAS v4i_t*)((p) + 1024), 0, 1, 2, 3, 4, 5, 6, 7)
#define G8_LDA(dst, b, h) do { _Pragma("unroll") for (int m = 0; m < 4; ++m) dst[m] = G8_LD32(lds + G8_SA(b, h) + aoff + m * 2048); } while (0)
#define G8_LDB(dst, b, h) do { _Pragma("unroll") for (int n = 0; n < 2; ++n) dst[n] = G8_LD32(lds + G8_SB(b, h) + boff + n * 2048); } while (0)
#define G8_LO(x) __builtin_bit_cast(bf16x8, __builtin_shufflevector(x, x, 0, 1, 2, 3))
#define G8_HI(x) __builtin_bit_cast(bf16x8, __builtin_shufflevector(x, x, 4, 5, 6, 7))
#define G8_MMA(ai, bj, At, Bt) do { __builtin_amdgcn_s_setprio(1); _Pragma("unroll") for (int m = 0; m < 4; ++m) _Pragma("unroll") for (int n = 0; n < 2; ++n) { \
        if constexpr (F8) acc[ai][bj][m][n] = __builtin_amdgcn_mfma_scale_f32_16x16x128_f8f6f4(Bt[n], At[m], acc[ai][bj][m][n], 0, 0, 0, sclW, 0, sclA); \
        else { acc[ai][bj][m][n] = __builtin_amdgcn_mfma_f32_16x16x32_bf16(G8_LO(Bt[n]), G8_LO(At[m]), acc[ai][bj][m][n], 0, 0, 0); \
               acc[ai][bj][m][n] = __builtin_amdgcn_mfma_f32_16x16x32_bf16(G8_HI(Bt[n]), G8_HI(At[m]), acc[ai][bj][m][n], 0, 0, 0); } } \
        __builtin_amdgcn_s_setprio(0); } while (0)
#define G8_WAIT_V(n) asm volatile("s_waitcnt vmcnt(" #n ")" ::: "memory")
#define G8_WAIT_L(n) asm volatile("s_waitcnt lgkmcnt(" #n ")" ::: "memory")
#define G8_BAR __builtin_amdgcn_s_barrier()
#define G8_SCHED __builtin_amdgcn_sched_barrier(0)
    Unit cur, nxt; int ui = 0;
    if (!S.next(0, cur)) return;
    f32x4 acc[2][2][4][2];
#pragma unroll
    for (int a = 0; a < 2; ++a)
#pragma unroll
        for (int b = 0; b < 2; ++b)
#pragma unroll
            for (int m = 0; m < 4; ++m)
#pragma unroll
                for (int n = 0; n < 2; ++n) acc[a][b][m][n] = (f32x4){0.f, 0.f, 0.f, 0.f};
    v8i_t At[4], B0[2], B1[2];
    unsigned cvA[2][2];
#define G8_NVSLOT ((LAS u32x4*)(lds + RING_BYTES) + (lane_id_fresh() + wid * 64))
#pragma unroll
    for (int h = 0; h < 2; ++h)
#pragma unroll
        for (int i = 0; i < 2; ++i) cvA[h][i] = S.a_off(cur, h * HALF + Rr[i], Cc[i]);
    const char* cA = S.a_base(cur); const char* cB = S.b_base(cur);
    G8_STAGE(G8_SB(0, 0), cB, voffB); G8_STAGE(G8_SB(0, 1), cB + hstepB, voffB); G8_STAGE(G8_SA(0, 0), cA, cvA[0]); G8_STAGE(G8_SA(0, 1), cA, cvA[1]);
    if (wr == 1) G8_BAR;
    G8_WAIT_V(2); G8_BAR;
    G8_STAGE(G8_SB(1, 0), cB + kstep, voffB); G8_STAGE(G8_SA(1, 0), cA + kstep, cvA[0]); G8_STAGE(G8_SB(1, 1), cB + hstepB + kstep, voffB);
    G8_WAIT_V(6); G8_BAR;
    LAS unsigned char* const metab = lds + RING_BYTES + 8192;
    for (;;) {
        E.meta_issue(cur, metab + (ui & 1) * 2048, wid);
        const bool has_next = S.next(ui + 1, nxt);
        const char* nA = has_next ? S.a_base(nxt) : cA; const char* nB = has_next ? S.b_base(nxt) : cB;
        if constexpr (Sched::GATHER) {
            const int t2 = lane_id_fresh() + wid * 64;
            int R0, C0, R1, C1; stage_rc(t2 * 16, R0, C0); stage_rc(t2 * 16 + 8192, R1, C1);
            u32x4 nv;
            nv.x = has_next ? S.a_off(nxt, R0, C0) : cvA[0][0]; nv.y = has_next ? S.a_off(nxt, R1, C1) : cvA[0][1];
            nv.z = has_next ? S.a_off(nxt, HALF + R0, C0) : cvA[1][0]; nv.w = has_next ? S.a_off(nxt, HALF + R1, C1) : cvA[1][1];
            *((LAS u32x4*)(lds + RING_BYTES) + t2) = nv;
        }
        asm volatile(".p2align 8" ::: "memory");
        for (int t = 0; t < nt; t += 2) {
            const bool last = (t == nt - 2);
            const char* a1 = cA + (size_t)(t + 1) * kstep;
            const char* a2 = last ? nA : cA + (size_t)(t + 2) * kstep; const char* b2 = last ? nB : cB + (size_t)(t + 2) * kstep;
            const char* a3 = a2 + kstep; const char* b3 = b2 + kstep;
            unsigned v2[2][2];
            if (Sched::GATHER && last) { const u32x4 nv = *G8_NVSLOT; v2[0][0] = nv.x; v2[0][1] = nv.y; v2[1][0] = nv.z; v2[1][1] = nv.w; }
            else { v2[0][0] = cvA[0][0]; v2[0][1] = cvA[0][1]; v2[1][0] = cvA[1][0]; v2[1][1] = cvA[1][1]; }
            G8_LDB(B0, 0, 0); G8_LDB(B1, 0, 1); G8_SCHED; G8_LDA(At, 0, 0); G8_STAGE(G8_SA(1, 1), a1, cvA[1]);
            G8_WAIT_V(8); G8_WAIT_L(0); G8_BAR; G8_MMA(0, 0, At, B0); G8_MMA(0, 1, At, B1); G8_BAR; G8_SCHED;
            G8_LDA(At, 0, 1); G8_STAGE(G8_SB(0, 0), b2, voffB); G8_STAGE(G8_SB(0, 1), b2 + hstepB, voffB); G8_STAGE(G8_SA(0, 0), a2, v2[0]);
            G8_WAIT_V(8); G8_WAIT_L(0); G8_BAR; G8_MMA(1, 0, At, B0); G8_MMA(1, 1, At, B1); G8_BAR; G8_SCHED;
            G8_LDB(B0, 1, 0); G8_LDB(B1, 1, 1); G8_SCHED; G8_LDA(At, 1, 0); G8_STAGE(G8_SA(0, 1), a2, v2[1]);
            G8_WAIT_V(8); G8_WAIT_L(0); G8_BAR; G8_MMA(0, 0, At, B0); G8_MMA(0, 1, At, B1); G8_BAR; G8_SCHED;
            G8_LDA(At, 1, 1); G8_STAGE(G8_SB(1, 0), b3, voffB); G8_STAGE(G8_SB(1, 1), b3 + hstepB, voffB); G8_STAGE(G8_SA(1, 0), a3, v2[0]);
            G8_WAIT_V(8); G8_WAIT_L(0); G8_BAR; G8_MMA(1, 0, At, B0); G8_MMA(1, 1, At, B1); G8_BAR; G8_SCHED;
        }
        if (wr == 0) G8_BAR;
        { const int lf = lane_id_fresh(); E(acc, cur, wr, wc, lf & 15, lf >> 4, (const LAS float*)(metab + (ui & 1) * 2048)); }
        if (!has_next) break;
#pragma unroll
        for (int a = 0; a < 2; ++a)
#pragma unroll
            for (int b = 0; b < 2; ++b)
#pragma unroll
                for (int m = 0; m < 4; ++m)
#pragma unroll
                    for (int n = 0; n < 2; ++n) acc[a][b][m][n] = (f32x4){0.f, 0.f, 0.f, 0.f};
        cur = nxt; cA = nA; cB = nB; ++ui;
        if constexpr (Sched::GATHER) { const u32x4 nv = *G8_NVSLOT; cvA[0][0] = nv.x; cvA[0][1] = nv.y; cvA[1][0] = nv.z; cvA[1][1] = nv.w; }
        if (wr == 1) G8_BAR;
    }
    G8_WAIT_V(0);
    G8_BAR;
#undef G8_SA
#undef G8_SB
#undef G8_STAGE
#undef G8_LDA
#undef G8_LDB
#undef G8_MMA
#undef G8_NVSLOT
#undef G8_LO
#undef G8_HI
#undef G8_LD32
#undef G8_WAIT_V
#undef G8_WAIT_L
#undef G8_BAR
#undef G8_SCHED
}

#define G8_META_DMA(srcptr, mbuf, col, wid) do { if ((wid) < 4) __builtin_amdgcn_global_load_lds((const unsigned*)(srcptr), (LAS unsigned*)((mbuf) + (col) * 1024 + (wid) * 256), 4, 0, 0); } while (0)

struct EpiProj {
    const float* rs0; const float* g_q; const float* g_k; bf16_t *Q, *Kb, *V, *GB, *CU;
    __device__ __forceinline__ void meta_issue(const Unit& u, LAS unsigned char* mb, int wid) const { G8_META_DMA(rs0 + u.pm * BM + wid * 64 + lane_id_fresh(), mb, 0, wid); }
    __device__ __forceinline__ void operator()(f32x4 (&acc)[2][2][4][2], const Unit& u, int wr, int wc, int fr, int fq, const LAS float* meta) const {
        const int pn = u.pn, rbase = u.pm * BM + wr * 64 + fr;
        float rsv[2][4];
#pragma unroll
        for (int ai = 0; ai < 2; ++ai)
#pragma unroll
            for (int m = 0; m < 4; ++m) rsv[ai][m] = meta[ai * HALF + wr * 64 + m * 16 + fr];
        if (pn < 8) {
            const bool isq = pn < 4; const float* gn = isq ? g_q : g_k; const float sc = isq ? 0.125f * LOG2E : 1.f;
            bf16_t* O = isq ? Q : Kb; const int colb = (pn & 3) * 256 + wc * 64 + fq * 8;
            f32x4 gv[2][2];
#pragma unroll
            for (int bj = 0; bj < 2; ++bj)
#pragma unroll
                for (int n = 0; n < 2; ++n) gv[bj][n] = *(const f32x4*)(gn + bj * 32 + fq * 8 + n * 4);
#pragma unroll
            for (int ai = 0; ai < 2; ++ai)
#pragma unroll
                for (int m = 0; m < 4; ++m) {
                    const int row = rbase + ai * HALF + m * 16; const float rs = rsv[ai][m];
                    float ss = 0.f;
#pragma unroll
                    for (int bj = 0; bj < 2; ++bj)
#pragma unroll
                        for (int n = 0; n < 2; ++n) { acc[ai][bj][m][n] = acc[ai][bj][m][n] * rs; ss += dot4(acc[ai][bj][m][n]); }
                    ss += __shfl_xor(ss, 16); ss += __shfl_xor(ss, 32);
                    const float r = rsqrtf(ss * (1.f / 64.f) + EPS) * sc;
#pragma unroll
                    for (int bj = 0; bj < 2; ++bj) *(u32x4*)(O + (size_t)row * 1024 + colb + bj * 32) = pack8(acc[ai][bj][m][0] * r * gv[bj][0], acc[ai][bj][m][1] * r * gv[bj][1]);
                }
        } else if (pn < 16) {
            bf16_t* O = pn < 12 ? V : GB; const int colb = (pn & 3) * 256 + wc * 32 + fq * 8;
#pragma unroll
            for (int ai = 0; ai < 2; ++ai)
#pragma unroll
                for (int m = 0; m < 4; ++m) {
                    const int row = rbase + ai * HALF + m * 16; const float rs = rsv[ai][m];
#pragma unroll
                    for (int bj = 0; bj < 2; ++bj) *(u32x4*)(O + (size_t)row * 1024 + colb + bj * 128) = pack8(acc[ai][bj][m][0] * rs, acc[ai][bj][m][1] * rs);
                }
        } else {
            const int colb = (pn - 16) * 128 + wc * 32 + fq * 8;
#pragma unroll
            for (int ai = 0; ai < 2; ++ai)
#pragma unroll
                for (int m = 0; m < 4; ++m) {
                    const int row = rbase + ai * HALF + m * 16; const float rs = rsv[ai][m], rs2 = rs * rs;
                    *(u32x4*)(CU + (size_t)row * 1024 + colb) = pack8(acc[ai][0][m][0] * acc[ai][1][m][0] * rs2, acc[ai][0][m][1] * acc[ai][1][m][1] * rs2);
                }
        }
    }
};
struct EpiBf16 {
    bf16_t* O; int ldo;
    __device__ __forceinline__ void meta_issue(const Unit&, LAS unsigned char*, int) const {}
    __device__ __forceinline__ void operator()(f32x4 (&acc)[2][2][4][2], const Unit& u, int wr, int wc, int fr, int fq, const LAS float* meta) const {
        const int rbase = u.pm * BM + wr * 64 + fr, colb = u.pn * BM + wc * 32 + fq * 8;
#pragma unroll
        for (int ai = 0; ai < 2; ++ai)
#pragma unroll
            for (int m = 0; m < 4; ++m) { const int row = rbase + ai * HALF + m * 16;
#pragma unroll
                for (int bj = 0; bj < 2; ++bj) *(u32x4*)(O + (size_t)row * ldo + colb + bj * 128) = pack8(acc[ai][bj][m][0], acc[ai][bj][m][1]); }
    }
};
struct EpiRes {
    __device__ __forceinline__ void meta_issue(const Unit&, LAS unsigned char*, int) const {}
    const bf16_t* xb; bf16_t* H; float* SSQ; unsigned char* H8;
    __device__ __forceinline__ void operator()(f32x4 (&acc)[2][2][4][2], const Unit& u, int wr, int wc, int fr, int fq, const LAS float* meta) const {
        const int rbase = u.pm * BM + wr * 64 + fr, colb = u.pn * BM + wc * 32 + fq * 8;
        u32x4 xa[2][4][2];
#pragma unroll
        for (int ai = 0; ai < 2; ++ai)
#pragma unroll
            for (int m = 0; m < 4; ++m)
#pragma unroll
                for (int bj = 0; bj < 2; ++bj) xa[ai][m][bj] = *(const u32x4*)(xb + (size_t)(rbase + ai * HALF + m * 16) * DM + colb + bj * 128);
#pragma unroll
        for (int ai = 0; ai < 2; ++ai)
#pragma unroll
            for (int m = 0; m < 4; ++m) { const int row = rbase + ai * HALF + m * 16; float ss = 0.f;
#pragma unroll
                for (int bj = 0; bj < 2; ++bj) { const size_t o = (size_t)row * DM + colb + bj * 128; const u32x4 xw = xa[ai][m][bj];
                    const f32x4 x0 = (f32x4){__uint_as_float(xw.x << 16), __uint_as_float(xw.x & 0xffff0000u), __uint_as_float(xw.y << 16), __uint_as_float(xw.y & 0xffff0000u)};
                    const f32x4 x1 = (f32x4){__uint_as_float(xw.z << 16), __uint_as_float(xw.z & 0xffff0000u), __uint_as_float(xw.w << 16), __uint_as_float(xw.w & 0xffff0000u)};
                    const f32x4 h0 = acc[ai][bj][m][0] + x0, h1 = acc[ai][bj][m][1] + x1;
                    ss += dot4(h0) + dot4(h1);
                    *(u32x4*)(H + o) = pack8(h0, h1);
                    u32x2 w8; w8.x = pack4_fp8(h0, F8_H); w8.y = pack4_fp8(h1, F8_H); *(u32x2*)(H8 + o) = w8; }
                ss += __shfl_xor(ss, 16); ss += __shfl_xor(ss, 32);
                if (fq == 0) SSQ[(size_t)row * 32 + u.pn * 4 + wc] = ss; }
    }
};
struct EpiRouter {
    float* PART;
    __device__ __forceinline__ void meta_issue(const Unit&, LAS unsigned char*, int) const {}
    __device__ __forceinline__ void operator()(f32x4 (&acc)[2][2][4][2], const Unit& u, int wr, int wc, int fr, int fq, const LAS float* meta) const {
        if (wc < 2) {
            const int rbase = u.pm * BM + wr * 64 + fr;
#pragma unroll
            for (int ai = 0; ai < 2; ++ai)
#pragma unroll
                for (int m = 0; m < 4; ++m) { const int row = rbase + ai * HALF + m * 16;
#pragma unroll
                    for (int n = 0; n < 2; ++n) *(f32x4*)(PART + ((size_t)u.e * M + row) * 64 + wc * 32 + n * 16 + fq * 4) = acc[ai][0][m][n]; }
        }
    }
};
struct KSplitSched {
    static constexpr bool GATHER = false;
    const char* A; const char* Bt; int G, c;
    __device__ __forceinline__ bool next(int i, Unit& u) const { const int L = i * G + c; if (L >= (M / BM) * 4) return false; u.pm = L >> 2; u.pn = 0; u.e = L & 3; return true; }
    __device__ __forceinline__ const char* a_base(const Unit& u) const { return A + (size_t)u.pm * BM * DM * 2 + (size_t)u.e * 512 * 2; }
    __device__ __forceinline__ const char* b_base(const Unit& u) const { return Bt + (size_t)u.e * 512 * 2; }
    __device__ __forceinline__ unsigned a_off(const Unit&, int row, int C) const { return (unsigned)(row * DM + C) * 2u; }
    __device__ __forceinline__ unsigned b_off(int row, int C) const { return (unsigned)(row * DM + C) * 2u; }
};
__device__ __forceinline__ f32x4 bf4lo(unsigned a, unsigned b) { return (f32x4){__uint_as_float(a << 16), __uint_as_float(a & 0xffff0000u), __uint_as_float(b << 16), __uint_as_float(b & 0xffff0000u)}; }
struct EpiFinal {
    const bf16_t* H2B; const bf16_t* PP; const float* rs2; float* out;
    __device__ __forceinline__ void meta_issue(const Unit& u, LAS unsigned char* mb, int wid) const { G8_META_DMA(rs2 + u.pm * BM + wid * 64 + lane_id_fresh(), mb, 0, wid); }
    __device__ __forceinline__ void operator()(f32x4 (&acc)[2][2][4][2], const Unit& u, int wr, int wc, int fr, int fq, const LAS float* meta) const {
        const int rbase = u.pm * BM + wr * 64 + fr, colb = u.pn * BM + wc * 32 + fq * 8;
        float rsv[2][4];
#pragma unroll
        for (int ai = 0; ai < 2; ++ai)
#pragma unroll
            for (int m = 0; m < 4; ++m) rsv[ai][m] = meta[ai * HALF + wr * 64 + m * 16 + fr];
        u32x4 hb[2][2][2], pb[2][2][2];
#define EF_LOAD(buf, b) do { _Pragma("unroll") for (int r2 = 0; r2 < 2; ++r2) { const int row_ = rbase + ((b) >> 1) * HALF + (((b) & 1) * 2 + r2) * 16; \
            _Pragma("unroll") for (int bj = 0; bj < 2; ++bj) { const size_t o_ = (size_t)row_ * DM + colb + bj * 128; hb[buf][r2][bj] = *(const u32x4*)(H2B + o_); pb[buf][r2][bj] = *(const u32x4*)(PP + o_); } } } while (0)
        EF_LOAD(0, 0);
#pragma unroll
        for (int b = 0; b < 4; ++b) {
            if (b == 0) EF_LOAD(1, 1); else if (b == 1) EF_LOAD(0, 2); else if (b == 2) EF_LOAD(1, 3);
#pragma unroll
            for (int r2 = 0; r2 < 2; ++r2) { const int ai = b >> 1, m = (b & 1) * 2 + r2, row = rbase + ai * HALF + m * 16; const float rs = rsv[ai][m];
#pragma unroll
                for (int bj = 0; bj < 2; ++bj) { const size_t o = (size_t)row * DM + colb + bj * 128;
                    const u32x4 hv = hb[b & 1][r2][bj], pv = pb[b & 1][r2][bj];
                    const f32x4 h0 = bf4lo(hv.x, hv.y), h1 = bf4lo(hv.z, hv.w), p0 = bf4lo(pv.x, pv.y), p1 = bf4lo(pv.z, pv.w);
                    f32x4 z0 = acc[ai][bj][m][0] * rs, z1 = acc[ai][bj][m][1] * rs, o0, o1;
#pragma unroll
                    for (int j = 0; j < 4; ++j) { o0[j] = h0[j] + p0[j] * fast_sigmoid(z0[j]); o1[j] = h1[j] + p1[j] * fast_sigmoid(z1[j]); }
                    *(f32x4*)(out + o) = o0; *(f32x4*)(out + o + 4) = o1; } }
        }
#undef EF_LOAD
    }
};

struct MoeTab { const LAS int* texp; const LAS int* trow0; const LAS int* tcnt; int ntile; };
struct UpSched {
    static constexpr bool GATHER = true;
    const char* Hb; const char* Wup; const int* LIST; MoeTab T; int G, c;
    __device__ __forceinline__ bool next(int i, Unit& u) const { const int L = i * G + c; if (L >= T.ntile * 4) return false; u.pm = L >> 2; u.pn = L & 3; u.e = T.texp[u.pm]; return true; }
    __device__ __forceinline__ const char* a_base(const Unit&) const { return Hb; }
    __device__ __forceinline__ const char* b_base(const Unit& u) const { return Wup + ((size_t)u.e * 1024 + (size_t)u.pn * 256) * DM; }
    __device__ __forceinline__ unsigned a_off(const Unit& u, int row, int C) const {
        int idx = T.trow0[u.pm] + row; const int n = T.tcnt[u.e]; idx = idx < n ? idx : n - 1;
        const int slot = LIST[(size_t)u.e * M + idx]; return (unsigned)(slot >> 1) * (unsigned)DM + (unsigned)C * 2u; }
    __device__ __forceinline__ unsigned b_off(int row, int C) const { return (unsigned)(row * DM + C * 2); }
};
struct DnSched {
    static constexpr bool GATHER = false;
    const char* HID; const char* Wdn; MoeTab T; int G, c;
    __device__ __forceinline__ bool next(int i, Unit& u) const { const int L = i * G + c; if (L >= T.ntile * 8) return false; u.pm = L >> 3; u.pn = L & 7; u.e = T.texp[u.pm]; return true; }
    __device__ __forceinline__ const char* a_base(const Unit& u) const { return HID + (size_t)u.pm * 256 * DFF; }
    __device__ __forceinline__ const char* b_base(const Unit& u) const { return Wdn + ((size_t)u.e * DM + (size_t)u.pn * 256) * DFF; }
    __device__ __forceinline__ unsigned a_off(const Unit&, int row, int C) const { return (unsigned)(row * DFF + C * 2); }
    __device__ __forceinline__ unsigned b_off(int row, int C) const { return (unsigned)(row * DFF + C * 2); }
};
struct EpiUp {
    const float* LRS; bf16_t* HID; MoeTab T;
    __device__ __forceinline__ void meta_issue(const Unit& u, LAS unsigned char* mb, int wid) const { const int n = T.tcnt[u.e]; int idx = T.trow0[u.pm] + wid * 64 + lane_id_fresh(); idx = idx < n ? idx : n - 1;
        G8_META_DMA(LRS + (size_t)u.e * M + idx, mb, 0, wid); }
    __device__ __forceinline__ void operator()(f32x4 (&acc)[2][2][4][2], const Unit& u, int wr, int wc, int fr, int fq, const LAS float* meta) const {
        const int r0 = T.trow0[u.pm], n = T.tcnt[u.e], colb = u.pn * 128 + wc * 32 + fq * 8;
        float rsv[2][4];
#pragma unroll
        for (int ai = 0; ai < 2; ++ai)
#pragma unroll
            for (int m = 0; m < 4; ++m) rsv[ai][m] = meta[ai * HALF + wr * 64 + m * 16 + fr];
#pragma unroll
        for (int ai = 0; ai < 2; ++ai)
#pragma unroll
            for (int m = 0; m < 4; ++m) {
                const int rit = ai * HALF + wr * 64 + m * 16 + fr; const float vmask = (r0 + rit < n) ? 1.f : 0.f, rs = rsv[ai][m];
                f32x4 h[2];
#pragma unroll
                for (int nn = 0; nn < 2; ++nn) { const f32x4 a = acc[ai][0][m][nn] * rs, b = acc[ai][1][m][nn] * (rs * vmask);
#pragma unroll
                    for (int j = 0; j < 4; ++j) h[nn][j] = a[j] * fast_sigmoid(a[j]) * b[j]; }
                u32x2 w8; w8.x = pack4_fp8(h[0], F8_HID); w8.y = pack4_fp8(h[1], F8_HID);
                *(u32x2*)((unsigned char*)HID + ((size_t)u.pm * 256 + rit) * DFF + colb) = w8;
            }
    }
};
struct EpiDn {
    const int* LIST; const float* LTW; bf16_t* Y0; bf16_t* Y1; MoeTab T;
    __device__ __forceinline__ void meta_issue(const Unit& u, LAS unsigned char* mb, int wid) const { const int n = T.tcnt[u.e]; int idx = T.trow0[u.pm] + wid * 64 + lane_id_fresh(); idx = idx < n ? idx : n - 1;
        G8_META_DMA(LIST + (size_t)u.e * M + idx, mb, 0, wid); G8_META_DMA(LTW + (size_t)u.e * M + idx, mb, 1, wid); }
    __device__ __forceinline__ void operator()(f32x4 (&acc)[2][2][4][2], const Unit& u, int wr, int wc, int fr, int fq, const LAS float* meta) const {
        const int r0 = T.trow0[u.pm], n = T.tcnt[u.e], colb = u.pn * BM + wc * 32 + fq * 8;
        int slv[2][4]; float twv[2][4];
#pragma unroll
        for (int ai = 0; ai < 2; ++ai)
#pragma unroll
            for (int m = 0; m < 4; ++m) { const int rit = ai * HALF + wr * 64 + m * 16 + fr; slv[ai][m] = ((const LAS int*)meta)[rit]; twv[ai][m] = meta[256 + rit]; }
#pragma unroll
        for (int ai = 0; ai < 2; ++ai)
#pragma unroll
            for (int m = 0; m < 4; ++m) {
                const int idx = r0 + ai * HALF + wr * 64 + m * 16 + fr;
                if (idx < n) { const int slot = slv[ai][m]; const float tw = twv[ai][m];
                    unsigned char* Y = (unsigned char*)((slot & 1) ? Y1 : Y0) + (size_t)(slot >> 1) * DM + colb;
#pragma unroll
                    for (int bj = 0; bj < 2; ++bj) { u32x2 w8; w8.x = pack4_fp8(acc[ai][bj][m][0] * tw, F8_Y); w8.y = pack4_fp8(acc[ai][bj][m][1] * tw, F8_Y); *(u32x2*)(Y + bj * 128) = w8; } }
            }
    }
};
}

struct Args { const float* in[27]; float* out; unsigned char* ws; int ph_lo, ph_hi, li, pad; };
struct Frame {
    LAS unsigned char* lds; volatile LAS unsigned* MISC; unsigned char* ws;
    int wave, vcu, G;
};

__device__ __forceinline__ float wave_sum(float v) {
#pragma unroll
    for (int o = 1; o < 64; o <<= 1) v += __shfl_xor(v, o);
    return v;
}

__device__ __forceinline__ void tr_item(const float* src, int ld, const float* ks, int k0, int c0, bf16_t* dst, int ldk, int d0, int d1, LAS float* scr, int lane) {
    f32x4 v[16];
#pragma unroll
    for (int i = 0; i < 16; ++i) v[i] = *(const f32x4*)(src + (size_t)(k0 + 4 * i + (lane >> 4)) * ld + c0 + (lane & 15) * 4);
    const int c8 = lane & 7;
    f32x4 g0 = (f32x4){1.f, 1.f, 1.f, 1.f}, g1 = g0;
    if (ks) { g0 = *(const f32x4*)(ks + k0 + 8 * c8); g1 = *(const f32x4*)(ks + k0 + 8 * c8 + 4); }
#pragma unroll
    for (int i = 0; i < 16; ++i) { LAS float* s = scr + (4 * i + (lane >> 4)) * 65 + (lane & 15) * 4; s[0] = v[i][0]; s[1] = v[i][1]; s[2] = v[i][2]; s[3] = v[i][3]; }
    asm volatile("s_waitcnt lgkmcnt(0)" ::: "memory");
#pragma unroll
    for (int j = 0; j < 8; ++j) { const int rr = j * 8 + (lane >> 3), c32 = rr & 31;
        const int p32 = ((c32 >> 2) & 1) * 16 + (c32 >> 3) * 4 + (c32 & 3), drow = ((rr >> 5) ? d1 : d0) + p32;
        const LAS float* s = scr + (8 * c8) * 65 + rr;
        u32x4 o; o.x = cvt_pk_bf16(s[0] * g0[0], s[65] * g0[1]); o.y = cvt_pk_bf16(s[2 * 65] * g0[2], s[3 * 65] * g0[3]); o.z = cvt_pk_bf16(s[4 * 65] * g1[0], s[5 * 65] * g1[1]); o.w = cvt_pk_bf16(s[6 * 65] * g1[2], s[7 * 65] * g1[3]);
        *(u32x4*)(dst + (size_t)drow * ldk + k0 + 8 * c8) = o; }
    asm volatile("s_waitcnt lgkmcnt(0)" ::: "memory");
}
__device__ __forceinline__ void tr_item8(const float* src, int ld, const float* ks, int k0, int c0, unsigned char* dst, int ldk, int d0, int d1, LAS float* scr, int lane) {
    f32x4 v[16];
#pragma unroll
    for (int i = 0; i < 16; ++i) v[i] = *(const f32x4*)(src + (size_t)(k0 + 4 * i + (lane >> 4)) * ld + c0 + (lane & 15) * 4);
    const int c8 = lane & 7;
    f32x4 g0 = (f32x4){1.f, 1.f, 1.f, 1.f}, g1 = g0;
    if (ks) { g0 = *(const f32x4*)(ks + k0 + 8 * c8); g1 = *(const f32x4*)(ks + k0 + 8 * c8 + 4); }
#pragma unroll
    for (int i = 0; i < 16; ++i) { LAS float* s = scr + (4 * i + (lane >> 4)) * 65 + (lane & 15) * 4; s[0] = v[i][0]; s[1] = v[i][1]; s[2] = v[i][2]; s[3] = v[i][3]; }
    asm volatile("s_waitcnt lgkmcnt(0)" ::: "memory");
#pragma unroll
    for (int j = 0; j < 8; ++j) { const int rr = j * 8 + (lane >> 3), c32 = rr & 31;
        const int p32 = ((c32 >> 2) & 1) * 16 + (c32 >> 3) * 4 + (c32 & 3), drow = ((rr >> 5) ? d1 : d0) + p32;
        const LAS float* s = scr + (8 * c8) * 65 + rr;
        u32x2 o; o.x = pack4_fp8((f32x4){s[0], s[65], s[2 * 65], s[3 * 65]} * g0, F8_W); o.y = pack4_fp8((f32x4){s[4 * 65], s[5 * 65], s[6 * 65], s[7 * 65]} * g1, F8_W);
        *(u32x2*)(dst + (size_t)drow * ldk + k0 + 8 * c8) = o; }
    asm volatile("s_waitcnt lgkmcnt(0)" ::: "memory");
}
__device__ __forceinline__ int map_in(int c) {
    if (c < 2048) { const int w = c & 255; return (c & ~255) + ((w >> 5) & 1) * 128 + (w >> 6) * 32; }
    if (c < 4096) return c;
    const int ch = (c - 4096) & 1023; return (16 + (ch >> 7)) * 256 + ((ch >> 5) & 3) * 32 + (c >= 5120 ? 128 : 0);
}

__device__ __forceinline__ void prep_row(const float* x, const float* p, bf16_t* XB, float* RS0, bf16_t* PB, int row, int lane) {
    const GAS f32x4* xr = (const GAS f32x4*)(x + (size_t)row * DM) + lane;
    f32x4 v[8]; float s = 0.f;
#pragma unroll
    for (int j = 0; j < 8; ++j) v[j] = xr[64 * j];
    const f32x4 pv = *((const GAS f32x4*)(p + (size_t)row * PLE) + lane);
#pragma unroll
    for (int j = 0; j < 8; ++j) s += dot4(v[j]);
    s = wave_sum(s);
    GAS u32x2* o = (GAS u32x2*)(XB + (size_t)row * DM) + lane;
#pragma unroll
    for (int j = 0; j < 8; ++j) { u32x2 w; w.x = cvt_pk_bf16(v[j][0], v[j][1]); w.y = cvt_pk_bf16(v[j][2], v[j][3]); o[64 * j] = w; }
    if (lane == 0) RS0[row] = rsqrtf(s * (1.f / DM) + EPS);
    u32x2 w; w.x = cvt_pk_bf16(pv[0], pv[1]); w.y = cvt_pk_bf16(pv[2], pv[3]);
    *((GAS u32x2*)(PB + (size_t)row * PLE) + lane) = w;
}

__device__ __forceinline__ void p0_prologue(Frame& F, const Args& a) {
    unsigned char* ws = F.ws; const int lane = lane_id(), tid = F.wave * 64 + lane;
    const float* w_in = a.in[4]; const float* g_mix = a.in[3]; const float* w_o = a.in[15]; const float* g_ffn = a.in[16];
    const float* w1 = a.in[21]; const float* w3 = a.in[22]; const float* w2 = a.in[23]; const float* g_ple = a.in[24]; const float* w_gate = a.in[25]; const float* w_proj = a.in[26];
    if (blockIdx.x == 0 && tid < 256) {
        LAS float* red = (LAS float*)(F.lds + LCTL_OFF + 128);
        const float* rel_bias = a.in[2]; const int t = tid;
        float gq = 0.f, gk = 0.f, rb = fabsf(rel_bias[t]);
        if (t < 64) { gq = fabsf(a.in[5][t]); gk = fabsf(a.in[6][t]); }
        for (int o = 32; o > 0; o >>= 1) { gq = fmaxf(gq, __shfl_xor(gq, o)); gk = fmaxf(gk, __shfl_xor(gk, o)); rb = fmaxf(rb, __shfl_xor(rb, o)); }
        if ((t & 63) == 0) { red[t >> 6] = rb; if (t == 0) { red[8] = gq; red[9] = gk; } }
    }
    __syncthreads();
    if (blockIdx.x == 0 && tid < 256) {
        LAS float* red = (LAS float*)(F.lds + LCTL_OFF + 128);
        const float* rel_bias = a.in[2]; const int t = tid;
        const float rbm = fmaxf(fmaxf(red[0], red[1]), fmaxf(red[2], red[3]));
        const float m0 = 8.f * red[8] * red[9] + rbm;
        float* BT = (float*)(ws + WS_BT);
        for (int i = t; i < NH * BT_N; i += 256) { const int h = i / BT_N, idx = i % BT_N, rel = idx - 255; BT[i] = (rel_bias[rel_bucket(rel) * NH + h] - m0) * LOG2E; }
        if (t < 64) {
            float x1 = a.in[7][t] * a.in[8][t], x2 = a.in[9][t] * a.in[10][t];
            for (int o = 32; o > 0; o >>= 1) { x1 += __shfl_xor(x1, o); x2 += __shfl_xor(x2, o); }
            if (t == 0) ((float*)(ws + WS_LAM))[0] = expf(x1) - expf(x2) + LAM_INIT;
        }
    }
    __syncthreads();
    const int gw = F.vcu * NWAVES + F.wave, NGW = F.G * NWAVES;
    for (int m = gw; m < M; m += NGW) prep_row(a.in[0], a.in[1], (bf16_t*)(ws + WS_A), (float*)(ws + WS_RS0), (bf16_t*)(ws + WS_PB), m, lane);
    { const float* w_group = a.in[17]; const float* w_expert = a.in[19]; bf16_t* WR = (bf16_t*)(ws + WS_WR);
      for (int i = (F.vcu * NWAVES + F.wave) * 64 + lane; i < 256 * (DM / 8); i += F.G * NTHR) { const int pr = i / (DM / 8), k8 = (i % (DM / 8)) * 8;
          float v[8];
#pragma unroll
          for (int q = 0; q < 8; ++q) { const int k = k8 + q; v[q] = pr < 4 ? g_ffn[k] * w_group[k * 4 + pr] : pr < 36 ? g_ffn[k] * w_expert[k * 32 + pr - 4] : 0.f; }
          u32x4 o; o.x = cvt_pk_bf16(v[0], v[1]); o.y = cvt_pk_bf16(v[2], v[3]); o.z = cvt_pk_bf16(v[4], v[5]); o.w = cvt_pk_bf16(v[6], v[7]);
          *(u32x4*)(WR + (size_t)pr * DM + k8) = o; } }
    LAS float* scr = (LAS float*)(F.lds + F.wave * 16640);
    constexpr int I_IN = 32 * 96, I_O = 32 * 32, I_G = 32 * 32, I_P = 4 * 32, I_UP = 32 * 512, I_DN = 32 * 256;
    constexpr int NITEMS = I_IN + I_O + I_G + I_P + I_UP + I_DN;
    for (int it = gw; it < NITEMS; it += NGW) {
        int r = it;
        if (r < I_IN) { const int kb = r / 96, cb = r % 96, c0 = cb * 64; tr_item(w_in, 6144, g_mix, kb * 64, c0, (bf16_t*)(ws + WS_WIN), DM, map_in(c0), map_in(c0 + 32), scr, lane); continue; } r -= I_IN;
        if (r < I_O) { const int kb = r / 32, c0 = (r % 32) * 64; tr_item(w_o, DM, nullptr, kb * 64, c0, (bf16_t*)(ws + WS_WO), DM, c0, c0 + 32, scr, lane); continue; } r -= I_O;
        if (r < I_G) { const int kb = r / 32, c0 = (r % 32) * 64; tr_item8(w_gate, DM, g_ple, kb * 64, c0, ws + WS_WG, DM, c0, c0 + 32, scr, lane); continue; } r -= I_G;
        if (r < I_P) { const int kb = r / 32, c0 = (r % 32) * 64; tr_item(w_proj, DM, nullptr, kb * 64, c0, (bf16_t*)(ws + WS_WP), PLE, c0, c0 + 32, scr, lane); continue; } r -= I_P;
        if (r < I_UP) { const int e = r / 512, q = r % 512, which = q / 256, q2 = q % 256, kb = q2 / 8, c0 = (q2 % 8) * 64;
            const float* src = (which ? w3 : w1) + (size_t)e * DM * DFF;
            const int d0 = (c0 >> 7) * 256 + ((c0 >> 5) & 3) * 32 + which * 128, d1 = ((c0 + 32) >> 7) * 256 + (((c0 + 32) >> 5) & 3) * 32 + which * 128;
            tr_item8(src, DFF, g_ffn, kb * 64, c0, ws + WS_WUP + (size_t)e * 1024 * DM, DM, d0, d1, scr, lane); continue; } r -= I_UP;
        { const int e = r / 256, q = r % 256, kb = q / 32, c0 = (q % 32) * 64;
            tr_item8(w2 + (size_t)e * DFF * DM, DM, nullptr, kb * 64, c0, ws + WS_WDN + (size_t)e * DM * DFF, DFF, c0, c0 + 32, scr, lane); }
    }
}


namespace att {
typedef short v4i16_t __attribute__((ext_vector_type(4)));
constexpr int SLOT = 32768, STG_STRIDE = 132, STG_BYTES = 32 * STG_STRIDE * 4;
static_assert(4 * SLOT <= RING_BYTES && 8 * STG_BYTES <= LCTL_OFF, "attention LDS");
__device__ __forceinline__ void glds16(const void* gsrc, unsigned lds_dst) { unsigned keep;
    asm volatile("s_mov_b32 %0, m0\n\ts_mov_b32 m0, %2\n\ts_nop 0\n\tglobal_load_lds_dwordx4 %1, off\n\ts_mov_b32 m0, %0" : "=&s"(keep) : "v"(gsrc), "s"(lds_dst) : "memory"); }
__device__ __forceinline__ v4i16_t vtr(const LAS unsigned char* p) { return __builtin_amdgcn_ds_read_tr16_b64_v4i16((LAS v4i16_t*)p); }
__device__ __forceinline__ int crow(int r, int hi) { return (r & 3) + 8 * (r >> 2) + 4 * hi; }

__device__ __forceinline__ void attn_unit(int b, int h, int qb, const bf16_t* Q, const bf16_t* K, const bf16_t* V, bf16_t* AO, const float* g_subln, float lam, LAS unsigned char* lds, int wid) {
    const int lane = lane_id(), r32 = lane & 31, hi = lane >> 5;
    const int pair = wid >> 1, comp = wid & 1;
    const long rowbase = (long)b * SEQ; const int q0 = qb * 128, myrow0 = q0 + pair * 32;
    const int cw = myrow0 >> 6;
    const int NT = (q0 >> 6) + 2;
    const LAS float* bt = (const LAS float*)(lds + LBT_OFF);
    const float ffar = __builtin_amdgcn_exp2f(bt[0]);
    const bf16_t* ksrc = K + (size_t)(rowbase + 8 * wid + (lane >> 3)) * 1024 + h * 128 + (((lane & 7) ^ (((8 * wid + (lane >> 3)) >> 1) & 7)) * 8);
    const bf16_t* vsrc = V + (size_t)(rowbase + 16 * (wid & 3) + (lane >> 2)) * 1024 + h * 128 + (wid >> 2) * 32 + (lane & 3) * 8;
    const unsigned lds0 = (unsigned)(size_t)lds;
    const unsigned kdst = lds0 + wid * 1024, vdst = lds0 + 16384 + (wid >> 2) * 4096 + (wid & 3) * 1024;
#define ATT_DMA(t, sl) do { const size_t go_ = (size_t)(t) * 65536; const unsigned so_ = (unsigned)(sl); \
        glds16(ksrc + go_, (unsigned)__builtin_amdgcn_readfirstlane(kdst + so_)); glds16(ksrc + go_ + 64, (unsigned)__builtin_amdgcn_readfirstlane(kdst + so_ + 8192)); \
        glds16(vsrc + go_, (unsigned)__builtin_amdgcn_readfirstlane(vdst + so_)); glds16(vsrc + go_ + 64, (unsigned)__builtin_amdgcn_readfirstlane(vdst + so_ + 8192)); } while (0)
    f32x16 o[4];
#pragma unroll
    for (int d = 0; d < 4; ++d)
#pragma unroll
        for (int r = 0; r < 16; ++r) o[d][r] = 0.f;
    float l = 0.f;
    ATT_DMA(0, 0); ATT_DMA(1, SLOT);
    bf16x8 qr[4];
#pragma unroll
    for (int d0 = 0; d0 < 4; ++d0) qr[d0] = *(const bf16x8*)(Q + (size_t)(rowbase + myrow0 + r32) * 1024 + h * 128 + comp * 64 + d0 * 16 + hi * 8);
    asm volatile("" :: "v"(qr[0]), "v"(qr[1]), "v"(qr[2]), "v"(qr[3]));
    int sl_cur = 0, sl_prev = 3 * SLOT, sl_nn = 2 * SLOT;
    int kofs[4];
#pragma unroll
    for (int d0 = 0; d0 < 4; ++d0) kofs[d0] = comp * 8192 + r32 * 128 + (((2 * d0 + hi) ^ ((r32 >> 1) & 7)) * 16);
    const int vofs = 16384 + ((lane >> 4) & 1) * 32 + (lane & 3) * 8 + (4 * hi + ((lane & 15) >> 2)) * 64;
    const bool grpY = wid >= 4;
    u32x4 pw[4];
#define ATT_SGB(mask, n) __builtin_amdgcn_sched_group_barrier(mask, n, 0)
    f32x16 p1;
#define ATT_QKEXP(t, slot) do { const LAS unsigned char* sb = lds + (slot); f32x16 p0; \
        bf16x8 kf[4][2]; \
        _Pragma("unroll") for (int d0 = 0; d0 < 4; ++d0) { kf[d0][0] = *(const LAS bf16x8*)(sb + kofs[d0]); kf[d0][1] = *(const LAS bf16x8*)(sb + kofs[d0] + 4096); } \
        if ((t) == cw - 2 && (t) > 0) l *= ffar; \
        if ((t) >= cw - 2) { const int base = 64 * (t) + 4 * hi - (myrow0 + r32) + 255; \
            _Pragma("unroll") for (int r = 0; r < 16; ++r) { p0[r] = bt[base + (r & 3) + 8 * (r >> 2)]; p1[r] = bt[base + 32 + (r & 3) + 8 * (r >> 2)]; } \
            _Pragma("unroll") for (int d0 = 0; d0 < 4; ++d0) { \
                p0 = __builtin_amdgcn_mfma_f32_32x32x16_bf16(kf[d0][0], qr[d0], p0, 0, 0, 0); p1 = __builtin_amdgcn_mfma_f32_32x32x16_bf16(kf[d0][1], qr[d0], p1, 0, 0, 0); } } \
        else { const f32x16 z16 = {0.f, 0.f, 0.f, 0.f, 0.f, 0.f, 0.f, 0.f, 0.f, 0.f, 0.f, 0.f, 0.f, 0.f, 0.f, 0.f};     \
            p0 = __builtin_amdgcn_mfma_f32_32x32x16_bf16(kf[0][0], qr[0], z16, 0, 0, 0); p1 = __builtin_amdgcn_mfma_f32_32x32x16_bf16(kf[0][1], qr[0], z16, 0, 0, 0); \
            _Pragma("unroll") for (int d0 = 1; d0 < 4; ++d0) { \
                p0 = __builtin_amdgcn_mfma_f32_32x32x16_bf16(kf[d0][0], qr[d0], p0, 0, 0, 0); p1 = __builtin_amdgcn_mfma_f32_32x32x16_bf16(kf[d0][1], qr[d0], p1, 0, 0, 0); } } \
        float sacc = 0.f; \
        _Pragma("unroll") for (int r = 0; r < 16; ++r) { p0[r] = __builtin_amdgcn_exp2f(p0[r]); sacc += p0[r]; } \
        l += sacc; \
        _Pragma("unroll") for (int i = 0; i < 4; ++i) { pw[0][i] = cvt_pk_bf16(p0[2 * i], p0[2 * i + 1]); pw[1][i] = cvt_pk_bf16(p0[8 + 2 * i], p0[9 + 2 * i]); } } while (0)
#define ATT_VLD2(dst, db, k0) do { _Pragma("unroll") for (int kk = 0; kk < 2; ++kk) { \
            const v4i16_t lo = vtr(sb + vofs + (db) * 4096 + ((k0) + kk) * 1024), hh = vtr(sb + vofs + (db) * 4096 + ((k0) + kk) * 1024 + 512); \
            dst[(db) * 2 + kk] = (bf16x8){lo[0], lo[1], lo[2], lo[3], hh[0], hh[1], hh[2], hh[3]}; } } while (0)
#define ATT_PV(t, slot) do { const LAS unsigned char* sb = lds + (slot); bf16x8 h1[8], h2[8]; \
        if ((t) == cw - 2 && (t) > 0) { _Pragma("unroll") for (int db = 0; db < 4; ++db) o[db] = o[db] * ffar; } \
        _Pragma("unroll") for (int db = 0; db < 4; ++db) ATT_VLD2(h1, db, 0); \
        _Pragma("unroll") for (int db = 0; db < 4; ++db) ATT_VLD2(h2, db, 2); \
        _Pragma("unroll") for (int db = 0; db < 4; ++db) { o[db] = __builtin_amdgcn_mfma_f32_32x32x16_bf16(__builtin_bit_cast(bf16x8, pw[0]), h1[db * 2], o[db], 0, 0, 0); \
                                                         o[db] = __builtin_amdgcn_mfma_f32_32x32x16_bf16(__builtin_bit_cast(bf16x8, pw[1]), h1[db * 2 + 1], o[db], 0, 0, 0); } \
        float sacc = 0.f; \
        _Pragma("unroll") for (int r = 0; r < 16; ++r) { p1[r] = __builtin_amdgcn_exp2f(p1[r]); sacc += p1[r]; } \
        l += sacc; \
        _Pragma("unroll") for (int i = 0; i < 4; ++i) { pw[2][i] = cvt_pk_bf16(p1[2 * i], p1[2 * i + 1]); pw[3][i] = cvt_pk_bf16(p1[8 + 2 * i], p1[9 + 2 * i]); } \
        _Pragma("unroll") for (int db = 0; db < 4; ++db) { o[db] = __builtin_amdgcn_mfma_f32_32x32x16_bf16(__builtin_bit_cast(bf16x8, pw[2]), h2[db * 2], o[db], 0, 0, 0); \
                                                         o[db] = __builtin_amdgcn_mfma_f32_32x32x16_bf16(__builtin_bit_cast(bf16x8, pw[3]), h2[db * 2 + 1], o[db], 0, 0, 0); } } while (0)
#define ATT_WAIT_A(s_) do { if ((s_) + 1 < NT) asm volatile("s_waitcnt vmcnt(4) lgkmcnt(0)\n\ts_barrier" ::: "memory"); else asm volatile("s_waitcnt vmcnt(0) lgkmcnt(0)\n\ts_barrier" ::: "memory"); } while (0)
#define ATT_BAR_B() asm volatile("s_waitcnt lgkmcnt(0)\n\ts_barrier" ::: "memory")
    asm volatile(".p2align 8" ::: "memory");
    if (!grpY) {
        for (int s = 0; s <= NT; ++s) {
            ATT_WAIT_A(s);
            if (s < NT && s <= cw) ATT_QKEXP(s, sl_cur);
            ATT_BAR_B();
            if (s + 2 < NT) ATT_DMA(s + 2, sl_nn);
            if (s < NT && s <= cw) ATT_PV(s, sl_cur);
            sl_prev = sl_cur; sl_cur = (sl_cur == 3 * SLOT) ? 0 : sl_cur + SLOT; sl_nn = (sl_nn == 3 * SLOT) ? 0 : sl_nn + SLOT;
        }
    } else {
        for (int s = 0; s <= NT; ++s) {
            ATT_WAIT_A(s);
            if (s >= 1 && s - 1 <= cw) ATT_PV(s - 1, sl_prev);
            ATT_BAR_B();
            if (s + 2 < NT) ATT_DMA(s + 2, sl_nn);
            if (s < NT && s <= cw) ATT_QKEXP(s, sl_cur);
            sl_prev = sl_cur; sl_cur = (sl_cur == 3 * SLOT) ? 0 : sl_cur + SLOT; sl_nn = (sl_nn == 3 * SLOT) ? 0 : sl_nn + SLOT;
        }
    }
#undef ATT_WAIT_A
#undef ATT_BAR_B
#undef ATT_QKEXP
#undef ATT_PV
#undef ATT_VLD2
#undef ATT_SGB
#undef ATT_DMA
    l += __shfl_xor(l, 32);
    asm volatile("s_waitcnt vmcnt(0) lgkmcnt(0)\n\ts_barrier" ::: "memory");
    {   LAS float* st = (LAS float*)(lds + wid * STG_BYTES);
#pragma unroll
        for (int db = 0; db < 4; ++db)
#pragma unroll
            for (int r = 0; r < 16; ++r) st[crow(r, hi) * STG_STRIDE + db * 32 + r32] = o[db][r];
        if (hi == 0) ((LAS float*)(lds + LLS_OFF))[wid * 32 + r32] = l;
    }
    asm volatile("s_waitcnt lgkmcnt(0)\n\ts_barrier" ::: "memory");
    {   const int rsel = comp * 16 + (lane >> 2), quarter = lane & 3;
        const LAS float* s1 = (const LAS float*)(lds + (pair * 2) * STG_BYTES) + rsel * STG_STRIDE + quarter * 32;
        const LAS float* s2 = (const LAS float*)(lds + (pair * 2 + 1) * STG_BYTES) + rsel * STG_STRIDE + quarter * 32;
        const LAS float* ls = (const LAS float*)(lds + LLS_OFF);
        const float i1 = 1.f / ls[(pair * 2) * 32 + rsel], i2 = lam / ls[(pair * 2 + 1) * 32 + rsel];
        f32x4 v[8]; float ss = 0.f;
#pragma unroll
        for (int c = 0; c < 8; ++c) { v[c] = *(const LAS f32x4*)(s1 + c * 4) * i1 - *(const LAS f32x4*)(s2 + c * 4) * i2; ss += dot4(v[c]); }
        ss += __shfl_xor(ss, 1); ss += __shfl_xor(ss, 2);
        const float rstd = rsqrtf(ss * (1.f / 128.f) + EPS) * (1.f - LAM_INIT);
        bf16_t* op = AO + (size_t)(rowbase + myrow0 + rsel - comp * 16 + comp * 16) * DM + h * 128 + quarter * 32;
#pragma unroll
        for (int c = 0; c < 4; ++c) { const f32x4 g0 = *(const f32x4*)(g_subln + quarter * 32 + c * 8), g1 = *(const f32x4*)(g_subln + quarter * 32 + c * 8 + 4);
            *(u32x4*)(op + c * 8) = pack8(v[2 * c] * rstd * g0, v[2 * c + 1] * rstd * g1); }
    }
    asm volatile("s_waitcnt lgkmcnt(0)\n\ts_barrier" ::: "memory");
}
}

__device__ __forceinline__ void p2_conv(Frame& F, const Args& a) {
    unsigned char* ws = F.ws; const int lane = lane_id(), c0 = lane * 16;
    const bf16_t* CU = (const bf16_t*)(ws + WS_D); const bf16_t* GB = (const bf16_t*)(ws + WS_C) + (size_t)M * 1024; bf16_t* AO = (bf16_t*)(ws + WS_AO);
    const float* conv_w = a.in[12]; const float* conv_b = a.in[13]; const float* g_conv = a.in[14];
    f32x4 w0[4], w1[4], w2[4], cb[4], gc[4];
#pragma unroll
    for (int i = 0; i < 4; ++i) { w0[i] = *(const f32x4*)(conv_w + c0 + i * 4); w1[i] = *(const f32x4*)(conv_w + 1024 + c0 + i * 4); w2[i] = *(const f32x4*)(conv_w + 2048 + c0 + i * 4);
        cb[i] = *(const f32x4*)(conv_b + c0 + i * 4); gc[i] = *(const f32x4*)(g_conv + c0 + i * 4); }
    const int gw = F.vcu * NWAVES + F.wave, NGW = F.G * NWAVES;
    for (int row = gw; row < M; row += NGW) {
        const int s = row & (SEQ - 1);
        const u32x4 zz = (u32x4){0u, 0u, 0u, 0u};
        u32x4 x0[2], x1[2], x2[2], gb[2];
#pragma unroll
        for (int i = 0; i < 2; ++i) { x0[i] = *(const u32x4*)(CU + (size_t)row * 1024 + c0 + i * 8); gb[i] = *(const u32x4*)(GB + (size_t)row * 1024 + c0 + i * 8);
            x1[i] = s >= 1 ? *(const u32x4*)(CU + (size_t)(row - 1) * 1024 + c0 + i * 8) : zz; x2[i] = s >= 2 ? *(const u32x4*)(CU + (size_t)(row - 2) * 1024 + c0 + i * 8) : zz; }
        f32x4 z[4]; float ss = 0.f;
#pragma unroll
        for (int i = 0; i < 4; ++i) { const int q = i >> 1;
            const f32x4 a0 = (i & 1) ? g8::bf4lo(x0[q].z, x0[q].w) : g8::bf4lo(x0[q].x, x0[q].y), a1 = (i & 1) ? g8::bf4lo(x1[q].z, x1[q].w) : g8::bf4lo(x1[q].x, x1[q].y);
            const f32x4 a2 = (i & 1) ? g8::bf4lo(x2[q].z, x2[q].w) : g8::bf4lo(x2[q].x, x2[q].y), g = (i & 1) ? g8::bf4lo(gb[q].z, gb[q].w) : g8::bf4lo(gb[q].x, gb[q].y);
            z[i] = g * (w2[i] * a0 + w1[i] * a1 + w0[i] * a2 + cb[i]); ss += dot4(z[i]); }
        ss += __shfl_xor(ss, 1); ss += __shfl_xor(ss, 2); ss += __shfl_xor(ss, 4);
        const float r = rsqrtf(ss * (1.f / 128.f) + EPS);
        *(u32x4*)(AO + (size_t)row * DM + 1024 + c0) = pack8(z[0] * r * gc[0], z[1] * r * gc[1]);
        *(u32x4*)(AO + (size_t)row * DM + 1024 + c0 + 8) = pack8(z[2] * r * gc[2], z[3] * r * gc[3]);
    }
}
__device__ __forceinline__ void p2_attention(Frame& F, const Args& a) {
    unsigned char* ws = F.ws; const int tid = F.wave * 64 + lane_id();
    const bf16_t* Qb = (const bf16_t*)(ws + WS_B); const bf16_t* Kb = Qb + (size_t)M * 1024; const bf16_t* Vb = (const bf16_t*)(ws + WS_C); bf16_t* AO = (bf16_t*)(ws + WS_AO);
    const int bh = F.vcu >> 3, j = F.vcu & 7, b = bh >> 3, h = bh & 7;
    if (bh >= BATCH * NH) return;
    const float lam = ((const float*)(ws + WS_LAM))[0];
    { LAS float* bt = (LAS float*)(F.lds + LBT_OFF); const float* BT = (const float*)(ws + WS_BT) + h * BT_N; if (tid < BT_N) bt[tid] = BT[tid]; }
    asm volatile("s_waitcnt vmcnt(0) lgkmcnt(0)\n\ts_barrier" ::: "memory");
    for (int i = 0; i < 4; ++i) { const int qb = (i == 0) ? 31 - j : (i == 1) ? 16 + j : (i == 2) ? 15 - j : j;
        att::attn_unit(b, h, qb, Qb, Kb, Vb, AO, a.in[11], lam, F.lds, F.wave); }
}

__device__ __forceinline__ void p5_route(Frame& F, const Args& a) {
    unsigned char* ws = F.ws; const int lane = lane_id();
    const float* PART = (const float*)(ws + WS_PART); const float* SSQ = (const float*)(ws + WS_SSQ);
    const float* b_group = a.in[18]; const float* b_expert = a.in[20];
    float* RS1 = (float*)(ws + WS_RS1); int* TE = (int*)(ws + WS_TE); float* TW = (float*)(ws + WS_TW); unsigned* CNT = (unsigned*)(ws + WS_CNT); int* LIST = (int*)(ws + WS_LIST);
    for (int row = (F.vcu * NWAVES + F.wave) * 64 + lane; row < M; row += F.G * NTHR) {
        float ss = 0.f;
#pragma unroll
        for (int i = 0; i < 8; ++i) { const f32x4 v = *(const f32x4*)(SSQ + (size_t)row * 32 + i * 4); ss += (v[0] + v[1]) + (v[2] + v[3]); }
        const float rs = rsqrtf(ss * (1.f / DM) + EPS);
        f32x4 gl = (f32x4){0.f, 0.f, 0.f, 0.f};
#pragma unroll
        for (int ks = 0; ks < 4; ++ks) gl = gl + *(const f32x4*)(PART + ((size_t)ks * M + row) * 64);
        int gi = 0; float gm = -1e30f; float glv[4];
#pragma unroll
        for (int g = 0; g < 4; ++g) { glv[g] = gl[g] * rs + b_group[g]; if (glv[g] > gm) { gm = glv[g]; gi = g; } }
        float den = 0.f;
#pragma unroll
        for (int g = 0; g < 4; ++g) den += expf(glv[g] - gm);
        const float pg = 1.f / den;
        f32x4 e0 = (f32x4){0.f, 0.f, 0.f, 0.f}, e1 = e0;
#pragma unroll
        for (int ks = 0; ks < 4; ++ks) { const float* pp = PART + ((size_t)ks * M + row) * 64 + 4 + gi * 8; e0 = e0 + *(const f32x4*)pp; e1 = e1 + *(const f32x4*)(pp + 4); }
        float v0 = -1e30f, v1 = -1e30f; int i0 = 0, i1 = 0;
#pragma unroll
        for (int e = 0; e < 8; ++e) { const float v = (e < 4 ? e0[e & 3] : e1[e & 3]) * rs + b_expert[gi * 8 + e];
            if (v > v0) { v1 = v0; i1 = i0; v0 = v; i0 = e; } else if (v > v1) { v1 = v; i1 = e; } }
        const float ex = expf(v1 - v0), w0 = pg / (1.f + ex), w1 = pg * ex / (1.f + ex);
        const int x0 = gi * 8 + i0, x1 = gi * 8 + i1;
        RS1[row] = rs; TE[row * 2] = x0; TE[row * 2 + 1] = x1; TW[row * 2] = w0; TW[row * 2 + 1] = w1;
        float* LRS = (float*)(ws + WS_LRS); float* LTW = (float*)(ws + WS_LTW);
        const unsigned p0 = atomicAdd(&CNT[x0], 1u); LIST[(size_t)x0 * M + p0] = row * 2; LRS[(size_t)x0 * M + p0] = rs; LTW[(size_t)x0 * M + p0] = w0;
        const unsigned p1 = atomicAdd(&CNT[x1], 1u); LIST[(size_t)x1 * M + p1] = row * 2 + 1; LRS[(size_t)x1 * M + p1] = rs; LTW[(size_t)x1 * M + p1] = w1;
    }
}
__device__ __forceinline__ g8::MoeTab moe_tables(Frame& F) {
    LAS int* tab = (LAS int*)(F.lds + LTAB_OFF); const int tid = F.wave * 64 + lane_id();
    const unsigned* CNT = (const unsigned*)(F.ws + WS_CNT);
    __syncthreads();
    if (tid < 32) tab[384 + tid] = (int)__hip_atomic_load(CNT + tid, __ATOMIC_RELAXED, __HIP_MEMORY_SCOPE_AGENT);
    __syncthreads();
    if (tid == 0) { int nt = 0;
        for (int e = 0; e < NE; ++e) { const int n = tab[384 + e]; for (int r = 0; r < n && nt < 192; r += 256) { tab[nt] = e; tab[192 + nt] = r; ++nt; } }
        tab[416] = nt; }
    __syncthreads();
    g8::MoeTab T; T.texp = tab; T.trow0 = tab + 192; T.tcnt = tab + 384; T.ntile = tab[416];
    return T;
}
__device__ __forceinline__ void p7_combine(Frame& F) {
    unsigned char* ws = F.ws;
    bf16_t* H = (bf16_t*)(ws + WS_B); const bf16_t* Y0 = (const bf16_t*)(ws + WS_A); const bf16_t* Y1 = (const bf16_t*)(ws + WS_D); float* RS2 = (float*)(ws + WS_RS2); unsigned char* H28 = ws + WS_H28;
    const int gw = F.vcu * NWAVES + F.wave, NGW = F.G * NWAVES, lane = lane_id();
    for (int row = gw; row < M; row += NGW) {
        float ss = 0.f;
#pragma unroll
        for (int j = 0; j < 4; ++j) { const size_t o = (size_t)row * DM + j * 512 + lane * 8;
            const u32x4 hv = *(const u32x4*)(H + o); const u32x2 y0 = *(const u32x2*)((const unsigned char*)Y0 + o), y1 = *(const u32x2*)((const unsigned char*)Y1 + o);
            const f32x4 a = g8::bf4lo(hv.x, hv.y) + (unpack4_fp8(y0.x) + unpack4_fp8(y1.x)) * (1.f / F8_Y), b = g8::bf4lo(hv.z, hv.w) + (unpack4_fp8(y0.y) + unpack4_fp8(y1.y)) * (1.f / F8_Y);
            ss += dot4(a) + dot4(b);
            *(u32x4*)(H + o) = pack8(a, b);
            u32x2 w8; w8.x = pack4_fp8(a, F8_H); w8.y = pack4_fp8(b, F8_H); *(u32x2*)(H28 + o) = w8; }
        ss = wave_sum(ss);
        if (lane == 0) RS2[row] = rsqrtf(ss * (1.f / DM) + EPS);
    }
}

__global__ void __launch_bounds__(NTHR, 2) mk_fwd(Args args) {
    extern __shared__ __attribute__((aligned(16))) unsigned char lds_raw[];
    Frame F;
    F.lds = (LAS unsigned char*)lds_raw; F.MISC = (volatile LAS unsigned*)(F.lds + LCTL_OFF); F.ws = args.ws;
    F.wave = __builtin_amdgcn_readfirstlane(threadIdx.x >> 6);
    F.G = gridDim.x; { const int bx = blockIdx.x; F.vcu = (F.G % 8 == 0) ? (bx % 8) * (F.G / 8) + bx / 8 : bx; }
    unsigned char* ws = args.ws;
    if (threadIdx.x < 32) F.MISC[threadIdx.x] = 0u;
    __syncthreads();
    XcdBarrier bar = xcd_barrier_post((unsigned*)(ws + WS_BAR) + args.li * XCD_BAR_WORDS, F.MISC + 8);
    const int lo = args.ph_lo, hi = args.ph_hi;
#define IN(k) (lo <= (k) && (k) < hi)
#define SEAM(k) do { if (IN(k) && IN((k) + 1)) xcd_barrier(bar); } while (0)

    bf16_t* XB = (bf16_t*)(ws + WS_A); bf16_t* AO = (bf16_t*)(ws + WS_AO);
    bf16_t* Qb = (bf16_t*)(ws + WS_B); bf16_t* Kb = Qb + (size_t)M * 1024; bf16_t* H = Qb;
    bf16_t* Vb = (bf16_t*)(ws + WS_C); bf16_t* GB = Vb + (size_t)M * 1024;
    bf16_t* CU = (bf16_t*)(ws + WS_D);
    bf16_t* PP = (bf16_t*)(ws + WS_E); bf16_t* PB = (bf16_t*)(ws + WS_PB);
    float* RS0 = (float*)(ws + WS_RS0); float* RS2 = (float*)(ws + WS_RS2);

    if (IN(0)) { p0_prologue(F, args); } SEAM(0);

    if (IN(1)) {
        g8::DenseSched S; S.init(XB, DM * 2, ws + WS_WIN, DM * 2, M, 6144, F.G, (int)blockIdx.x);
        g8::EpiProj E{RS0, args.in[5], args.in[6], Qb, Kb, Vb, GB, CU};
        g8::gemm_phase<g8::EpiProj, g8::DenseSched>(F.lds, F.wave, DM, S, E);
    } SEAM(1);

    if (IN(2)) { p2_conv(F, args); p2_attention(F, args); } SEAM(2);

    if (IN(3)) {
        g8::DenseSched S; S.init(AO, DM * 2, ws + WS_WO, DM * 2, M, DM, F.G, (int)blockIdx.x);
        g8::EpiRes E{XB, H, (float*)(ws + WS_SSQ), ws + WS_H8};
        g8::gemm_phase<g8::EpiRes, g8::DenseSched>(F.lds, F.wave, DM, S, E);
    } SEAM(3);

    if (IN(4)) {
        g8::KSplitSched S{(const char*)H, (const char*)(ws + WS_WR), F.G, (int)blockIdx.x};
        g8::EpiRouter E{(float*)(ws + WS_PART)};
        g8::gemm_phase<g8::EpiRouter, g8::KSplitSched>(F.lds, F.wave, 512, S, E);
    } SEAM(4);

    if (IN(5)) { p5_route(F, args); } SEAM(5);

    if (IN(6)) {
        const g8::MoeTab T = moe_tables(F);
        g8::UpSched S{(const char*)(ws + WS_H8), (const char*)(ws + WS_WUP), (const int*)(ws + WS_LIST), T, F.G, F.vcu};
        g8::EpiUp E{(const float*)(ws + WS_LRS), Vb  , T};
        g8::gemm_phase<g8::EpiUp, g8::UpSched, true>(F.lds, F.wave, DM, S, E, E8_W, E8_H);
    } SEAM(6);

    if (IN(7)) {
        const g8::MoeTab T = moe_tables(F);
        g8::DnSched S{(const char*)Vb, (const char*)(ws + WS_WDN), T, F.G, F.vcu};
        g8::EpiDn E{(const int*)(ws + WS_LIST), (const float*)(ws + WS_LTW), XB  , CU  , T};
        int kdff = DFF; asm volatile("" : "+s"(kdff));
        g8::gemm_phase<g8::EpiDn, g8::DnSched, true>(F.lds, F.wave, kdff, S, E, E8_W, E8_HID);
    } SEAM(7);

    if (IN(8)) { p7_combine(F); } SEAM(8);

    if (IN(9)) {
        { g8::DenseSched S; S.init(PB, PLE * 2, ws + WS_WP, PLE * 2, M, DM, F.G, (int)blockIdx.x);
          g8::EpiBf16 E{PP, DM};
          int kple = PLE; asm volatile("" : "+s"(kple));
          g8::gemm_phase<g8::EpiBf16, g8::DenseSched>(F.lds, F.wave, kple, S, E);
          asm volatile("s_waitcnt vmcnt(0)" ::: "memory"); __syncthreads(); }
        g8::DenseSched S; S.init(ws + WS_H28, DM, ws + WS_WG, DM, M, DM, F.G, (int)blockIdx.x);
        g8::EpiFinal E{H, PP, RS2, args.out};
        g8::gemm_phase<g8::EpiFinal, g8::DenseSched, true>(F.lds, F.wave, DM, S, E, E8_W, E8_H);
    }
#undef IN
#undef SEAM
}


static int mk_grid = 0;
static void launch_mk(Args a, int lo, int hi, int li, hipStream_t stream) {
    a.ph_lo = lo; a.ph_hi = hi; a.li = li; a.pad = 0;
    hipLaunchKernelGGL(mk_fwd, dim3(mk_grid), dim3(NTHR), LDS_BYTES, stream, a);
}

extern "C" void kernel_launch(void* const* d_in, const int* in_sizes, int n_in, void* d_out, int out_size, void* d_ws, size_t ws_size, hipStream_t stream) {
    if (n_in != 27 || ws_size < WS_END) { fprintf(stderr, "kernel_launch: unexpected n_in %d / ws %zu\n", n_in, ws_size); return; }
    if (mk_grid == 0) {
        int dev = 0, cus = 0;
        (void)hipGetDevice(&dev); (void)hipDeviceGetAttribute(&cus, hipDeviceAttributeMultiprocessorCount, dev);
        (void)hipFuncSetAttribute((const void*)mk_fwd, hipFuncAttributeMaxDynamicSharedMemorySize, LDS_BYTES);
        int per_cu = 0; (void)hipOccupancyMaxActiveBlocksPerMultiprocessor(&per_cu, (const void*)mk_fwd, NTHR, LDS_BYTES); (void)hipGetLastError();
        mk_grid = 256;
        if (cus != 256 || per_cu < 1) fprintf(stderr, "kernel_launch: note: %d CUs, occupancy query %d; built for 256 CUs x 1 workgroup\n", cus, per_cu);
    }
    float* out = (float*)d_out; unsigned char* ws = (unsigned char*)d_ws;
    (void)in_sizes; (void)out_size;
    (void)hipMemsetAsync(ws + WS_CTL, 0, 1 * MiB, stream);
    Args a{};
    for (int i = 0; i < 27; ++i) a.in[i] = (const float*)d_in[i];
    a.out = out; a.ws = ws;
    launch_mk(a, 0, 10, 0, stream);
}
```

```cpp
#include <hip/hip_runtime.h>
#include <cstdint>
#include <cstdio>

typedef unsigned short bf16_t;
typedef float f32x4 __attribute__((ext_vector_type(4)));

constexpr int BATCH = 4, SEQ = 4096, DM = 2048, M = BATCH * SEQ;
constexpr int NH = 8, DQK = 64, DV = 128, DATT = 1024, DCONV = 1024;
constexpr int NE = 32, NG = 4, EPG = 8, DFF = 512, PLE = 256;
constexpr float EPS = 1e-6f;
constexpr float LOG2E = 1.4426950408889634f;
constexpr float LAM_INIT = 0.2f;
constexpr int BT_N = 320;

constexpr size_t MiB = 1u << 20;
constexpr size_t WS_CTL = 0;
constexpr size_t WS_BT = 64 * 1024;
constexpr size_t WS_LAM = WS_BT + 16 * 1024;
constexpr size_t WS_CNT = 128 * 1024;
constexpr size_t WS_W = 1 * MiB;
constexpr size_t WS_A = 236 * MiB;
constexpr size_t WS_B = 300 * MiB;
constexpr size_t WS_C = 364 * MiB;
constexpr size_t WS_D = 428 * MiB;
constexpr size_t WS_E = 492 * MiB;
constexpr size_t WS_PB = 556 * MiB;
constexpr size_t WS_SM = 564 * MiB;
constexpr size_t WS_RS0 = WS_SM, WS_RS1 = WS_SM + 64 * 1024, WS_RS2 = WS_SM + 128 * 1024;
constexpr size_t WS_TE = WS_SM + 192 * 1024;
constexpr size_t WS_TW = WS_SM + 320 * 1024;
constexpr size_t WS_LIST = WS_SM + 1 * MiB;
constexpr size_t WS_END = 576 * MiB;

__device__ __forceinline__ float bf2f(bf16_t v) { return __uint_as_float((unsigned)v << 16); }
__device__ __forceinline__ bf16_t f2bf(float f) { unsigned u = __float_as_uint(f); return (bf16_t)((u + 0x7fffu + ((u >> 16) & 1u)) >> 16); }

__device__ __forceinline__ int rel_bucket(int rel) {
    int ret = rel > 0 ? 16 : 0; int n = rel < 0 ? -rel : rel;
    if (n < 8) return ret + n;
    int l = 31 - __clz(n * n) + 2; if (l > 15) l = 15;
    return ret + l;
}

__device__ __forceinline__ float block_sum(float v, float* red) {
    for (int o = 32; o > 0; o >>= 1) v += __shfl_xor(v, o);
    const int w = threadIdx.x >> 6, nw = blockDim.x >> 6;
    __syncthreads();
    if ((threadIdx.x & 63) == 0) red[w] = v;
    __syncthreads();
    float s = 0.f; for (int i = 0; i < nw; ++i) s += red[i];
    return s;
}


#define GAS __attribute__((address_space(1)))
#define LAS __attribute__((address_space(3)))
typedef short bf16x8 __attribute__((ext_vector_type(8)));
typedef unsigned u32x4 __attribute__((ext_vector_type(4)));
typedef unsigned u32x2 __attribute__((ext_vector_type(2)));
typedef float f32x16 __attribute__((ext_vector_type(16)));
typedef GAS unsigned gu32;
#define RLX_AGENT __ATOMIC_RELAXED, __HIP_MEMORY_SCOPE_AGENT

constexpr int NWAVES = 8, NTHR = 512;
constexpr int RING_BYTES = 131072;
constexpr int LCTL_OFF = 145408;
constexpr int LBT_OFF = LCTL_OFF + 128;
constexpr int LLS_OFF = LBT_OFF + 1280;
constexpr int LTAB_OFF = LCTL_OFF + 128;
constexpr int LDS_BYTES = 149504;
static_assert(LLS_OFF + 1024 <= LDS_BYTES && LTAB_OFF + (192 + 192 + 32) * 4 <= LDS_BYTES, "LDS map");

constexpr size_t WS_ZERO = 512 * 1024;
constexpr size_t WS_BAR = 256 * 1024;
constexpr size_t WS_WIN = WS_W;
constexpr size_t WS_WO = WS_WIN + 24 * MiB;
constexpr size_t WS_WG = WS_WO + 8 * MiB;
constexpr size_t WS_WP = WS_WG + 8 * MiB;
constexpr size_t WS_WUP = WS_WP + 1 * MiB;
constexpr size_t WS_WDN = WS_WUP + 128 * MiB;
constexpr size_t WS_WR = WS_WDN + 64 * MiB;
constexpr size_t WS_AO = WS_WUP + 64 * MiB;
static_assert(WS_WR + 1 * MiB <= WS_A, "weight region");
constexpr size_t WS_LRS = WS_SM + 6 * MiB, WS_LTW = WS_SM + 8 * MiB;
constexpr size_t WS_SSQ = WS_SM + 4 * MiB;
constexpr size_t WS_H8 = WS_E + 32 * MiB;
constexpr size_t WS_H28 = WS_C + 32 * MiB;
constexpr size_t WS_PART = WS_E;

__device__ __forceinline__ int lane_id() { return (int)__builtin_amdgcn_mbcnt_hi(~0u, __builtin_amdgcn_mbcnt_lo(~0u, 0u)); }
__device__ __forceinline__ int lane_id_fresh() { unsigned z = 0u; asm volatile("" : "+v"(z)); return (int)__builtin_amdgcn_mbcnt_hi(~0u, __builtin_amdgcn_mbcnt_lo(~0u, z)); }
typedef float f32x2_t __attribute__((ext_vector_type(2))); typedef __bf16 bf16x2_t __attribute__((ext_vector_type(2)));
__device__ __forceinline__ unsigned cvt_pk_bf16(float lo, float hi) { const f32x2_t v = {lo, hi}; const bf16x2_t b = __builtin_convertvector(v, bf16x2_t); return __builtin_bit_cast(unsigned, b); }
typedef int v8i_t __attribute__((ext_vector_type(8)));
typedef int v4i_t __attribute__((ext_vector_type(4)));
__device__ __forceinline__ unsigned pack4_fp8(f32x4 v, float sc) {
    int w = 0;
    const float a = __builtin_amdgcn_fmed3f(v[0] * sc, -448.f, 448.f), b = __builtin_amdgcn_fmed3f(v[1] * sc, -448.f, 448.f);
    const float c = __builtin_amdgcn_fmed3f(v[2] * sc, -448.f, 448.f), d = __builtin_amdgcn_fmed3f(v[3] * sc, -448.f, 448.f);
    w = __builtin_amdgcn_cvt_pk_fp8_f32(a, b, w, false); w = __builtin_amdgcn_cvt_pk_fp8_f32(c, d, w, true);
    return (unsigned)w;
}
__device__ __forceinline__ f32x4 unpack4_fp8(unsigned w) { const int iw = (int)w;
    return (f32x4){__builtin_amdgcn_cvt_f32_fp8(iw, 0), __builtin_amdgcn_cvt_f32_fp8(iw, 1), __builtin_amdgcn_cvt_f32_fp8(iw, 2), __builtin_amdgcn_cvt_f32_fp8(iw, 3)}; }
constexpr float F8_W = 256.f, F8_H = 16.f, F8_HID = 8.f, F8_Y = 32.f;
constexpr int E8_W = 0x77777777, E8_H = 0x7b7b7b7b, E8_HID = 0x7c7c7c7c;
__device__ __forceinline__ float fast_sigmoid(float z) { return __builtin_amdgcn_rcpf(1.f + __builtin_amdgcn_exp2f(-LOG2E * z)); }

__device__ __forceinline__ u32x4 pack8(f32x4 a, f32x4 b) { u32x4 w; w.x = cvt_pk_bf16(a[0], a[1]); w.y = cvt_pk_bf16(a[2], a[3]); w.z = cvt_pk_bf16(b[0], b[1]); w.w = cvt_pk_bf16(b[2], b[3]); return w; }
__device__ __forceinline__ float dot4(f32x4 a) { return (a[0] * a[0] + a[1] * a[1]) + (a[2] * a[2] + a[3] * a[3]); }

#define XB_TMO      128
#define XB_XCNT(j)  (256  + 64 * (j))
#define XB_XSUB(j)  (1280 + 64 * (j))
#define XB_XGEN(j)  (2304 + 64 * (j))
#define XB_TOP      3328
#define XB_TOPGEN   3392
#define XCD_BAR_WORDS 3456
#define XB_SPIN_CAP (1u << 18)
__device__ __forceinline__ unsigned xb_ld(unsigned* p)              { return __hip_atomic_load(p, __ATOMIC_RELAXED, __HIP_MEMORY_SCOPE_AGENT); }
__device__ __forceinline__ unsigned xb_add(unsigned* p, unsigned v) { return __hip_atomic_fetch_add(p, v, __ATOMIC_RELAXED, __HIP_MEMORY_SCOPE_AGENT); }
__device__ __forceinline__ unsigned xb_xcc_id() { return (unsigned)__builtin_amdgcn_s_getreg((3 << 11) | 20) & 0xFu; }
#define XB_SPIN(cond, bar) do { unsigned _sp = 0; while (cond) { __builtin_amdgcn_s_sleep(1); \
    if ((++_sp & 255u) == 0u) { if (xb_ld(&(bar)[XB_TMO])) break; if (_sp > XB_SPIN_CAP) { atomicAdd(&(bar)[XB_TMO], 1u); break; } } } } while (0)
struct XcdBarrier { unsigned* bar; unsigned x; volatile LAS unsigned* st; };
__device__ __forceinline__ XcdBarrier xcd_barrier_post(unsigned* bar, volatile LAS unsigned* st) {
    XcdBarrier b; b.bar = bar; b.x = xb_xcc_id(); b.st = st;
    if (threadIdx.x == 0) (void)xb_add(&bar[XB_XCNT(b.x)], 1u);
    return b;
}
__device__ __forceinline__ void xcd_barrier_complete(unsigned* bar, unsigned x, unsigned& nloc, unsigned& nx) {
    const unsigned G = gridDim.x * gridDim.y * gridDim.z;
    unsigned sum, cnt, mine, sp = 0u;
    for (;;) {
        sum = 0u; cnt = 0u; mine = 0u;
#pragma unroll
        for (unsigned j = 0; j < 16; ++j) { const unsigned c = xb_ld(&bar[XB_XCNT(j)]); sum += c; cnt += (c > 0u) ? 1u : 0u; mine = (j == x) ? c : mine; }
        if (sum == G) break;
        __builtin_amdgcn_s_sleep(1);
        if ((++sp & 255u) == 0u) { if (xb_ld(&bar[XB_TMO])) break; if (sp > XB_SPIN_CAP) { atomicAdd(&bar[XB_TMO], 1u); break; } }
    }
    nloc = mine > 0u ? mine : 1u; nx = cnt > 0u ? cnt : 1u;
}
__device__ __forceinline__ void xcd_barrier(const XcdBarrier& b) {
    asm volatile("s_waitcnt vmcnt(0)" ::: "memory");
    __syncthreads();
    if (threadIdx.x == 0) {
        unsigned* bar = b.bar;
        __builtin_amdgcn_s_waitcnt(0);
        unsigned nloc = b.st[0], nx = b.st[1];
        if (nloc == 0u) { xcd_barrier_complete(bar, b.x, nloc, nx); b.st[0] = nloc; b.st[1] = nx; }
        const unsigned old = xb_add(&bar[XB_XSUB(b.x)], 1u);
        const unsigned gen = old / nloc;
        if (old + 1u == (gen + 1u) * nloc) {
            __builtin_amdgcn_fence(__ATOMIC_RELEASE, "agent");
            asm volatile("s_waitcnt vmcnt(0)" ::: "memory");
            const unsigned og = xb_add(&bar[XB_TOP], 1u);
            const unsigned tg = og / nx;
            if (og + 1u == (tg + 1u) * nx) xb_add(&bar[XB_TOPGEN], 1u);
            else XB_SPIN(xb_ld(&bar[XB_TOPGEN]) == tg, bar);
            __builtin_amdgcn_fence(__ATOMIC_ACQUIRE, "agent");
            xb_add(&bar[XB_XGEN(b.x)], 1u);
            asm volatile("s_waitcnt vmcnt(0)" ::: "memory");
        } else {
            XB_SPIN(xb_ld(&bar[XB_XGEN(b.x)]) == gen, bar);
            __builtin_amdgcn_fence(__ATOMIC_ACQUIRE, "agent");
            asm volatile("s_waitcnt vmcnt(0)" ::: "memory");
        }
    }
    __syncthreads();
}

namespace g8 {
constexpr int BM = 256, BK = 64, HALF = 128, HTB = HALF * BK * 2, STAGE_BYTES = 8 * HTB;
static_assert(STAGE_BYTES == RING_BYTES, "ring");
__host__ __device__ __forceinline__ int lds_byte(int r, int c) { const int st = (r >> 4) * 2 + (c >> 5), rr = r & 15, cc = c & 31, ob = rr * 64 + cc * 2; return st * 1024 + (ob ^ (((ob >> 9) & 1) << 5)); }
__host__ __device__ __forceinline__ void stage_rc(int b, int& R, int& C) { const int st = b / 1024, sb = b % 1024, swz = sb ^ (((sb >> 9) & 1) << 5); R = (st >> 1) * 16 + swz / 64; C = (st & 1) * 32 + (swz % 64) / 2; }
struct Unit { int pm, pn, e; };

struct DenseSched {
    static constexpr bool GATHER = false;
    const char* A; const char* Bt; int lda, ldb; int nM, nN, nwg, G, c;
    __device__ __forceinline__ void init(const void* A_, int lda_, const void* Bt_, int ldb_, int Mrows, int N, int G_, int c_) { A = (const char*)A_; Bt = (const char*)Bt_; lda = lda_; ldb = ldb_; nM = Mrows / BM; nN = N / BM; nwg = nM * nN; G = G_; c = c_; }
    __device__ __forceinline__ bool next(int i, Unit& u) const {
        const long L = (long)i * G + c; if (L >= nwg) return false;
        int wgid = (int)L; { const int q = nwg / 8, r = nwg % 8, xcd = wgid % 8, off = wgid / 8; wgid = (xcd < r ? xcd * (q + 1) : r * (q + 1) + (xcd - r) * q) + off; }
        const int nig = 8 * nN, gid = wgid / nig, fm = gid * 8, gsz = (nM - fm) < 8 ? (nM - fm) : 8;
        u.pm = fm + ((wgid % nig) % gsz); u.pn = (wgid % nig) / gsz; u.e = 0; return true;
    }
    __device__ __forceinline__ const char* a_base(const Unit& u) const { return A + (size_t)u.pm * BM * lda; }
    __device__ __forceinline__ const char* b_base(const Unit& u) const { return Bt + (size_t)u.pn * BM * ldb; }
    __device__ __forceinline__ unsigned a_off(const Unit&, int row, int C) const { return (unsigned)(row * lda + C * 2); }
    __device__ __forceinline__ unsigned b_off(int row, int C) const { return (unsigned)(row * ldb + C * 2); }
};

struct TailSched {
    static constexpr bool GATHER = false;
    const char* A; const char* Bt; int lda, ldb, nunits, first, stride;
    __device__ __forceinline__ bool next(int i, Unit& u) const { const int L = first + i * stride; if (first < 0 || L >= nunits) return false; u.pm = L >> 3; u.pn = L & 7; u.e = 0; return true; }
    __device__ __forceinline__ const char* a_base(const Unit& u) const { return A + (size_t)u.pm * BM * lda; }
    __device__ __forceinline__ const char* b_base(const Unit& u) const { return Bt + (size_t)u.pn * BM * ldb; }
    __device__ __forceinline__ unsigned a_off(const Unit&, int row, int C) const { return (unsigned)(row * lda + C * 2); }
    __device__ __forceinline__ unsigned b_off(int row, int C) const { return (unsigned)(row * ldb + C * 2); }
};

template <class Epi, class Sched, bool F8 = false>
__device__ __forceinline__ void gemm_phase(LAS unsigned char* lds, const int wid, const int K, const Sched& S, const Epi& E, const int sclW = 0, const int sclA = 0) {
    const int lane = lane_id_fresh()  , tid = wid * 64 + lane, wr = wid >> 2, wc = wid & 3, fr = lane & 15, fq = lane >> 4;
    const int nt = F8 ? K / 128 : K / BK;
    int Rr[2], Cc[2];
#pragma unroll
    for (int i = 0; i < 2; ++i) stage_rc(tid * 16 + i * 8192, Rr[i], Cc[i]);
    unsigned voffB[2];
#pragma unroll
    for (int i = 0; i < 2; ++i) voffB[i] = S.b_off(Rr[i], Cc[i]);
    const size_t kstep = (size_t)(BK * 2);
    const size_t hstepB = (size_t)S.b_off(HALF, 0);
    const unsigned ldsw = (unsigned)wid * 1024u;
    const int aoff = lds_byte(wr * 64 + fr, fq * 8), boff = lds_byte(wc * 32 + fr, fq * 8);
#define G8_SA(b, h) (((b) * 2 + (h)) * HTB)
#define G8_SB(b, h) ((4 + (b) * 2 + (h)) * HTB)
#define G8_STAGE(bufoff, gbase, voff) do { _Pragma("unroll") for (int _i = 0; _i < 2; ++_i) { unsigned _o = (voff)[_i]; asm volatile("" : "+v"(_o));     \
        __builtin_amdgcn_global_load_lds((const unsigned*)((const char*)(gbase) + _o), (LAS unsigned*)(lds + (bufoff) + ldsw + _i * 8192), 16, 0, 0); } } while (0)
#define G8_LD32(p) __builtin_shufflevector(*(const LAS v4i_t*)(p), *(const LAS v4i_t*)((p) + 1024), 0, 1, 2, 3, 4, 5, 6, 7)
#define G8_LDA(dst, b, h) do { _Pragma("unroll") for (int m = 0; m < 4; ++m) dst[m] = G8_LD32(lds + G8_SA(b, h) + aoff + m * 2048); } while (0)
#define G8_LDB(dst, b, h) do { _Pragma("unroll") for (int n = 0; n < 2; ++n) dst[n] = G8_LD32(lds + G8_SB(b, h) + boff + n * 2048); } while (0)
#define G8_LO(x) __builtin_bit_cast(bf16x8, __builtin_shufflevector(x, x, 0, 1, 2, 3))
#define G8_HI(x) __builtin_bit_cast(bf16x8, __builtin_shufflevector(x, x, 4, 5, 6, 7))
#define G8_MMA(ai, bj, At, Bt) do { __builtin_amdgcn_s_setprio(1); _Pragma("unroll") for (int m = 0; m < 4; ++m) _Pragma("unroll") for (int n = 0; n < 2; ++n) { \
        if constexpr (F8) acc[ai][bj][m][n] = __builtin_amdgcn_mfma_scale_f32_16x16x128_f8f6f4(Bt[n], At[m], acc[ai][bj][m][n], 0, 0, 0, sclW, 0, sclA); \
        else { acc[ai][bj][m][n] = __builtin_amdgcn_mfma_f32_16x16x32_bf16(G8_LO(Bt[n]), G8_LO(At[m]), acc[ai][bj][m][n], 0, 0, 0); \
               acc[ai][bj][m][n] = __builtin_amdgcn_mfma_f32_16x16x32_bf16(G8_HI(Bt[n]), G8_HI(At[m]), acc[ai][bj][m][n], 0, 0, 0); } } \
        __builtin_amdgcn_s_setprio(0); } while (0)
#define G8_WAIT_V(n) asm volatile("s_waitcnt vmcnt(" #n ")" ::: "memory")
#define G8_WAIT_L(n) asm volatile("s_waitcnt lgkmcnt(" #n ")" ::: "memory")
#define G8_BAR __builtin_amdgcn_s_barrier()
#define G8_SCHED __builtin_amdgcn_sched_barrier(0)
    Unit cur, nxt; int ui = 0;
    if (!S.next(0, cur)) return;
    f32x4 acc[2][2][4][2];
#pragma unroll
    for (int a = 0; a < 2; ++a)
#pragma unroll
        for (int b = 0; b < 2; ++b)
#pragma unroll
            for (int m = 0; m < 4; ++m)
#pragma unroll
                for (int n = 0; n < 2; ++n) acc[a][b][m][n] = (f32x4){0.f, 0.f, 0.f, 0.f};
    v8i_t At[4], B0[2], B1[2];
    unsigned cvA[2][2];
#define G8_NVSLOT ((LAS u32x4*)(lds + RING_BYTES) + (lane_id_fresh() + wid * 64))
#pragma unroll
    for (int h = 0; h < 2; ++h)
#pragma unroll
        for (int i = 0; i < 2; ++i) cvA[h][i] = S.a_off(cur, h * HALF + Rr[i], Cc[i]);
    const char* cA = S.a_base(cur); const char* cB = S.b_base(cur);
    G8_STAGE(G8_SB(0, 0), cB, voffB); G8_STAGE(G8_SB(0, 1), cB + hstepB, voffB); G8_STAGE(G8_SA(0, 0), cA, cvA[0]); G8_STAGE(G8_SA(0, 1), cA, cvA[1]);
    if (wr == 1) G8_BAR;
    G8_WAIT_V(2); G8_BAR;
    G8_STAGE(G8_SB(1, 0), cB + kstep, voffB); G8_STAGE(G8_SA(1, 0), cA + kstep, cvA[0]); G8_STAGE(G8_SB(1, 1), cB + hstepB + kstep, voffB);
    G8_WAIT_V(6); G8_BAR;
    LAS unsigned char* const metab = lds + RING_BYTES + 8192;
    for (;;) {
        E.meta_issue(cur, metab + (ui & 1) * 2048, wid);
        const bool has_next = S.next(ui + 1, nxt);
        const char* nA = has_next ? S.a_base(nxt) : cA; const char* nB = has_next ? S.b_base(nxt) : cB;
        if constexpr (Sched::GATHER) {
            const int t2 = lane_id_fresh() + wid * 64;
            int R0, C0, R1, C1; stage_rc(t2 * 16, R0, C0); stage_rc(t2 * 16 + 8192, R1, C1);
            u32x4 nv;
            nv.x = has_next ? S.a_off(nxt, R0, C0) : cvA[0][0]; nv.y = has_next ? S.a_off(nxt, R1, C1) : cvA[0][1];
            nv.z = has_next ? S.a_off(nxt, HALF + R0, C0) : cvA[1][0]; nv.w = has_next ? S.a_off(nxt, HALF + R1, C1) : cvA[1][1];
            *((LAS u32x4*)(lds + RING_BYTES) + t2) = nv;
        }
        asm volatile(".p2align 8" ::: "memory");
        for (int t = 0; t < nt; t += 2) {
            const bool last = (t == nt - 2);
            const char* a1 = cA + (size_t)(t + 1) * kstep;
            const char* a2 = last ? nA : cA + (size_t)(t + 2) * kstep; const char* b2 = last ? nB : cB + (size_t)(t + 2) * kstep;
            const char* a3 = a2 + kstep; const char* b3 = b2 + kstep;
            unsigned v2[2][2];
            if (Sched::GATHER && last) { const u32x4 nv = *G8_NVSLOT; v2[0][0] = nv.x; v2[0][1] = nv.y; v2[1][0] = nv.z; v2[1][1] = nv.w; }
            else { v2[0][0] = cvA[0][0]; v2[0][1] = cvA[0][1]; v2[1][0] = cvA[1][0]; v2[1][1] = cvA[1][1]; }
            G8_LDB(B0, 0, 0); G8_LDB(B1, 0, 1); G8_SCHED; G8_LDA(At, 0, 0); G8_STAGE(G8_SA(1, 1), a1, cvA[1]);
            G8_WAIT_V(8); G8_WAIT_L(0); G8_BAR; G8_MMA(0, 0, At, B0); G8_MMA(0, 1, At, B1); G8_BAR; G8_SCHED;
            G8_LDA(At, 0, 1); G8_STAGE(G8_SB(0, 0), b2, voffB); G8_STAGE(G8_SB(0, 1), b2 + hstepB, voffB); G8_STAGE(G8_SA(0, 0), a2, v2[0]);
            G8_WAIT_V(8); G8_WAIT_L(0); G8_BAR; G8_MMA(1, 0, At, B0); G8_MMA(1, 1, At, B1); G8_BAR; G8_SCHED;
            G8_LDB(B0, 1, 0); G8_LDB(B1, 1, 1); G8_SCHED; G8_LDA(At, 1, 0); G8_STAGE(G8_SA(0, 1), a2, v2[1]);
            G8_WAIT_V(8); G8_WAIT_L(0); G8_BAR; G8_MMA(0, 0, At, B0); G8_MMA(0, 1, At, B1); G8_BAR; G8_SCHED;
            G8_LDA(At, 1, 1); G8_STAGE(G8_SB(1, 0), b3, voffB); G8_STAGE(G8_SB(1, 1), b3 + hstepB, voffB); G8_STAGE(G8_SA(1, 0), a3, v2[0]);
            G8_WAIT_V(8); G8_WAIT_L(0); G8_BAR; G8_MMA(1, 0, At, B0); G8_MMA(1, 1, At, B1); G8_BAR; G8_SCHED;
        }
        if (wr == 0) G8_BAR;
        { const int lf = lane_id_fresh(); E(acc, cur, wr, wc, lf & 15, lf >> 4, (const LAS float*)(metab + (ui & 1) * 2048)); }
        if (!has_next) break;
#pragma unroll
        for (int a = 0; a < 2; ++a)
#pragma unroll
            for (int b = 0; b < 2; ++b)
#pragma unroll
                for (int m = 0; m < 4; ++m)
#pragma unroll
                    for (int n = 0; n < 2; ++n) acc[a][b][m][n] = (f32x4){0.f, 0.f, 0.f, 0.f};
        cur = nxt; cA = nA; cB = nB; ++ui;
        if constexpr (Sched::GATHER) { const u32x4 nv = *G8_NVSLOT; cvA[0][0] = nv.x; cvA[0][1] = nv.y; cvA[1][0] = nv.z; cvA[1][1] = nv.w; }
        if (wr == 1) G8_BAR;
    }
    G8_WAIT_V(0);
    G8_BAR;
#undef G8_SA
#undef G8_SB
#undef G8_STAGE
#undef G8_LDA
#undef G8_LDB
#undef G8_MMA
#undef G8_NVSLOT
#undef G8_LO
#undef G8_HI
#undef G8_LD32
#undef G8_WAIT_V
#undef G8_WAIT_L
#undef G8_BAR
#undef G8_SCHED
}

#define G8_META_DMA(srcptr, mbuf, col, wid) do { if ((wid) < 4) __builtin_amdgcn_global_load_lds((const unsigned*)(srcptr), (LAS unsigned*)((mbuf) + (col) * 1024 + (wid) * 256), 4, 0, 0); } while (0)

struct EpiProj {
    const float* rs0; const float* g_q; const float* g_k; bf16_t *Q, *Kb, *V, *GB, *CU;
    __device__ __forceinline__ void meta_issue(const Unit& u, LAS unsigned char* mb, int wid) const { G8_META_DMA(rs0 + u.pm * BM + wid * 64 + lane_id_fresh(), mb, 0, wid); }
    __device__ __forceinline__ void operator()(f32x4 (&acc)[2][2][4][2], const Unit& u, int wr, int wc, int fr, int fq, const LAS float* meta) const {
        const int pn = u.pn, rbase = u.pm * BM + wr * 64 + fr;
        float rsv[2][4];
#pragma unroll
        for (int ai = 0; ai < 2; ++ai)
#pragma unroll
            for (int m = 0; m < 4; ++m) rsv[ai][m] = meta[ai * HALF + wr * 64 + m * 16 + fr];
        if (pn < 8) {
            const bool isq = pn < 4; const float* gn = isq ? g_q : g_k; const float sc = isq ? 0.125f * LOG2E : 1.f;
            bf16_t* O = isq ? Q : Kb; const int colb = (pn & 3) * 256 + wc * 64 + fq * 8;
            f32x4 gv[2][2];
#pragma unroll
            for (int bj = 0; bj < 2; ++bj)
#pragma unroll
                for (int n = 0; n < 2; ++n) gv[bj][n] = *(const f32x4*)(gn + bj * 32 + fq * 8 + n * 4);
#pragma unroll
            for (int ai = 0; ai < 2; ++ai)
#pragma unroll
                for (int m = 0; m < 4; ++m) {
                    const int row = rbase + ai * HALF + m * 16; const float rs = rsv[ai][m];
                    float ss = 0.f;
#pragma unroll
                    for (int bj = 0; bj < 2; ++bj)
#pragma unroll
                        for (int n = 0; n < 2; ++n) { acc[ai][bj][m][n] = acc[ai][bj][m][n] * rs; ss += dot4(acc[ai][bj][m][n]); }
                    ss += __shfl_xor(ss, 16); ss += __shfl_xor(ss, 32);
                    const float r = rsqrtf(ss * (1.f / 64.f) + EPS) * sc;
#pragma unroll
                    for (int bj = 0; bj < 2; ++bj) *(u32x4*)(O + (size_t)row * 1024 + colb + bj * 32) = pack8(acc[ai][bj][m][0] * r * gv[bj][0], acc[ai][bj][m][1] * r * gv[bj][1]);
                }
        } else if (pn < 16) {
            bf16_t* O = pn < 12 ? V : GB; const int colb = (pn & 3) * 256 + wc * 32 + fq * 8;
#pragma unroll
            for (int ai = 0; ai < 2; ++ai)
#pragma unroll
                for (int m = 0; m < 4; ++m) {
                    const int row = rbase + ai * HALF + m * 16; const float rs = rsv[ai][m];
#pragma unroll
                    for (int bj = 0; bj < 2; ++bj) *(u32x4*)(O + (size_t)row * 1024 + colb + bj * 128) = pack8(acc[ai][bj][m][0] * rs, acc[ai][bj][m][1] * rs);
                }
        } else {
            const int colb = (pn - 16) * 128 + wc * 32 + fq * 8;
#pragma unroll
            for (int ai = 0; ai < 2; ++ai)
#pragma unroll
                for (int m = 0; m < 4; ++m) {
                    const int row = rbase + ai * HALF + m * 16; const float rs = rsv[ai][m], rs2 = rs * rs;
                    *(u32x4*)(CU + (size_t)row * 1024 + colb) = pack8(acc[ai][0][m][0] * acc[ai][1][m][0] * rs2, acc[ai][0][m][1] * acc[ai][1][m][1] * rs2);
                }
        }
    }
};
struct EpiBf16 {
    bf16_t* O; int ldo;
    __device__ __forceinline__ void meta_issue(const Unit&, LAS unsigned char*, int) const {}
    __device__ __forceinline__ void operator()(f32x4 (&acc)[2][2][4][2], const Unit& u, int wr, int wc, int fr, int fq, const LAS float* meta) const {
        const int rbase = u.pm * BM + wr * 64 + fr, colb = u.pn * BM + wc * 32 + fq * 8;
#pragma unroll
        for (int ai = 0; ai < 2; ++ai)
#pragma unroll
            for (int m = 0; m < 4; ++m) { const int row = rbase + ai * HALF + m * 16;
#pragma unroll
                for (int bj = 0; bj < 2; ++bj) *(u32x4*)(O + (size_t)row * ldo + colb + bj * 128) = pack8(acc[ai][bj][m][0], acc[ai][bj][m][1]); }
    }
};
struct EpiRes {
    __device__ __forceinline__ void meta_issue(const Unit&, LAS unsigned char*, int) const {}
    const bf16_t* xb; bf16_t* H; float* SSQ; unsigned char* H8;
    __device__ __forceinline__ void operator()(f32x4 (&acc)[2][2][4][2], const Unit& u, int wr, int wc, int fr, int fq, const LAS float* meta) const {
        const int rbase = u.pm * BM + wr * 64 + fr, colb = u.pn * BM + wc * 32 + fq * 8;
        u32x4 xa[2][4][2];
#pragma unroll
        for (int ai = 0; ai < 2; ++ai)
#pragma unroll
            for (int m = 0; m < 4; ++m)
#pragma unroll
                for (int bj = 0; bj < 2; ++bj) xa[ai][m][bj] = *(const u32x4*)(xb + (size_t)(rbase + ai * HALF + m * 16) * DM + colb + bj * 128);
#pragma unroll
        for (int ai = 0; ai < 2; ++ai)
#pragma unroll
            for (int m = 0; m < 4; ++m) { const int row = rbase + ai * HALF + m * 16; float ss = 0.f;
#pragma unroll
                for (int bj = 0; bj < 2; ++bj) { const size_t o = (size_t)row * DM + colb + bj * 128; const u32x4 xw = xa[ai][m][bj];
                    const f32x4 x0 = (f32x4){__uint_as_float(xw.x << 16), __uint_as_float(xw.x & 0xffff0000u), __uint_as_float(xw.y << 16), __uint_as_float(xw.y & 0xffff0000u)};
                    const f32x4 x1 = (f32x4){__uint_as_float(xw.z << 16), __uint_as_float(xw.z & 0xffff0000u), __uint_as_float(xw.w << 16), __uint_as_float(xw.w & 0xffff0000u)};
                    const f32x4 h0 = acc[ai][bj][m][0] + x0, h1 = acc[ai][bj][m][1] + x1;
                    ss += dot4(h0) + dot4(h1);
                    *(u32x4*)(H + o) = pack8(h0, h1);
                    u32x2 w8; w8.x = pack4_fp8(h0, F8_H); w8.y = pack4_fp8(h1, F8_H); *(u32x2*)(H8 + o) = w8; }
                ss += __shfl_xor(ss, 16); ss += __shfl_xor(ss, 32);
                if (fq == 0) SSQ[(size_t)row * 32 + u.pn * 4 + wc] = ss; }
    }
};
struct EpiRouter {
    float* PART;
    __device__ __forceinline__ void meta_issue(const Unit&, LAS unsigned char*, int) const {}
    __device__ __forceinline__ void operator()(f32x4 (&acc)[2][2][4][2], const Unit& u, int wr, int wc, int fr, int fq, const LAS float* meta) const {
        if (wc < 2) {
            const int rbase = u.pm * BM + wr * 64 + fr;
#pragma unroll
            for (int ai = 0; ai < 2; ++ai)
#pragma unroll
                for (int m = 0; m < 4; ++m) { const int row = rbase + ai * HALF + m * 16;
#pragma unroll
                    for (int n = 0; n < 2; ++n) *(f32x4*)(PART + ((size_t)u.e * M + row) * 64 + wc * 32 + n * 16 + fq * 4) = acc[ai][0][m][n]; }
        }
    }
};
struct KSplitSched {
    static constexpr bool GATHER = false;
    const char* A; const char* Bt; int G, c;
    __device__ __forceinline__ bool next(int i, Unit& u) const { const int L = i * G + c; if (L >= (M / BM) * 4) return false; u.pm = L >> 2; u.pn = 0; u.e = L & 3; return true; }
    __device__ __forceinline__ const char* a_base(const Unit& u) const { return A + (size_t)u.pm * BM * DM * 2 + (size_t)u.e * 512 * 2; }
    __device__ __forceinline__ const char* b_base(const Unit& u) const { return Bt + (size_t)u.e * 512 * 2; }
    __device__ __forceinline__ unsigned a_off(const Unit&, int row, int C) const { return (unsigned)(row * DM + C) * 2u; }
    __device__ __forceinline__ unsigned b_off(int row, int C) const { return (unsigned)(row * DM + C) * 2u; }
};
__device__ __forceinline__ f32x4 bf4lo(unsigned a, unsigned b) { return (f32x4){__uint_as_float(a << 16), __uint_as_float(a & 0xffff0000u), __uint_as_float(b << 16), __uint_as_float(b & 0xffff0000u)}; }
struct EpiFinal {
    const bf16_t* H2B; const bf16_t* PP; const float* rs2; float* out;
    __device__ __forceinline__ void meta_issue(const Unit& u, LAS unsigned char* mb, int wid) const { G8_META_DMA(rs2 + u.pm * BM + wid * 64 + lane_id_fresh(), mb, 0, wid); }
    __device__ __forceinline__ void operator()(f32x4 (&acc)[2][2][4][2], const Unit& u, int wr, int wc, int fr, int fq, const LAS float* meta) const {
        const int rbase = u.pm * BM + wr * 64 + fr, colb = u.pn * BM + wc * 32 + fq * 8;
        float rsv[2][4];
#pragma unroll
        for (int ai = 0; ai < 2; ++ai)
#pragma unroll
            for (int m = 0; m < 4; ++m) rsv[ai][m] = meta[ai * HALF + wr * 64 + m * 16 + fr];
        u32x4 hb[2][2][2], pb[2][2][2];
#define EF_LOAD(buf, b) do { _Pragma("unroll") for (int r2 = 0; r2 < 2; ++r2) { const int row_ = rbase + ((b) >> 1) * HALF + (((b) & 1) * 2 + r2) * 16; \
            _Pragma("unroll") for (int bj = 0; bj < 2; ++bj) { const size_t o_ = (size_t)row_ * DM + colb + bj * 128; hb[buf][r2][bj] = *(const u32x4*)(H2B + o_); pb[buf][r2][bj] = *(const u32x4*)(PP + o_); } } } while (0)
        EF_LOAD(0, 0);
#pragma unroll
        for (int b = 0; b < 4; ++b) {
            if (b == 0) EF_LOAD(1, 1); else if (b == 1) EF_LOAD(0, 2); else if (b == 2) EF_LOAD(1, 3);
#pragma unroll
            for (int r2 = 0; r2 < 2; ++r2) { const int ai = b >> 1, m = (b & 1) * 2 + r2, row = rbase + ai * HALF + m * 16; const float rs = rsv[ai][m];
#pragma unroll
                for (int bj = 0; bj < 2; ++bj) { const size_t o = (size_t)row * DM + colb + bj * 128;
                    const u32x4 hv = hb[b & 1][r2][bj], pv = pb[b & 1][r2][bj];
                    const f32x4 h0 = bf4lo(hv.x, hv.y), h1 = bf4lo(hv.z, hv.w), p0 = bf4lo(pv.x, pv.y), p1 = bf4lo(pv.z, pv.w);
                    f32x4 z0 = acc[ai][bj][m][0] * rs, z1 = acc[ai][bj][m][1] * rs, o0, o1;
#pragma unroll
                    for (int j = 0; j < 4; ++j) { o0[j] = h0[j] + p0[j] * fast_sigmoid(z0[j]); o1[j] = h1[j] + p1[j] * fast_sigmoid(z1[j]); }
                    *(f32x4*)(out + o) = o0; *(f32x4*)(out + o + 4) = o1; } }
        }
#undef EF_LOAD
    }
};

struct MoeTab { const LAS int* texp; const LAS int* trow0; const LAS int* tcnt; int ntile; };
struct UpSched {
    static constexpr bool GATHER = true;
    const char* Hb; const char* Wup; const int* LIST; MoeTab T; int G, c;
    __device__ __forceinline__ bool next(int i, Unit& u) const { const int L = i * G + c; if (L >= T.ntile * 4) return false; u.pm = L >> 2; u.pn = L & 3; u.e = T.texp[u.pm]; return true; }
    __device__ __forceinline__ const char* a_base(const Unit&) const { return Hb; }
    __device__ __forceinline__ const char* b_base(const Unit& u) const { return Wup + ((size_t)u.e * 1024 + (size_t)u.pn * 256) * DM; }
    __device__ __forceinline__ unsigned a_off(const Unit& u, int row, int C) const {
        int idx = T.trow0[u.pm] + row; const int n = T.tcnt[u.e]; idx = idx < n ? idx : n - 1;
        const int slot = LIST[(size_t)u.e * M + idx]; return (unsigned)(slot >> 1) * (unsigned)DM + (unsigned)C * 2u; }
    __device__ __forceinline__ unsigned b_off(int row, int C) const { return (unsigned)(row * DM + C * 2); }
};
struct DnSched {
    static constexpr bool GATHER = false;
    const char* HID; const char* Wdn; MoeTab T; int G, c;
    __device__ __forceinline__ bool next(int i, Unit& u) const { const int L = i * G + c; if (L >= T.ntile * 8) return false; u.pm = L >> 3; u.pn = L & 7; u.e = T.texp[u.pm]; return true; }
    __device__ __forceinline__ const char* a_base(const Unit& u) const { return HID + (size_t)u.pm * 256 * DFF; }
    __device__ __forceinline__ const char* b_base(const Unit& u) const { return Wdn + ((size_t)u.e * DM + (size_t)u.pn * 256) * DFF; }
    __device__ __forceinline__ unsigned a_off(const Unit&, int row, int C) const { return (unsigned)(row * DFF + C * 2); }
    __device__ __forceinline__ unsigned b_off(int row, int C) const { return (unsigned)(row * DFF + C * 2); }
};
struct EpiUp {
    const float* LRS; bf16_t* HID; MoeTab T; const float* ZERO;
    __device__ __forceinline__ void meta_issue(const Unit& u, LAS unsigned char* mb, int wid) const { const int n = T.tcnt[u.e]; const int idx = T.trow0[u.pm] + wid * 64 + lane_id_fresh();
        G8_META_DMA(idx < n ? LRS + (size_t)u.e * M + idx : ZERO, mb, 0, wid); }
    __device__ __forceinline__ void operator()(f32x4 (&acc)[2][2][4][2], const Unit& u, int wr, int wc, int fr, int fq, const LAS float* meta) const {
        const int colb = u.pn * 128 + wc * 32 + fq * 8;
        float rsv[2][4];
#pragma unroll
        for (int ai = 0; ai < 2; ++ai)
#pragma unroll
            for (int m = 0; m < 4; ++m) rsv[ai][m] = meta[ai * HALF + wr * 64 + m * 16 + fr];
#pragma unroll
        for (int ai = 0; ai < 2; ++ai)
#pragma unroll
            for (int m = 0; m < 4; ++m) {
                const int rit = ai * HALF + wr * 64 + m * 16 + fr; const float rs = rsv[ai][m];
                f32x4 h[2];
#pragma unroll
                for (int nn = 0; nn < 2; ++nn) { const f32x4 a = acc[ai][0][m][nn] * rs, b = acc[ai][1][m][nn] * rs;
#pragma unroll
                    for (int j = 0; j < 4; ++j) h[nn][j] = a[j] * fast_sigmoid(a[j]) * b[j]; }
                u32x2 w8; w8.x = pack4_fp8(h[0], F8_HID); w8.y = pack4_fp8(h[1], F8_HID);
                *(u32x2*)((unsigned char*)HID + ((size_t)u.pm * 256 + rit) * DFF + colb) = w8;
            }
    }
};
struct EpiDn {
    const int* LIST; const float* LTW; bf16_t* Y0; bf16_t* Y1; MoeTab T;
    __device__ __forceinline__ void meta_issue(const Unit& u, LAS unsigned char* mb, int wid) const { const int n = T.tcnt[u.e]; int idx = T.trow0[u.pm] + wid * 64 + lane_id_fresh(); idx = idx < n ? idx : n - 1;
        G8_META_DMA(LIST + (size_t)u.e * M + idx, mb, 0, wid); G8_META_DMA(LTW + (size_t)u.e * M + idx, mb, 1, wid); }
    __device__ __forceinline__ void operator()(f32x4 (&acc)[2][2][4][2], const Unit& u, int wr, int wc, int fr, int fq, const LAS float* meta) const {
        const int r0 = T.trow0[u.pm], n = T.tcnt[u.e], colb = u.pn * BM + wc * 32 + fq * 8;
        int slv[2][4]; float twv[2][4];
#pragma unroll
        for (int ai = 0; ai < 2; ++ai)
#pragma unroll
            for (int m = 0; m < 4; ++m) { const int rit = ai * HALF + wr * 64 + m * 16 + fr; slv[ai][m] = ((const LAS int*)meta)[rit]; twv[ai][m] = meta[256 + rit]; }
#pragma unroll
        for (int ai = 0; ai < 2; ++ai)
#pragma unroll
            for (int m = 0; m < 4; ++m) {
                const int idx = r0 + ai * HALF + wr * 64 + m * 16 + fr;
                if (idx < n) { const int slot = slv[ai][m]; const float tw = twv[ai][m];
                    unsigned char* Y = (unsigned char*)((slot & 1) ? Y1 : Y0) + (size_t)(slot >> 1) * DM + colb;
#pragma unroll
                    for (int bj = 0; bj < 2; ++bj) { u32x2 w8; w8.x = pack4_fp8(acc[ai][bj][m][0] * tw, F8_Y); w8.y = pack4_fp8(acc[ai][bj][m][1] * tw, F8_Y); *(u32x2*)(Y + bj * 128) = w8; } }
            }
    }
};
}

struct Args { const float* in[27]; float* out; unsigned char* ws; int ph_lo, ph_hi, li, pad; };
struct Frame {
    LAS unsigned char* lds; volatile LAS unsigned* MISC; unsigned char* ws;
    int wave, vcu, G;
};

__device__ __forceinline__ float wave_sum(float v) {
#pragma unroll
    for (int o = 1; o < 64; o <<= 1) v += __shfl_xor(v, o);
    return v;
}

__device__ __forceinline__ void tr_item(const float* src, int ld, const float* ks, int k0, int c0, bf16_t* dst, int ldk, int d0, int d1, LAS float* scr, int lane) {
    f32x4 v[16];
#pragma unroll
    for (int i = 0; i < 16; ++i) v[i] = *(const f32x4*)(src + (size_t)(k0 + 4 * i + (lane >> 4)) * ld + c0 + (lane & 15) * 4);
    const int c8 = lane & 7;
    f32x4 g0 = (f32x4){1.f, 1.f, 1.f, 1.f}, g1 = g0;
    if (ks) { g0 = *(const f32x4*)(ks + k0 + 8 * c8); g1 = *(const f32x4*)(ks + k0 + 8 * c8 + 4); }
#pragma unroll
    for (int i = 0; i < 16; ++i) { LAS float* s = scr + (4 * i + (lane >> 4)) * 65 + (lane & 15) * 4; s[0] = v[i][0]; s[1] = v[i][1]; s[2] = v[i][2]; s[3] = v[i][3]; }
    asm volatile("s_waitcnt lgkmcnt(0)" ::: "memory");
#pragma unroll
    for (int j = 0; j < 8; ++j) { const int rr = j * 8 + (lane >> 3), c32 = rr & 31;
        const int p32 = ((c32 >> 2) & 1) * 16 + (c32 >> 3) * 4 + (c32 & 3), drow = ((rr >> 5) ? d1 : d0) + p32;
        const LAS float* s = scr + (8 * c8) * 65 + rr;
        u32x4 o; o.x = cvt_pk_bf16(s[0] * g0[0], s[65] * g0[1]); o.y = cvt_pk_bf16(s[2 * 65] * g0[2], s[3 * 65] * g0[3]); o.z = cvt_pk_bf16(s[4 * 65] * g1[0], s[5 * 65] * g1[1]); o.w = cvt_pk_bf16(s[6 * 65] * g1[2], s[7 * 65] * g1[3]);
        *(u32x4*)(dst + (size_t)drow * ldk + k0 + 8 * c8) = o; }
    asm volatile("s_waitcnt lgkmcnt(0)" ::: "memory");
}
__device__ __forceinline__ void tr_item8(const float* src, int ld, const float* ks, int k0, int c0, unsigned char* dst, int ldk, int d0, int d1, LAS float* scr, int lane) {
    f32x4 v[16];
#pragma unroll
    for (int i = 0; i < 16; ++i) v[i] = *(const f32x4*)(src + (size_t)(k0 + 4 * i + (lane >> 4)) * ld + c0 + (lane & 15) * 4);
    const int c8 = lane & 7;
    f32x4 g0 = (f32x4){1.f, 1.f, 1.f, 1.f}, g1 = g0;
    if (ks) { g0 = *(const f32x4*)(ks + k0 + 8 * c8); g1 = *(const f32x4*)(ks + k0 + 8 * c8 + 4); }
#pragma unroll
    for (int i = 0; i < 16; ++i) { LAS float* s = scr + (4 * i + (lane >> 4)) * 65 + (lane & 15) * 4; s[0] = v[i][0]; s[1] = v[i][1]; s[2] = v[i][2]; s[3] = v[i][3]; }
    asm volatile("s_waitcnt lgkmcnt(0)" ::: "memory");
#pragma unroll
    for (int j = 0; j < 8; ++j) { const int rr = j * 8 + (lane >> 3), c32 = rr & 31;
        const int p32 = ((c32 >> 2) & 1) * 16 + (c32 >> 3) * 4 + (c32 & 3), drow = ((rr >> 5) ? d1 : d0) + p32;
        const LAS float* s = scr + (8 * c8) * 65 + rr;
        u32x2 o; o.x = pack4_fp8((f32x4){s[0], s[65], s[2 * 65], s[3 * 65]} * g0, F8_W); o.y = pack4_fp8((f32x4){s[4 * 65], s[5 * 65], s[6 * 65], s[7 * 65]} * g1, F8_W);
        *(u32x2*)(dst + (size_t)drow * ldk + k0 + 8 * c8) = o; }
    asm volatile("s_waitcnt lgkmcnt(0)" ::: "memory");
}
__device__ __forceinline__ int map_in(int c) {
    if (c < 2048) { const int w = c & 255; return (c & ~255) + ((w >> 5) & 1) * 128 + (w >> 6) * 32; }
    if (c < 4096) return c;
    const int ch = (c - 4096) & 1023; return (16 + (ch >> 7)) * 256 + ((ch >> 5) & 3) * 32 + (c >= 5120 ? 128 : 0);
}

__device__ __forceinline__ void prep_row(const float* x, const float* p, bf16_t* XB, float* RS0, bf16_t* PB, int row, int lane) {
    const GAS f32x4* xr = (const GAS f32x4*)(x + (size_t)row * DM) + lane;
    f32x4 v[8]; float s = 0.f;
#pragma unroll
    for (int j = 0; j < 8; ++j) v[j] = xr[64 * j];
    const f32x4 pv = *((const GAS f32x4*)(p + (size_t)row * PLE) + lane);
#pragma unroll
    for (int j = 0; j < 8; ++j) s += dot4(v[j]);
    s = wave_sum(s);
    GAS u32x2* o = (GAS u32x2*)(XB + (size_t)row * DM) + lane;
#pragma unroll
    for (int j = 0; j < 8; ++j) { u32x2 w; w.x = cvt_pk_bf16(v[j][0], v[j][1]); w.y = cvt_pk_bf16(v[j][2], v[j][3]); o[64 * j] = w; }
    if (lane == 0) RS0[row] = rsqrtf(s * (1.f / DM) + EPS);
    u32x2 w; w.x = cvt_pk_bf16(pv[0], pv[1]); w.y = cvt_pk_bf16(pv[2], pv[3]);
    *((GAS u32x2*)(PB + (size_t)row * PLE) + lane) = w;
}

__device__ __forceinline__ void p0_prologue(Frame& F, const Args& a) {
    unsigned char* ws = F.ws; const int lane = lane_id(), tid = F.wave * 64 + lane;
    const float* w_in = a.in[4]; const float* g_mix = a.in[3]; const float* w_o = a.in[15]; const float* g_ffn = a.in[16];
    const float* w1 = a.in[21]; const float* w3 = a.in[22]; const float* w2 = a.in[23]; const float* g_ple = a.in[24]; const float* w_gate = a.in[25]; const float* w_proj = a.in[26];
    if (blockIdx.x == 0 && tid < 256) {
        LAS float* red = (LAS float*)(F.lds + LCTL_OFF + 128);
        const float* rel_bias = a.in[2]; const int t = tid;
        float gq = 0.f, gk = 0.f, rb = fabsf(rel_bias[t]);
        if (t < 64) { gq = fabsf(a.in[5][t]); gk = fabsf(a.in[6][t]); }
        for (int o = 32; o > 0; o >>= 1) { gq = fmaxf(gq, __shfl_xor(gq, o)); gk = fmaxf(gk, __shfl_xor(gk, o)); rb = fmaxf(rb, __shfl_xor(rb, o)); }
        if ((t & 63) == 0) { red[t >> 6] = rb; if (t == 0) { red[8] = gq; red[9] = gk; } }
    }
    __syncthreads();
    if (blockIdx.x == 0 && tid < 256) {
        LAS float* red = (LAS float*)(F.lds + LCTL_OFF + 128);
        const float* rel_bias = a.in[2]; const int t = tid;
        const float rbm = fmaxf(fmaxf(red[0], red[1]), fmaxf(red[2], red[3]));
        const float m0 = 8.f * red[8] * red[9] + rbm;
        float* BT = (float*)(ws + WS_BT);
        for (int i = t; i < NH * BT_N; i += 256) { const int h = i / BT_N, idx = i % BT_N, rel = idx - 255; BT[i] = (rel_bias[rel_bucket(rel) * NH + h] - m0) * LOG2E; }
        if (t < 64) {
            float x1 = a.in[7][t] * a.in[8][t], x2 = a.in[9][t] * a.in[10][t];
            for (int o = 32; o > 0; o >>= 1) { x1 += __shfl_xor(x1, o); x2 += __shfl_xor(x2, o); }
            if (t == 0) ((float*)(ws + WS_LAM))[0] = expf(x1) - expf(x2) + LAM_INIT;
        }
    }
    __syncthreads();
    const int gw = F.vcu * NWAVES + F.wave, NGW = F.G * NWAVES;
    for (int m = gw; m < M; m += NGW) prep_row(a.in[0], a.in[1], (bf16_t*)(ws + WS_A), (float*)(ws + WS_RS0), (bf16_t*)(ws + WS_PB), m, lane);
    { const float* w_group = a.in[17]; const float* w_expert = a.in[19]; bf16_t* WR = (bf16_t*)(ws + WS_WR);
      for (int i = (F.vcu * NWAVES + F.wave) * 64 + lane; i < 256 * (DM / 8); i += F.G * NTHR) { const int pr = i / (DM / 8), k8 = (i % (DM / 8)) * 8;
          float v[8];
#pragma unroll
          for (int q = 0; q < 8; ++q) { const int k = k8 + q; v[q] = pr < 4 ? g_ffn[k] * w_group[k * 4 + pr] : pr < 36 ? g_ffn[k] * w_expert[k * 32 + pr - 4] : 0.f; }
          u32x4 o; o.x = cvt_pk_bf16(v[0], v[1]); o.y = cvt_pk_bf16(v[2], v[3]); o.z = cvt_pk_bf16(v[4], v[5]); o.w = cvt_pk_bf16(v[6], v[7]);
          *(u32x4*)(WR + (size_t)pr * DM + k8) = o; } }
    LAS float* scr = (LAS float*)(F.lds + F.wave * 16640);
    constexpr int I_IN = 32 * 96, I_O = 32 * 32, I_G = 32 * 32, I_P = 4 * 32, I_UP = 32 * 512, I_DN = 32 * 256;
    constexpr int NITEMS = I_IN + I_O + I_G + I_P + I_UP + I_DN;
    for (int it = gw; it < NITEMS; it += NGW) {
        int r = it;
        if (r < I_IN) { const int kb = r / 96, cb = r % 96, c0 = cb * 64; tr_item(w_in, 6144, g_mix, kb * 64, c0, (bf16_t*)(ws + WS_WIN), DM, map_in(c0), map_in(c0 + 32), scr, lane); continue; } r -= I_IN;
        if (r < I_O) { const int kb = r / 32, c0 = (r % 32) * 64; tr_item(w_o, DM, nullptr, kb * 64, c0, (bf16_t*)(ws + WS_WO), DM, c0, c0 + 32, scr, lane); continue; } r -= I_O;
        if (r < I_G) { const int kb = r / 32, c0 = (r % 32) * 64; tr_item8(w_gate, DM, g_ple, kb * 64, c0, ws + WS_WG, DM, c0, c0 + 32, scr, lane); continue; } r -= I_G;
        if (r < I_P) { const int kb = r / 32, c0 = (r % 32) * 64; tr_item(w_proj, DM, nullptr, kb * 64, c0, (bf16_t*)(ws + WS_WP), PLE, c0, c0 + 32, scr, lane); continue; } r -= I_P;
        if (r < I_UP) { const int e = r / 512, q = r % 512, which = q / 256, q2 = q % 256, kb = q2 / 8, c0 = (q2 % 8) * 64;
            const float* src = (which ? w3 : w1) + (size_t)e * DM * DFF;
            const int d0 = (c0 >> 7) * 256 + ((c0 >> 5) & 3) * 32 + which * 128, d1 = ((c0 + 32) >> 7) * 256 + (((c0 + 32) >> 5) & 3) * 32 + which * 128;
            tr_item8(src, DFF, g_ffn, kb * 64, c0, ws + WS_WUP + (size_t)e * 1024 * DM, DM, d0, d1, scr, lane); continue; } r -= I_UP;
        { const int e = r / 256, q = r % 256, kb = q / 32, c0 = (q % 32) * 64;
            tr_item8(w2 + (size_t)e * DFF * DM, DM, nullptr, kb * 64, c0, ws + WS_WDN + (size_t)e * DM * DFF, DFF, c0, c0 + 32, scr, lane); }
    }
}


namespace att {
typedef short v4i16_t __attribute__((ext_vector_type(4)));
constexpr int SLOT = 32768, STG_STRIDE = 132, STG_BYTES = 32 * STG_STRIDE * 4;
static_assert(4 * SLOT <= RING_BYTES && 8 * STG_BYTES <= LCTL_OFF, "attention LDS");
__device__ __forceinline__ void glds16(const void* gsrc, unsigned lds_dst) { unsigned keep;
    asm volatile("s_mov_b32 %0, m0\n\ts_mov_b32 m0, %2\n\ts_nop 0\n\tglobal_load_lds_dwordx4 %1, off\n\ts_mov_b32 m0, %0" : "=&s"(keep) : "v"(gsrc), "s"(lds_dst) : "memory"); }
__device__ __forceinline__ v4i16_t vtr(const LAS unsigned char* p) { return __builtin_amdgcn_ds_read_tr16_b64_v4i16((LAS v4i16_t*)p); }
__device__ __forceinline__ int crow(int r, int hi) { return (r & 3) + 8 * (r >> 2) + 4 * hi; }

__device__ __forceinline__ void attn_unit(int b, int h, int qb, const bf16_t* Q, const bf16_t* K, const bf16_t* V, bf16_t* AO, const float* g_subln, float lam, LAS unsigned char* lds, int wid) {
    const int lane = lane_id(), r32 = lane & 31, hi = lane >> 5;
    const int pair = wid >> 1, comp = wid & 1;
    const long rowbase = (long)b * SEQ; const int q0 = qb * 128, myrow0 = q0 + pair * 32;
    const int cw = myrow0 >> 6;
    const int NT = (q0 >> 6) + 2;
    const LAS float* bt = (const LAS float*)(lds + LBT_OFF);
    const float ffar = __builtin_amdgcn_exp2f(bt[0]);
    const bf16_t* ksrc = K + (size_t)(rowbase + 8 * wid + (lane >> 3)) * 1024 + h * 128 + (((lane & 7) ^ (((8 * wid + (lane >> 3)) >> 1) & 7)) * 8);
    const bf16_t* vsrc = V + (size_t)(rowbase + 16 * (wid & 3) + (lane >> 2)) * 1024 + h * 128 + (wid >> 2) * 32 + (lane & 3) * 8;
    const unsigned lds0 = (unsigned)(size_t)lds;
    const unsigned kdst = lds0 + wid * 1024, vdst = lds0 + 16384 + (wid >> 2) * 4096 + (wid & 3) * 1024;
#define ATT_DMA(t, sl) do { const size_t go_ = (size_t)(t) * 65536; const unsigned so_ = (unsigned)(sl); \
        glds16(ksrc + go_, (unsigned)__builtin_amdgcn_readfirstlane(kdst + so_)); glds16(ksrc + go_ + 64, (unsigned)__builtin_amdgcn_readfirstlane(kdst + so_ + 8192)); \
        glds16(vsrc + go_, (unsigned)__builtin_amdgcn_readfirstlane(vdst + so_)); glds16(vsrc + go_ + 64, (unsigned)__builtin_amdgcn_readfirstlane(vdst + so_ + 8192)); } while (0)
    f32x16 o[4];
#pragma unroll
    for (int d = 0; d < 4; ++d)
#pragma unroll
        for (int r = 0; r < 16; ++r) o[d][r] = 0.f;
    float l = 0.f;
    ATT_DMA(0, 0); ATT_DMA(1, SLOT);
    bf16x8 qr[4];
#pragma unroll
    for (int d0 = 0; d0 < 4; ++d0) qr[d0] = *(const bf16x8*)(Q + (size_t)(rowbase + myrow0 + r32) * 1024 + h * 128 + comp * 64 + d0 * 16 + hi * 8);
    asm volatile("" :: "v"(qr[0]), "v"(qr[1]), "v"(qr[2]), "v"(qr[3]));
    int sl_cur = 0, sl_prev = 3 * SLOT, sl_nn = 2 * SLOT;
    int kofs[4];
#pragma unroll
    for (int d0 = 0; d0 < 4; ++d0) kofs[d0] = comp * 8192 + r32 * 128 + (((2 * d0 + hi) ^ ((r32 >> 1) & 7)) * 16);
    const int vofs = 16384 + ((lane >> 4) & 1) * 32 + (lane & 3) * 8 + (4 * hi + ((lane & 15) >> 2)) * 64;
    const bool grpY = wid >= 4;
    u32x4 pw[4];
#define ATT_SGB(mask, n) __builtin_amdgcn_sched_group_barrier(mask, n, 0)
    f32x16 p1;
#define ATT_QKEXP(t, slot) do { const LAS unsigned char* sb = lds + (slot); f32x16 p0; \
        bf16x8 kf[4][2]; \
        _Pragma("unroll") for (int d0 = 0; d0 < 4; ++d0) { kf[d0][0] = *(const LAS bf16x8*)(sb + kofs[d0]); kf[d0][1] = *(const LAS bf16x8*)(sb + kofs[d0] + 4096); } \
        if ((t) == cw - 2 && (t) > 0) l *= ffar; \
        if ((t) >= cw - 2) { const int base = 64 * (t) + 4 * hi - (myrow0 + r32) + 255; \
            _Pragma("unroll") for (int r = 0; r < 16; ++r) { p0[r] = bt[base + (r & 3) + 8 * (r >> 2)]; p1[r] = bt[base + 32 + (r & 3) + 8 * (r >> 2)]; } \
            _Pragma("unroll") for (int d0 = 0; d0 < 4; ++d0) { \
                p0 = __builtin_amdgcn_mfma_f32_32x32x16_bf16(kf[d0][0], qr[d0], p0, 0, 0, 0); p1 = __builtin_amdgcn_mfma_f32_32x32x16_bf16(kf[d0][1], qr[d0], p1, 0, 0, 0); } } \
        else { const f32x16 z16 = {0.f, 0.f, 0.f, 0.f, 0.f, 0.f, 0.f, 0.f, 0.f, 0.f, 0.f, 0.f, 0.f, 0.f, 0.f, 0.f};     \
            p0 = __builtin_amdgcn_mfma_f32_32x32x16_bf16(kf[0][0], qr[0], z16, 0, 0, 0); p1 = __builtin_amdgcn_mfma_f32_32x32x16_bf16(kf[0][1], qr[0], z16, 0, 0, 0); \
            _Pragma("unroll") for (int d0 = 1; d0 < 4; ++d0) { \
                p0 = __builtin_amdgcn_mfma_f32_32x32x16_bf16(kf[d0][0], qr[d0], p0, 0, 0, 0); p1 = __builtin_amdgcn_mfma_f32_32x32x16_bf16(kf[d0][1], qr[d0], p1, 0, 0, 0); } } \
        float sacc = 0.f; \
        _Pragma("unroll") for (int r = 0; r < 16; ++r) { p0[r] = __builtin_amdgcn_exp2f(p0[r]); sacc += p0[r]; } \
        l += sacc; \
        _Pragma("unroll") for (int i = 0; i < 4; ++i) { pw[0][i] = cvt_pk_bf16(p0[2 * i], p0[2 * i + 1]); pw[1][i] = cvt_pk_bf16(p0[8 + 2 * i], p0[9 + 2 * i]); } } while (0)
#define ATT_VLD2(dst, db, k0) do { _Pragma("unroll") for (int kk = 0; kk < 2; ++kk) { \
            const v4i16_t lo = vtr(sb + vofs + (db) * 4096 + ((k0) + kk) * 1024), hh = vtr(sb + vofs + (db) * 4096 + ((k0) + kk) * 1024 + 512); \
            dst[(db) * 2 + kk] = (bf16x8){lo[0], lo[1], lo[2], lo[3], hh[0], hh[1], hh[2], hh[3]}; } } while (0)
#define ATT_PV(t, slot) do { const LAS unsigned char* sb = lds + (slot); bf16x8 h1[8], h2[8]; \
        if ((t) == cw - 2 && (t) > 0) { _Pragma("unroll") for (int db = 0; db < 4; ++db) o[db] = o[db] * ffar; } \
        _Pragma("unroll") for (int db = 0; db < 4; ++db) ATT_VLD2(h1, db, 0); \
        _Pragma("unroll") for (int db = 0; db < 4; ++db) ATT_VLD2(h2, db, 2); \
        _Pragma("unroll") for (int db = 0; db < 4; ++db) { o[db] = __builtin_amdgcn_mfma_f32_32x32x16_bf16(__builtin_bit_cast(bf16x8, pw[0]), h1[db * 2], o[db], 0, 0, 0); \
                                                         o[db] = __builtin_amdgcn_mfma_f32_32x32x16_bf16(__builtin_bit_cast(bf16x8, pw[1]), h1[db * 2 + 1], o[db], 0, 0, 0); } \
        float sacc = 0.f; \
        _Pragma("unroll") for (int r = 0; r < 16; ++r) { p1[r] = __builtin_amdgcn_exp2f(p1[r]); sacc += p1[r]; } \
        l += sacc; \
        _Pragma("unroll") for (int i = 0; i < 4; ++i) { pw[2][i] = cvt_pk_bf16(p1[2 * i], p1[2 * i + 1]); pw[3][i] = cvt_pk_bf16(p1[8 + 2 * i], p1[9 + 2 * i]); } \
        _Pragma("unroll") for (int db = 0; db < 4; ++db) { o[db] = __builtin_amdgcn_mfma_f32_32x32x16_bf16(__builtin_bit_cast(bf16x8, pw[2]), h2[db * 2], o[db], 0, 0, 0); \
                                                         o[db] = __builtin_amdgcn_mfma_f32_32x32x16_bf16(__builtin_bit_cast(bf16x8, pw[3]), h2[db * 2 + 1], o[db], 0, 0, 0); } } while (0)
#define ATT_WAIT_A(s_) do { if ((s_) + 1 < NT) asm volatile("s_waitcnt vmcnt(4) lgkmcnt(0)\n\ts_barrier" ::: "memory"); else asm volatile("s_waitcnt vmcnt(0) lgkmcnt(0)\n\ts_barrier" ::: "memory"); } while (0)
#define ATT_BAR_B() asm volatile("s_waitcnt lgkmcnt(0)\n\ts_barrier" ::: "memory")
    asm volatile(".p2align 8" ::: "memory");
    if (!grpY) {
        for (int s = 0; s <= NT; ++s) {
            ATT_WAIT_A(s);
            if (s < NT && s <= cw) ATT_QKEXP(s, sl_cur);
            ATT_BAR_B();
            if (s + 2 < NT) ATT_DMA(s + 2, sl_nn);
            if (s < NT && s <= cw) ATT_PV(s, sl_cur);
            sl_prev = sl_cur; sl_cur = (sl_cur == 3 * SLOT) ? 0 : sl_cur + SLOT; sl_nn = (sl_nn == 3 * SLOT) ? 0 : sl_nn + SLOT;
        }
    } else {
        for (int s = 0; s <= NT; ++s) {
            ATT_WAIT_A(s);
            if (s >= 1 && s - 1 <= cw) ATT_PV(s - 1, sl_prev);
            ATT_BAR_B();
            if (s + 2 < NT) ATT_DMA(s + 2, sl_nn);
            if (s < NT && s <= cw) ATT_QKEXP(s, sl_cur);
            sl_prev = sl_cur; sl_cur = (sl_cur == 3 * SLOT) ? 0 : sl_cur + SLOT; sl_nn = (sl_nn == 3 * SLOT) ? 0 : sl_nn + SLOT;
        }
    }
#undef ATT_WAIT_A
#undef ATT_BAR_B
#undef ATT_QKEXP
#undef ATT_PV
#undef ATT_VLD2
#undef ATT_SGB
#undef ATT_DMA
    l += __shfl_xor(l, 32);
    asm volatile("s_waitcnt vmcnt(0) lgkmcnt(0)\n\ts_barrier" ::: "memory");
    {   LAS float* st = (LAS float*)(lds + wid * STG_BYTES);
#pragma unroll
        for (int db = 0; db < 4; ++db)
#pragma unroll
            for (int r = 0; r < 16; ++r) st[crow(r, hi) * STG_STRIDE + db * 32 + r32] = o[db][r];
        if (hi == 0) ((LAS float*)(lds + LLS_OFF))[wid * 32 + r32] = l;
    }
    asm volatile("s_waitcnt lgkmcnt(0)\n\ts_barrier" ::: "memory");
    {   const int rsel = comp * 16 + (lane >> 2), quarter = lane & 3;
        const LAS float* s1 = (const LAS float*)(lds + (pair * 2) * STG_BYTES) + rsel * STG_STRIDE + quarter * 32;
        const LAS float* s2 = (const LAS float*)(lds + (pair * 2 + 1) * STG_BYTES) + rsel * STG_STRIDE + quarter * 32;
        const LAS float* ls = (const LAS float*)(lds + LLS_OFF);
        const float i1 = 1.f / ls[(pair * 2) * 32 + rsel], i2 = lam / ls[(pair * 2 + 1) * 32 + rsel];
        f32x4 v[8]; float ss = 0.f;
#pragma unroll
        for (int c = 0; c < 8; ++c) { v[c] = *(const LAS f32x4*)(s1 + c * 4) * i1 - *(const LAS f32x4*)(s2 + c * 4) * i2; ss += dot4(v[c]); }
        ss += __shfl_xor(ss, 1); ss += __shfl_xor(ss, 2);
        const float rstd = rsqrtf(ss * (1.f / 128.f) + EPS) * (1.f - LAM_INIT);
        bf16_t* op = AO + (size_t)(rowbase + myrow0 + rsel - comp * 16 + comp * 16) * DM + h * 128 + quarter * 32;
#pragma unroll
        for (int c = 0; c < 4; ++c) { const f32x4 g0 = *(const f32x4*)(g_subln + quarter * 32 + c * 8), g1 = *(const f32x4*)(g_subln + quarter * 32 + c * 8 + 4);
            *(u32x4*)(op + c * 8) = pack8(v[2 * c] * rstd * g0, v[2 * c + 1] * rstd * g1); }
    }
    asm volatile("s_waitcnt lgkmcnt(0)\n\ts_barrier" ::: "memory");
}
}

__device__ __forceinline__ void p2_conv(Frame& F, const Args& a) {
    unsigned char* ws = F.ws; const int lane = lane_id(), c0 = lane * 16;
    const bf16_t* CU = (const bf16_t*)(ws + WS_D); const bf16_t* GB = (const bf16_t*)(ws + WS_C) + (size_t)M * 1024; bf16_t* AO = (bf16_t*)(ws + WS_AO);
    const float* conv_w = a.in[12]; const float* conv_b = a.in[13]; const float* g_conv = a.in[14];
    f32x4 w0[4], w1[4], w2[4], cb[4], gc[4];
#pragma unroll
    for (int i = 0; i < 4; ++i) { w0[i] = *(const f32x4*)(conv_w + c0 + i * 4); w1[i] = *(const f32x4*)(conv_w + 1024 + c0 + i * 4); w2[i] = *(const f32x4*)(conv_w + 2048 + c0 + i * 4);
        cb[i] = *(const f32x4*)(conv_b + c0 + i * 4); gc[i] = *(const f32x4*)(g_conv + c0 + i * 4); }
    const int gw = F.vcu * NWAVES + F.wave, NGW = F.G * NWAVES;
    for (int row = gw; row < M; row += NGW) {
        const int s = row & (SEQ - 1);
        const u32x4 zz = (u32x4){0u, 0u, 0u, 0u};
        u32x4 x0[2], x1[2], x2[2], gb[2];
#pragma unroll
        for (int i = 0; i < 2; ++i) { x0[i] = *(const u32x4*)(CU + (size_t)row * 1024 + c0 + i * 8); gb[i] = *(const u32x4*)(GB + (size_t)row * 1024 + c0 + i * 8);
            x1[i] = s >= 1 ? *(const u32x4*)(CU + (size_t)(row - 1) * 1024 + c0 + i * 8) : zz; x2[i] = s >= 2 ? *(const u32x4*)(CU + (size_t)(row - 2) * 1024 + c0 + i * 8) : zz; }
        f32x4 z[4]; float ss = 0.f;
#pragma unroll
        for (int i = 0; i < 4; ++i) { const int q = i >> 1;
            const f32x4 a0 = (i & 1) ? g8::bf4lo(x0[q].z, x0[q].w) : g8::bf4lo(x0[q].x, x0[q].y), a1 = (i & 1) ? g8::bf4lo(x1[q].z, x1[q].w) : g8::bf4lo(x1[q].x, x1[q].y);
            const f32x4 a2 = (i & 1) ? g8::bf4lo(x2[q].z, x2[q].w) : g8::bf4lo(x2[q].x, x2[q].y), g = (i & 1) ? g8::bf4lo(gb[q].z, gb[q].w) : g8::bf4lo(gb[q].x, gb[q].y);
            z[i] = g * (w2[i] * a0 + w1[i] * a1 + w0[i] * a2 + cb[i]); ss += dot4(z[i]); }
        ss += __shfl_xor(ss, 1); ss += __shfl_xor(ss, 2); ss += __shfl_xor(ss, 4);
        const float r = rsqrtf(ss * (1.f / 128.f) + EPS);
        *(u32x4*)(AO + (size_t)row * DM + 1024 + c0) = pack8(z[0] * r * gc[0], z[1] * r * gc[1]);
        *(u32x4*)(AO + (size_t)row * DM + 1024 + c0 + 8) = pack8(z[2] * r * gc[2], z[3] * r * gc[3]);
    }
}
__device__ __forceinline__ void p2_attention(Frame& F, const Args& a) {
    unsigned char* ws = F.ws; const int tid = F.wave * 64 + lane_id();
    const bf16_t* Qb = (const bf16_t*)(ws + WS_B); const bf16_t* Kb = Qb + (size_t)M * 1024; const bf16_t* Vb = (const bf16_t*)(ws + WS_C); bf16_t* AO = (bf16_t*)(ws + WS_AO);
    const int bh = F.vcu >> 3, j = F.vcu & 7, b = bh >> 3, h = bh & 7;
    if (bh >= BATCH * NH) return;
    const float lam = ((const float*)(ws + WS_LAM))[0];
    { LAS float* bt = (LAS float*)(F.lds + LBT_OFF); const float* BT = (const float*)(ws + WS_BT) + h * BT_N; if (tid < BT_N) bt[tid] = BT[tid]; }
    asm volatile("s_waitcnt vmcnt(0) lgkmcnt(0)\n\ts_barrier" ::: "memory");
    for (int i = 0; i < 4; ++i) { const int qb = (i == 0) ? 31 - j : (i == 1) ? 16 + j : (i == 2) ? 15 - j : j;
        att::attn_unit(b, h, qb, Qb, Kb, Vb, AO, a.in[11], lam, F.lds, F.wave); }
}

__device__ __forceinline__ void p5_route(Frame& F, const Args& a) {
    unsigned char* ws = F.ws; const int lane = lane_id();
    const float* PART = (const float*)(ws + WS_PART); const float* SSQ = (const float*)(ws + WS_SSQ);
    const float* b_group = a.in[18]; const float* b_expert = a.in[20];
    float* RS1 = (float*)(ws + WS_RS1); int* TE = (int*)(ws + WS_TE); float* TW = (float*)(ws + WS_TW); unsigned* CNT = (unsigned*)(ws + WS_CNT); int* LIST = (int*)(ws + WS_LIST);
    for (int row = (F.vcu * NWAVES + F.wave) * 64 + lane; row < M; row += F.G * NTHR) {
        float ss = 0.f;
#pragma unroll
        for (int i = 0; i < 8; ++i) { const f32x4 v = *(const f32x4*)(SSQ + (size_t)row * 32 + i * 4); ss += (v[0] + v[1]) + (v[2] + v[3]); }
        const float rs = rsqrtf(ss * (1.f / DM) + EPS);
        f32x4 gl = (f32x4){0.f, 0.f, 0.f, 0.f};
#pragma unroll
        for (int ks = 0; ks < 4; ++ks) gl = gl + *(const f32x4*)(PART + ((size_t)ks * M + row) * 64);
        int gi = 0; float gm = -1e30f; float glv[4];
#pragma unroll
        for (int g = 0; g < 4; ++g) { glv[g] = gl[g] * rs + b_group[g]; if (glv[g] > gm) { gm = glv[g]; gi = g; } }
        float den = 0.f;
#pragma unroll
        for (int g = 0; g < 4; ++g) den += expf(glv[g] - gm);
        const float pg = 1.f / den;
        f32x4 e0 = (f32x4){0.f, 0.f, 0.f, 0.f}, e1 = e0;
#pragma unroll
        for (int ks = 0; ks < 4; ++ks) { const float* pp = PART + ((size_t)ks * M + row) * 64 + 4 + gi * 8; e0 = e0 + *(const f32x4*)pp; e1 = e1 + *(const f32x4*)(pp + 4); }
        float v0 = -1e30f, v1 = -1e30f; int i0 = 0, i1 = 0;
#pragma unroll
        for (int e = 0; e < 8; ++e) { const float v = (e < 4 ? e0[e & 3] : e1[e & 3]) * rs + b_expert[gi * 8 + e];
            if (v > v0) { v1 = v0; i1 = i0; v0 = v; i0 = e; } else if (v > v1) { v1 = v; i1 = e; } }
        const float ex = expf(v1 - v0), w0 = pg / (1.f + ex), w1 = pg * ex / (1.f + ex);
        const int x0 = gi * 8 + i0, x1 = gi * 8 + i1;
        RS1[row] = rs; TE[row * 2] = x0; TE[row * 2 + 1] = x1; TW[row * 2] = w0; TW[row * 2 + 1] = w1;
        float* LRS = (float*)(ws + WS_LRS); float* LTW = (float*)(ws + WS_LTW);
        const unsigned p0 = atomicAdd(&CNT[x0], 1u); LIST[(size_t)x0 * M + p0] = row * 2; LRS[(size_t)x0 * M + p0] = rs; LTW[(size_t)x0 * M + p0] = w0;
        const unsigned p1 = atomicAdd(&CNT[x1], 1u); LIST[(size_t)x1 * M + p1] = row * 2 + 1; LRS[(size_t)x1 * M + p1] = rs; LTW[(size_t)x1 * M + p1] = w1;
    }
}
__device__ __forceinline__ g8::MoeTab moe_tables(Frame& F) {
    LAS int* tab = (LAS int*)(F.lds + LTAB_OFF); const int tid = F.wave * 64 + lane_id();
    const unsigned* CNT = (const unsigned*)(F.ws + WS_CNT);
    __syncthreads();
    if (tid < 32) tab[384 + tid] = (int)__hip_atomic_load(CNT + tid, __ATOMIC_RELAXED, __HIP_MEMORY_SCOPE_AGENT);
    __syncthreads();
    if (tid == 0) { int nt = 0;
        for (int e = 0; e < NE; ++e) { const int n = tab[384 + e]; for (int r = 0; r < n && nt < 192; r += 256) { tab[nt] = e; tab[192 + nt] = r; ++nt; } }
        tab[416] = nt; }
    __syncthreads();
    g8::MoeTab T; T.texp = tab; T.trow0 = tab + 192; T.tcnt = tab + 384; T.ntile = tab[416];
    return T;
}
__device__ __forceinline__ void p7_combine(Frame& F) {
    unsigned char* ws = F.ws;
    bf16_t* H = (bf16_t*)(ws + WS_B); const bf16_t* Y0 = (const bf16_t*)(ws + WS_A); const bf16_t* Y1 = (const bf16_t*)(ws + WS_D); float* RS2 = (float*)(ws + WS_RS2); unsigned char* H28 = ws + WS_H28;
    const int gw = F.vcu * NWAVES + F.wave, NGW = F.G * NWAVES, lane = lane_id();
    for (int row = gw; row < M; row += NGW) {
        float ss = 0.f;
#pragma unroll
        for (int j = 0; j < 4; ++j) { const size_t o = (size_t)row * DM + j * 512 + lane * 8;
            const u32x4 hv = *(const u32x4*)(H + o); const u32x2 y0 = *(const u32x2*)((const unsigned char*)Y0 + o), y1 = *(const u32x2*)((const unsigned char*)Y1 + o);
            const f32x4 a = g8::bf4lo(hv.x, hv.y) + (unpack4_fp8(y0.x) + unpack4_fp8(y1.x)) * (1.f / F8_Y), b = g8::bf4lo(hv.z, hv.w) + (unpack4_fp8(y0.y) + unpack4_fp8(y1.y)) * (1.f / F8_Y);
            ss += dot4(a) + dot4(b);
            *(u32x4*)(H + o) = pack8(a, b);
            u32x2 w8; w8.x = pack4_fp8(a, F8_H); w8.y = pack4_fp8(b, F8_H); *(u32x2*)(H28 + o) = w8; }
        ss = wave_sum(ss);
        if (lane == 0) RS2[row] = rsqrtf(ss * (1.f / DM) + EPS);
    }
}

__global__ void __launch_bounds__(NTHR, 2) mk_fwd(Args args) {
    extern __shared__ __attribute__((aligned(16))) unsigned char lds_raw[];
    Frame F;
    F.lds = (LAS unsigned char*)lds_raw; F.MISC = (volatile LAS unsigned*)(F.lds + LCTL_OFF); F.ws = args.ws;
    F.wave = __builtin_amdgcn_readfirstlane(threadIdx.x >> 6);
    F.G = gridDim.x; { const int bx = blockIdx.x; F.vcu = (F.G % 8 == 0) ? (bx % 8) * (F.G / 8) + bx / 8 : bx; }
    unsigned char* ws = args.ws;
    if (threadIdx.x < 32) F.MISC[threadIdx.x] = 0u;
    __syncthreads();
    XcdBarrier bar = xcd_barrier_post((unsigned*)(ws + WS_BAR) + args.li * XCD_BAR_WORDS, F.MISC + 8);
    const int lo = args.ph_lo, hi = args.ph_hi;
#define IN(k) (lo <= (k) && (k) < hi)
#define SEAM(k) do { if (IN(k) && IN((k) + 1)) xcd_barrier(bar); } while (0)

    bf16_t* XB = (bf16_t*)(ws + WS_A); bf16_t* AO = (bf16_t*)(ws + WS_AO);
    bf16_t* Qb = (bf16_t*)(ws + WS_B); bf16_t* Kb = Qb + (size_t)M * 1024; bf16_t* H = Qb;
    bf16_t* Vb = (bf16_t*)(ws + WS_C); bf16_t* GB = Vb + (size_t)M * 1024;
    bf16_t* CU = (bf16_t*)(ws + WS_D);
    bf16_t* PP = (bf16_t*)(ws + WS_AO)  ; bf16_t* PB = (bf16_t*)(ws + WS_PB);
    float* RS0 = (float*)(ws + WS_RS0); float* RS2 = (float*)(ws + WS_RS2);

    if (IN(0)) { p0_prologue(F, args); } SEAM(0);

    if (IN(1)) {
        g8::DenseSched S; S.init(XB, DM * 2, ws + WS_WIN, DM * 2, M, 6144, F.G, (int)blockIdx.x);
        g8::EpiProj E{RS0, args.in[5], args.in[6], Qb, Kb, Vb, GB, CU};
        g8::gemm_phase<g8::EpiProj, g8::DenseSched>(F.lds, F.wave, DM, S, E);
    } SEAM(1);

    if (IN(2)) { p2_conv(F, args); p2_attention(F, args); } SEAM(2);

    if (IN(3)) {
        g8::DenseSched S; S.init(AO, DM * 2, ws + WS_WO, DM * 2, M, DM, F.G, (int)blockIdx.x);
        g8::EpiRes E{XB, H, (float*)(ws + WS_SSQ), ws + WS_H8};
        g8::gemm_phase<g8::EpiRes, g8::DenseSched>(F.lds, F.wave, DM, S, E);
    } SEAM(3);

    if (IN(4)) {
        g8::KSplitSched S{(const char*)H, (const char*)(ws + WS_WR), F.G, (int)blockIdx.x};
        g8::EpiRouter E{(float*)(ws + WS_PART)};
        g8::gemm_phase<g8::EpiRouter, g8::KSplitSched>(F.lds, F.wave, 512, S, E);
    } SEAM(4);

    if (IN(5)) { p5_route(F, args); } SEAM(5);

    if (IN(6)) {
        const g8::MoeTab T = moe_tables(F);
        g8::UpSched S{(const char*)(ws + WS_H8), (const char*)(ws + WS_WUP), (const int*)(ws + WS_LIST), T, F.G, F.vcu};
        g8::EpiUp E{(const float*)(ws + WS_LRS), Vb  , T, (const float*)(ws + WS_ZERO)};
        g8::gemm_phase<g8::EpiUp, g8::UpSched, true>(F.lds, F.wave, DM, S, E, E8_W, E8_H);
        { unsigned char* w2 = F.ws; const int nrem = (((const LAS int*)(F.lds + LTAB_OFF))[416] * 4) % F.G; const bool all = (nrem == 0) || (F.G - nrem < 96);
          g8::TailSched S2{(const char*)(w2 + WS_PB), (const char*)(w2 + WS_WP), PLE * 2, PLE * 2, (M / 256) * 8, all ? F.vcu : F.vcu - nrem, all ? F.G : F.G - nrem};
          g8::EpiBf16 E2{(bf16_t*)(w2 + WS_AO), DM};
          int kple = PLE; asm volatile("" : "+s"(kple));
          g8::gemm_phase<g8::EpiBf16, g8::TailSched>(F.lds, F.wave, kple, S2, E2); }
    } SEAM(6);

    if (IN(7)) {
        const g8::MoeTab T = moe_tables(F);
        g8::DnSched S{(const char*)Vb, (const char*)(ws + WS_WDN), T, F.G, F.vcu};
        g8::EpiDn E{(const int*)(ws + WS_LIST), (const float*)(ws + WS_LTW), XB  , CU  , T};
        int kdff = DFF; asm volatile("" : "+s"(kdff));
        g8::gemm_phase<g8::EpiDn, g8::DnSched, true>(F.lds, F.wave, kdff, S, E, E8_W, E8_HID);
    } SEAM(7);

    if (IN(8)) { p7_combine(F); } SEAM(8);

    if (IN(9)) {
        g8::DenseSched S; S.init(ws + WS_H28, DM, ws + WS_WG, DM, M, DM, F.G, (int)blockIdx.x);
        g8::EpiFinal E{H, PP, RS2, args.out};
        g8::gemm_phase<g8::EpiFinal, g8::DenseSched, true>(F.lds, F.wave, DM, S, E, E8_W, E8_H);
    }
#undef IN
#undef SEAM
}


static int mk_grid = 0;
static void launch_mk(Args a, int lo, int hi, int li, hipStream_t stream) {
    a.ph_lo = lo; a.ph_hi = hi; a.li = li; a.pad = 0;
    hipLaunchKernelGGL(mk_fwd, dim3(mk_grid), dim3(NTHR), LDS_BYTES, stream, a);
}

extern "C" void kernel_launch(void* const* d_in, const int* in_sizes, int n_in, void* d_out, int out_size, void* d_ws, size_t ws_size, hipStream_t stream) {
    if (n_in != 27 || ws_size < WS_END) { fprintf(stderr, "kernel_launch: unexpected n_in %d / ws %zu\n", n_in, ws_size); return; }
    if (mk_grid == 0) {
        int dev = 0, cus = 0;
        (void)hipGetDevice(&dev); (void)hipDeviceGetAttribute(&cus, hipDeviceAttributeMultiprocessorCount, dev);
        (void)hipFuncSetAttribute((const void*)mk_fwd, hipFuncAttributeMaxDynamicSharedMemorySize, LDS_BYTES);
        int per_cu = 0; (void)hipOccupancyMaxActiveBlocksPerMultiprocessor(&per_cu, (const void*)mk_fwd, NTHR, LDS_BYTES); (void)hipGetLastError();
        mk_grid = 256;
        if (cus != 256 || per_cu < 1) fprintf(stderr, "kernel_launch: note: %d CUs, occupancy query %d; built for 256 CUs x 1 workgroup\n", cus, per_cu);
    }
    float* out = (float*)d_out; unsigned char* ws = (unsigned char*)d_ws;
    (void)in_sizes; (void)out_size;
    (void)hipMemsetAsync(ws + WS_CTL, 0, 1 * MiB, stream);
    Args a{};
    for (int i = 0; i < 27; ++i) a.in[i] = (const float*)d_in[i];
    a.out = out; a.ws = ws;
    launch_mk(a, 0, 10, 0, stream);
}
```

```cpp
#include <hip/hip_runtime.h>
#include <cstdint>
#include <cstdio>

typedef unsigned short bf16_t;
typedef float f32x4 __attribute__((ext_vector_type(4)));

constexpr int BATCH = 4, SEQ = 4096, DM = 2048, M = BATCH * SEQ;
constexpr int NH = 8, DQK = 64, DV = 128, DATT = 1024, DCONV = 1024;
constexpr int NE = 32, NG = 4, EPG = 8, DFF = 512, PLE = 256;
constexpr float EPS = 1e-6f;
constexpr float LOG2E = 1.4426950408889634f;
constexpr float LAM_INIT = 0.2f;
constexpr int BT_N = 320;

constexpr size_t MiB = 1u << 20;
constexpr size_t WS_CTL = 0;
constexpr size_t WS_BT = 64 * 1024;
constexpr size_t WS_LAM = WS_BT + 16 * 1024;
constexpr size_t WS_CNT = 128 * 1024;
constexpr size_t WS_W = 1 * MiB;
constexpr size_t WS_A = 236 * MiB;
constexpr size_t WS_B = 300 * MiB;
constexpr size_t WS_C = 364 * MiB;
constexpr size_t WS_D = 428 * MiB;
constexpr size_t WS_E = 492 * MiB;
constexpr size_t WS_PB = 556 * MiB;
constexpr size_t WS_SM = 564 * MiB;
constexpr size_t WS_RS0 = WS_SM, WS_RS1 = WS_SM + 64 * 1024, WS_RS2 = WS_SM + 128 * 1024;
constexpr size_t WS_TE = WS_SM + 192 * 1024;
constexpr size_t WS_TW = WS_SM + 320 * 1024;
constexpr size_t WS_LIST = WS_SM + 1 * MiB;
constexpr size_t WS_END = 576 * MiB;

__device__ __forceinline__ float bf2f(bf16_t v) { return __uint_as_float((unsigned)v << 16); }
__device__ __forceinline__ bf16_t f2bf(float f) { unsigned u = __float_as_uint(f); return (bf16_t)((u + 0x7fffu + ((u >> 16) & 1u)) >> 16); }

__device__ __forceinline__ int rel_bucket(int rel) {
    int ret = rel > 0 ? 16 : 0; int n = rel < 0 ? -rel : rel;
    if (n < 8) return ret + n;
    int l = 31 - __clz(n * n) + 2; if (l > 15) l = 15;
    return ret + l;
}

__device__ __forceinline__ float block_sum(float v, float* red) {
    for (int o = 32; o > 0; o >>= 1) v += __shfl_xor(v, o);
    const int w = threadIdx.x >> 6, nw = blockDim.x >> 6;
    __syncthreads();
    if ((threadIdx.x & 63) == 0) red[w] = v;
    __syncthreads();
    float s = 0.f; for (int i = 0; i < nw; ++i) s += red[i];
    return s;
}


#define GAS __attribute__((address_space(1)))
#define LAS __attribute__((address_space(3)))
typedef short bf16x8 __attribute__((ext_vector_type(8)));
typedef unsigned u32x4 __attribute__((ext_vector_type(4)));
typedef unsigned u32x2 __attribute__((ext_vector_type(2)));
typedef float f32x16 __attribute__((ext_vector_type(16)));
typedef GAS unsigned gu32;
#define RLX_AGENT __ATOMIC_RELAXED, __HIP_MEMORY_SCOPE_AGENT

constexpr int NWAVES = 8, NTHR = 512;
constexpr int RING_BYTES = 131072;
constexpr int LCTL_OFF = 145408;
constexpr int LBT_OFF = LCTL_OFF + 128;
constexpr int LLS_OFF = LBT_OFF + 1280;
constexpr int LTAB_OFF = LCTL_OFF + 128;
constexpr int LDS_BYTES = 149504;
static_assert(LLS_OFF + 1024 <= LDS_BYTES && LTAB_OFF + (192 + 192 + 32) * 4 <= LDS_BYTES, "LDS map");

constexpr size_t WS_ZERO = 512 * 1024;
constexpr size_t WS_BAR = 256 * 1024;
constexpr size_t WS_WIN = WS_W;
constexpr size_t WS_WO = WS_WIN + 24 * MiB;
constexpr size_t WS_WG = WS_WO + 8 * MiB;
constexpr size_t WS_WP = WS_WG + 8 * MiB;
constexpr size_t WS_WUP = WS_WP + 1 * MiB;
constexpr size_t WS_WDN = WS_WUP + 128 * MiB;
constexpr size_t WS_WR = WS_WDN + 64 * MiB;
constexpr size_t WS_AO = WS_WUP + 64 * MiB;
static_assert(WS_WR + 1 * MiB <= WS_A, "weight region");
constexpr size_t WS_LRS = WS_SM + 6 * MiB, WS_LTW = WS_SM + 8 * MiB;
constexpr size_t WS_SSQ = WS_SM + 4 * MiB;
constexpr size_t WS_H8 = WS_E + 32 * MiB;
constexpr size_t WS_H28 = WS_C + 32 * MiB;
constexpr size_t WS_PART = WS_E;

__device__ __forceinline__ int lane_id() { return (int)__builtin_amdgcn_mbcnt_hi(~0u, __builtin_amdgcn_mbcnt_lo(~0u, 0u)); }
__device__ __forceinline__ int lane_id_fresh() { unsigned z = 0u; asm volatile("" : "+v"(z)); return (int)__builtin_amdgcn_mbcnt_hi(~0u, __builtin_amdgcn_mbcnt_lo(~0u, z)); }
typedef float f32x2_t __attribute__((ext_vector_type(2))); typedef __bf16 bf16x2_t __attribute__((ext_vector_type(2)));
__device__ __forceinline__ unsigned cvt_pk_bf16(float lo, float hi) { const f32x2_t v = {lo, hi}; const bf16x2_t b = __builtin_convertvector(v, bf16x2_t); return __builtin_bit_cast(unsigned, b); }
typedef int v8i_t __attribute__((ext_vector_type(8)));
typedef int v4i_t __attribute__((ext_vector_type(4)));
__device__ __forceinline__ unsigned pack4_fp8(f32x4 v, float sc) {
    int w = 0;
    const float a = __builtin_amdgcn_fmed3f(v[0] * sc, -448.f, 448.f), b = __builtin_amdgcn_fmed3f(v[1] * sc, -448.f, 448.f);
    const float c = __builtin_amdgcn_fmed3f(v[2] * sc, -448.f, 448.f), d = __builtin_amdgcn_fmed3f(v[3] * sc, -448.f, 448.f);
    w = __builtin_amdgcn_cvt_pk_fp8_f32(a, b, w, false); w = __builtin_amdgcn_cvt_pk_fp8_f32(c, d, w, true);
    return (unsigned)w;
}
__device__ __forceinline__ f32x4 unpack4_fp8(unsigned w) { const int iw = (int)w;
    return (f32x4){__builtin_amdgcn_cvt_f32_fp8(iw, 0), __builtin_amdgcn_cvt_f32_fp8(iw, 1), __builtin_amdgcn_cvt_f32_fp8(iw, 2), __builtin_amdgcn_cvt_f32_fp8(iw, 3)}; }
constexpr float F8_W = 256.f, F8_H = 16.f, F8_HID = 8.f, F8_Y = 32.f;
constexpr int E8_W = 0x77777777, E8_H = 0x7b7b7b7b, E8_HID = 0x7c7c7c7c;
__device__ __forceinline__ float fast_sigmoid(float z) { return __builtin_amdgcn_rcpf(1.f + __builtin_amdgcn_exp2f(-LOG2E * z)); }

__device__ __forceinline__ u32x4 pack8(f32x4 a, f32x4 b) { u32x4 w; w.x = cvt_pk_bf16(a[0], a[1]); w.y = cvt_pk_bf16(a[2], a[3]); w.z = cvt_pk_bf16(b[0], b[1]); w.w = cvt_pk_bf16(b[2], b[3]); return w; }
__device__ __forceinline__ float dot4(f32x4 a) { return (a[0] * a[0] + a[1] * a[1]) + (a[2] * a[2] + a[3] * a[3]); }

#define XB_TMO      128
#define XB_XCNT(j)  (256  + 64 * (j))
#define XB_XSUB(j)  (1280 + 64 * (j))
#define XB_XGEN(j)  (2304 + 64 * (j))
#define XB_TOP      3328
#define XB_TOPGEN   3392
#define XCD_BAR_WORDS 3456
#define XB_SPIN_CAP (1u << 18)
__device__ __forceinline__ unsigned xb_ld(unsigned* p)              { return __hip_atomic_load(p, __ATOMIC_RELAXED, __HIP_MEMORY_SCOPE_AGENT); }
__device__ __forceinline__ unsigned xb_add(unsigned* p, unsigned v) { return __hip_atomic_fetch_add(p, v, __ATOMIC_RELAXED, __HIP_MEMORY_SCOPE_AGENT); }
__device__ __forceinline__ unsigned xb_xcc_id() { return (unsigned)__builtin_amdgcn_s_getreg((3 << 11) | 20) & 0xFu; }
#define XB_SPIN(cond, bar) do { unsigned _sp = 0; while (cond) { __builtin_amdgcn_s_sleep(1); \
    if ((++_sp & 255u) == 0u) { if (xb_ld(&(bar)[XB_TMO])) break; if (_sp > XB_SPIN_CAP) { atomicAdd(&(bar)[XB_TMO], 1u); break; } } } } while (0)
struct XcdBarrier { unsigned* bar; unsigned x; volatile LAS unsigned* st; };
__device__ __forceinline__ XcdBarrier xcd_barrier_post(unsigned* bar, volatile LAS unsigned* st) {
    XcdBarrier b; b.bar = bar; b.x = xb_xcc_id(); b.st = st;
    if (threadIdx.x == 0) (void)xb_add(&bar[XB_XCNT(b.x)], 1u);
    return b;
}
__device__ __forceinline__ void xcd_barrier_complete(unsigned* bar, unsigned x, unsigned& nloc, unsigned& nx) {
    const unsigned G = gridDim.x * gridDim.y * gridDim.z;
    unsigned sum, cnt, mine, sp = 0u;
    for (;;) {
        sum = 0u; cnt = 0u; mine = 0u;
#pragma unroll
        for (unsigned j = 0; j < 16; ++j) { const unsigned c = xb_ld(&bar[XB_XCNT(j)]); sum += c; cnt += (c > 0u) ? 1u : 0u; mine = (j == x) ? c : mine; }
        if (sum == G) break;
        __builtin_amdgcn_s_sleep(1);
        if ((++sp & 255u) == 0u) { if (xb_ld(&bar[XB_TMO])) break; if (sp > XB_SPIN_CAP) { atomicAdd(&bar[XB_TMO], 1u); break; } }
    }
    nloc = mine > 0u ? mine : 1u; nx = cnt > 0u ? cnt : 1u;
}
__device__ __forceinline__ void xcd_barrier(const XcdBarrier& b) {
    asm volatile("s_waitcnt vmcnt(0)" ::: "memory");
    __syncthreads();
    if (threadIdx.x == 0) {
        unsigned* bar = b.bar;
        __builtin_amdgcn_s_waitcnt(0);
        unsigned nloc = b.st[0], nx = b.st[1];
        if (nloc == 0u) { xcd_barrier_complete(bar, b.x, nloc, nx); b.st[0] = nloc; b.st[1] = nx; }
        const unsigned old = xb_add(&bar[XB_XSUB(b.x)], 1u);
        const unsigned gen = old / nloc;
        if (old + 1u == (gen + 1u) * nloc) {
            __builtin_amdgcn_fence(__ATOMIC_RELEASE, "agent");
            asm volatile("s_waitcnt vmcnt(0)" ::: "memory");
            const unsigned og = xb_add(&bar[XB_TOP], 1u);
            const unsigned tg = og / nx;
            if (og + 1u == (tg + 1u) * nx) xb_add(&bar[XB_TOPGEN], 1u);
            else XB_SPIN(xb_ld(&bar[XB_TOPGEN]) == tg, bar);
            __builtin_amdgcn_fence(__ATOMIC_ACQUIRE, "agent");
            xb_add(&bar[XB_XGEN(b.x)], 1u);
            asm volatile("s_waitcnt vmcnt(0)" ::: "memory");
        } else {
            XB_SPIN(xb_ld(&bar[XB_XGEN(b.x)]) == gen, bar);
            __builtin_amdgcn_fence(__ATOMIC_ACQUIRE, "agent");
            asm volatile("s_waitcnt vmcnt(0)" ::: "memory");
        }
    }
    __syncthreads();
}

namespace g8 {
constexpr int BM = 256, BK = 64, HALF = 128, HTB = HALF * BK * 2, STAGE_BYTES = 8 * HTB;
static_assert(STAGE_BYTES == RING_BYTES, "ring");
__host__ __device__ __forceinline__ int lds_byte(int r, int c) { const int st = (r >> 4) * 2 + (c >> 5), rr = r & 15, cc = c & 31, ob = rr * 64 + cc * 2; return st * 1024 + (ob ^ (((ob >> 9) & 1) << 5)); }
__host__ __device__ __forceinline__ void stage_rc(int b, int& R, int& C) { const int st = b / 1024, sb = b % 1024, swz = sb ^ (((sb >> 9) & 1) << 5); R = (st >> 1) * 16 + swz / 64; C = (st & 1) * 32 + (swz % 64) / 2; }
struct Unit { int pm, pn, e; };

struct DenseSched {
    static constexpr bool GATHER = false;
    const char* A; const char* Bt; int lda, ldb; int nM, nN, nwg, G, c;
    __device__ __forceinline__ void init(const void* A_, int lda_, const void* Bt_, int ldb_, int Mrows, int N, int G_, int c_) { A = (const char*)A_; Bt = (const char*)Bt_; lda = lda_; ldb = ldb_; nM = Mrows / BM; nN = N / BM; nwg = nM * nN; G = G_; c = c_; }
    __device__ __forceinline__ bool next(int i, Unit& u) const {
        const long L = (long)i * G + c; if (L >= nwg) return false;
        int wgid = (int)L; { const int q = nwg / 8, r = nwg % 8, xcd = wgid % 8, off = wgid / 8; wgid = (xcd < r ? xcd * (q + 1) : r * (q + 1) + (xcd - r) * q) + off; }
        const int nig = 8 * nN, gid = wgid / nig, fm = gid * 8, gsz = (nM - fm) < 8 ? (nM - fm) : 8;
        u.pm = fm + ((wgid % nig) % gsz); u.pn = (wgid % nig) / gsz; u.e = 0; return true;
    }
    __device__ __forceinline__ const char* a_base(const Unit& u) const { return A + (size_t)u.pm * BM * lda; }
    __device__ __forceinline__ const char* b_base(const Unit& u) const { return Bt + (size_t)u.pn * BM * ldb; }
    __device__ __forceinline__ unsigned a_off(const Unit&, int row, int C) const { return (unsigned)(row * lda + C * 2); }
    __device__ __forceinline__ unsigned b_off(int row, int C) const { return (unsigned)(row * ldb + C * 2); }
};

struct TailSched {
    static constexpr bool GATHER = false;
    const char* A; const char* Bt; int lda, ldb, nunits, first, stride;
    __device__ __forceinline__ bool next(int i, Unit& u) const { const int L = first + i * stride; if (first < 0 || L >= nunits) return false; u.pm = L >> 3; u.pn = L & 7; u.e = 0; return true; }
    __device__ __forceinline__ const char* a_base(const Unit& u) const { return A + (size_t)u.pm * BM * lda; }
    __device__ __forceinline__ const char* b_base(const Unit& u) const { return Bt + (size_t)u.pn * BM * ldb; }
    __device__ __forceinline__ unsigned a_off(const Unit&, int row, int C) const { return (unsigned)(row * lda + C * 2); }
    __device__ __forceinline__ unsigned b_off(int row, int C) const { return (unsigned)(row * ldb + C * 2); }
};

template <class Epi, class Sched, bool F8 = false>
__device__ __forceinline__ void gemm_phase(LAS unsigned char* lds, const int wid, const int K, const Sched& S, const Epi& E, const int sclW = 0, const int sclA = 0) {
    const int lane = lane_id_fresh()  , tid = wid * 64 + lane, wr = wid >> 2, wc = wid & 3, fr = lane & 15, fq = lane >> 4;
    const int nt = F8 ? K / 128 : K / BK;
    int Rr[2], Cc[2];
#pragma unroll
    for (int i = 0; i < 2; ++i) stage_rc(tid * 16 + i * 8192, Rr[i], Cc[i]);
    unsigned voffB[2];
#pragma unroll
    for (int i = 0; i < 2; ++i) voffB[i] = S.b_off(Rr[i], Cc[i]);
    const size_t kstep = (size_t)(BK * 2);
    const size_t hstepB = (size_t)S.b_off(HALF, 0);
    const unsigned ldsw = (unsigned)wid * 1024u;
    const int aoff = lds_byte(wr * 64 + fr, fq * 8), boff = lds_byte(wc * 32 + fr, fq * 8);
#define G8_SA(b, h) (((b) * 2 + (h)) * HTB)
#define G8_SB(b, h) ((4 + (b) * 2 + (h)) * HTB)
#define G8_STAGE(bufoff, gbase, voff) do { _Pragma("unroll") for (int _i = 0; _i < 2; ++_i) { unsigned _o = (voff)[_i]; asm volatile("" : "+v"(_o));     \
        __builtin_amdgcn_global_load_lds((const unsigned*)((const char*)(gbase) + _o), (LAS unsigned*)(lds + (bufoff) + ldsw + _i * 8192), 16, 0, 0); } } while (0)
#define G8_LD32(p) __builtin_shufflevector(*(const LAS v4i_t*)(p), *(const LAS v4i_t*)((p) + 1024), 0, 1, 2, 3, 4, 5, 6, 7)
#define G8_LDA(dst, b, h) do { _Pragma("unroll") for (int m = 0; m < 4; ++m) dst[m] = G8_LD32(lds + G8_SA(b, h) + aoff + m * 2048); } while (0)
#define G8_LDB(dst, b, h) do { _Pragma("unroll") for (int n = 0; n < 2; ++n) dst[n] = G8_LD32(lds + G8_SB(b, h) + boff + n * 2048); } while (0)
#define G8_LO(x) __builtin_bit_cast(bf16x8, __builtin_shufflevector(x, x, 0, 1, 2, 3))
#define G8_HI(x) __builtin_bit_cast(bf16x8, __builtin_shufflevector(x, x, 4, 5, 6, 7))
#define G8_MMA(ai, bj, At, Bt) do { __builtin_amdgcn_s_setprio(1); _Pragma("unroll") for (int m = 0; m < 4; ++m) _Pragma("unroll") for (int n = 0; n < 2; ++n) { \
        if constexpr (F8) acc[ai][bj][m][n] = __builtin_amdgcn_mfma_scale_f32_16x16x128_f8f6f4(Bt[n], At[m], acc[ai][bj][m][n], 0, 0, 0, sclW, 0, sclA); \
        else { acc[ai][bj][m][n] = __builtin_amdgcn_mfma_f32_16x16x32_bf16(G8_LO(Bt[n]), G8_LO(At[m]), acc[ai][bj][m][n], 0, 0, 0); \
               acc[ai][bj][m][n] = __builtin_amdgcn_mfma_f32_16x16x32_bf16(G8_HI(Bt[n]), G8_HI(At[m]), acc[ai][bj][m][n], 0, 0, 0); } } \
        __builtin_amdgcn_s_setprio(0); } while (0)
#define G8_WAIT_V(n) asm volatile("s_waitcnt vmcnt(" #n ")" ::: "memory")
#define G8_WAIT_L(n) asm volatile("s_waitcnt lgkmcnt(" #n ")" ::: "memory")
#define G8_BAR __builtin_amdgcn_s_barrier()
#define G8_SCHED __builtin_amdgcn_sched_barrier(0)
    Unit cur, nxt; int ui = 0;
    if (!S.next(0, cur)) return;
    f32x4 acc[2][2][4][2];
#pragma unroll
    for (int a = 0; a < 2; ++a)
#pragma unroll
        for (int b = 0; b < 2; ++b)
#pragma unroll
            for (int m = 0; m < 4; ++m)
#pragma unroll
                for (int n = 0; n < 2; ++n) acc[a][b][m][n] = (f32x4){0.f, 0.f, 0.f, 0.f};
    v8i_t At[4], B0[2], B1[2];
    unsigned cvA[2][2];
#define G8_NVSLOT ((LAS u32x4*)(lds + RING_BYTES) + (lane_id_fresh() + wid * 64))
#pragma unroll
    for (int h = 0; h < 2; ++h)
#pragma unroll
        for (int i = 0; i < 2; ++i) cvA[h][i] = S.a_off(cur, h * HALF + Rr[i], Cc[i]);
    const char* cA = S.a_base(cur); const char* cB = S.b_base(cur);
    G8_STAGE(G8_SB(0, 0), cB, voffB); G8_STAGE(G8_SB(0, 1), cB + hstepB, voffB); G8_STAGE(G8_SA(0, 0), cA, cvA[0]); G8_STAGE(G8_SA(0, 1), cA, cvA[1]);
    if (wr == 1) G8_BAR;
    G8_WAIT_V(2); G8_BAR;
    G8_STAGE(G8_SB(1, 0), cB + kstep, voffB); G8_STAGE(G8_SA(1, 0), cA + kstep, cvA[0]); G8_STAGE(G8_SB(1, 1), cB + hstepB + kstep, voffB);
    G8_WAIT_V(6); G8_BAR;
    LAS unsigned char* const metab = lds + RING_BYTES + 8192;
    for (;;) {
        E.meta_issue(cur, metab + (ui & 1) * 2048, wid);
        const bool has_next = S.next(ui + 1, nxt);
        const char* nA = has_next ? S.a_base(nxt) : cA; const char* nB = has_next ? S.b_base(nxt) : cB;
        if constexpr (Sched::GATHER) {
            const int t2 = lane_id_fresh() + wid * 64;
            int R0, C0, R1, C1; stage_rc(t2 * 16, R0, C0); stage_rc(t2 * 16 + 8192, R1, C1);
            u32x4 nv;
            nv.x = has_next ? S.a_off(nxt, R0, C0) : cvA[0][0]; nv.y = has_next ? S.a_off(nxt, R1, C1) : cvA[0][1];
            nv.z = has_next ? S.a_off(nxt, HALF + R0, C0) : cvA[1][0]; nv.w = has_next ? S.a_off(nxt, HALF + R1, C1) : cvA[1][1];
            *((LAS u32x4*)(lds + RING_BYTES) + t2) = nv;
        }
        asm volatile(".p2align 8" ::: "memory");
        for (int t = 0; t < nt; t += 2) {
            const bool last = (t == nt - 2);
            const char* a1 = cA + (size_t)(t + 1) * kstep;
            const char* a2 = last ? nA : cA + (size_t)(t + 2) * kstep; const char* b2 = last ? nB : cB + (size_t)(t + 2) * kstep;
            const char* a3 = a2 + kstep; const char* b3 = b2 + kstep;
            unsigned v2[2][2];
            if (Sched::GATHER && last) { const u32x4 nv = *G8_NVSLOT; v2[0][0] = nv.x; v2[0][1] = nv.y; v2[1][0] = nv.z; v2[1][1] = nv.w; }
            else { v2[0][0] = cvA[0][0]; v2[0][1] = cvA[0][1]; v2[1][0] = cvA[1][0]; v2[1][1] = cvA[1][1]; }
            G8_LDB(B0, 0, 0); G8_LDB(B1, 0, 1); G8_SCHED; G8_LDA(At, 0, 0); G8_STAGE(G8_SA(1, 1), a1, cvA[1]);
            G8_WAIT_V(8); G8_WAIT_L(0); G8_BAR; G8_MMA(0, 0, At, B0); G8_MMA(0, 1, At, B1); G8_BAR; G8_SCHED;
            G8_LDA(At, 0, 1); G8_STAGE(G8_SB(0, 0), b2, voffB); G8_STAGE(G8_SB(0, 1), b2 + hstepB, voffB); G8_STAGE(G8_SA(0, 0), a2, v2[0]);
            G8_WAIT_V(8); G8_WAIT_L(0); G8_BAR; G8_MMA(1, 0, At, B0); G8_MMA(1, 1, At, B1); G8_BAR; G8_SCHED;
            G8_LDB(B0, 1, 0); G8_LDB(B1, 1, 1); G8_SCHED; G8_LDA(At, 1, 0); G8_STAGE(G8_SA(0, 1), a2, v2[1]);
            G8_WAIT_V(8); G8_WAIT_L(0); G8_BAR; G8_MMA(0, 0, At, B0); G8_MMA(0, 1, At, B1); G8_BAR; G8_SCHED;
            G8_LDA(At, 1, 1); G8_STAGE(G8_SB(1, 0), b3, voffB); G8_STAGE(G8_SB(1, 1), b3 + hstepB, voffB); G8_STAGE(G8_SA(1, 0), a3, v2[0]);
            G8_WAIT_V(8); G8_WAIT_L(0); G8_BAR; G8_MMA(1, 0, At, B0); G8_MMA(1, 1, At, B1); G8_BAR; G8_SCHED;
        }
        if (wr == 0) G8_BAR;
        { const int lf = lane_id_fresh(); E(acc, cur, wr, wc, lf & 15, lf >> 4, (const LAS float*)(metab + (ui & 1) * 2048)); }
        if (!has_next) break;
#pragma unroll
        for (int a = 0; a < 2; ++a)
#pragma unroll
            for (int b = 0; b < 2; ++b)
#pragma unroll
                for (int m = 0; m < 4; ++m)
#pragma unroll
                    for (int n = 0; n < 2; ++n) acc[a][b][m][n] = (f32x4){0.f, 0.f, 0.f, 0.f};
        cur = nxt; cA = nA; cB = nB; ++ui;
        if constexpr (Sched::GATHER) { const u32x4 nv = *G8_NVSLOT; cvA[0][0] = nv.x; cvA[0][1] = nv.y; cvA[1][0] = nv.z; cvA[1][1] = nv.w; }
        if (wr == 1) G8_BAR;
    }
    G8_WAIT_V(0);
    G8_BAR;
#undef G8_SA
#undef G8_SB
#undef G8_STAGE
#undef G8_LDA
#undef G8_LDB
#undef G8_MMA
#undef G8_NVSLOT
#undef G8_LO
#undef G8_HI
#undef G8_LD32
#undef G8_WAIT_V
#undef G8_WAIT_L
#undef G8_BAR
#undef G8_SCHED
}

#define G8_META_DMA(srcptr, mbuf, col, wid) do { if ((wid) < 4) __builtin_amdgcn_global_load_lds((const unsigned*)(srcptr), (LAS unsigned*)((mbuf) + (col) * 1024 + (wid) * 256), 4, 0, 0); } while (0)

struct EpiProj {
    const float* rs0; const float* g_q; const float* g_k; bf16_t *Q, *Kb, *V, *GB, *CU;
    __device__ __forceinline__ void meta_issue(const Unit& u, LAS unsigned char* mb, int wid) const { G8_META_DMA(rs0 + u.pm * BM + wid * 64 + lane_id_fresh(), mb, 0, wid); }
    __device__ __forceinline__ void operator()(f32x4 (&acc)[2][2][4][2], const Unit& u, int wr, int wc, int fr, int fq, const LAS float* meta) const {
        const int pn = u.pn, rbase = u.pm * BM + wr * 64 + fr;
        float rsv[2][4];
#pragma unroll
        for (int ai = 0; ai < 2; ++ai)
#pragma unroll
            for (int m = 0; m < 4; ++m) rsv[ai][m] = meta[ai * HALF + wr * 64 + m * 16 + fr];
        if (pn < 8) {
            const bool isq = pn < 4; const float* gn = isq ? g_q : g_k; const float sc = isq ? 0.125f * LOG2E : 1.f;
            bf16_t* O = isq ? Q : Kb; const int colb = (pn & 3) * 256 + wc * 64 + fq * 8;
            f32x4 gv[2][2];
#pragma unroll
            for (int bj = 0; bj < 2; ++bj)
#pragma unroll
                for (int n = 0; n < 2; ++n) gv[bj][n] = *(const f32x4*)(gn + bj * 32 + fq * 8 + n * 4);
#pragma unroll
            for (int ai = 0; ai < 2; ++ai)
#pragma unroll
                for (int m = 0; m < 4; ++m) {
                    const int row = rbase + ai * HALF + m * 16; const float rs = rsv[ai][m];
                    float ss = 0.f;
#pragma unroll
                    for (int bj = 0; bj < 2; ++bj)
#pragma unroll
                        for (int n = 0; n < 2; ++n) { acc[ai][bj][m][n] = acc[ai][bj][m][n] * rs; ss += dot4(acc[ai][bj][m][n]); }
                    ss += __shfl_xor(ss, 16); ss += __shfl_xor(ss, 32);
                    const float r = rsqrtf(ss * (1.f / 64.f) + EPS) * sc;
#pragma unroll
                    for (int bj = 0; bj < 2; ++bj) *(u32x4*)(O + (size_t)row * 1024 + colb + bj * 32) = pack8(acc[ai][bj][m][0] * r * gv[bj][0], acc[ai][bj][m][1] * r * gv[bj][1]);
                }
        } else if (pn < 16) {
            bf16_t* O = pn < 12 ? V : GB; const int colb = (pn & 3) * 256 + wc * 32 + fq * 8;
#pragma unroll
            for (int ai = 0; ai < 2; ++ai)
#pragma unroll
                for (int m = 0; m < 4; ++m) {
                    const int row = rbase + ai * HALF + m * 16; const float rs = rsv[ai][m];
#pragma unroll
                    for (int bj = 0; bj < 2; ++bj) *(u32x4*)(O + (size_t)row * 1024 + colb + bj * 128) = pack8(acc[ai][bj][m][0] * rs, acc[ai][bj][m][1] * rs);
                }
        } else {
            const int colb = (pn - 16) * 128 + wc * 32 + fq * 8;
#pragma unroll
            for (int ai = 0; ai < 2; ++ai)
#pragma unroll
                for (int m = 0; m < 4; ++m) {
                    const int row = rbase + ai * HALF + m * 16; const float rs = rsv[ai][m], rs2 = rs * rs;
                    *(u32x4*)(CU + (size_t)row * 1024 + colb) = pack8(acc[ai][0][m][0] * acc[ai][1][m][0] * rs2, acc[ai][0][m][1] * acc[ai][1][m][1] * rs2);
                }
        }
    }
};
struct EpiBf16 {
    bf16_t* O; int ldo;
    __device__ __forceinline__ void meta_issue(const Unit&, LAS unsigned char*, int) const {}
    __device__ __forceinline__ void operator()(f32x4 (&acc)[2][2][4][2], const Unit& u, int wr, int wc, int fr, int fq, const LAS float* meta) const {
        const int rbase = u.pm * BM + wr * 64 + fr, colb = u.pn * BM + wc * 32 + fq * 8;
#pragma unroll
        for (int ai = 0; ai < 2; ++ai)
#pragma unroll
            for (int m = 0; m < 4; ++m) { const int row = rbase + ai * HALF + m * 16;
#pragma unroll
                for (int bj = 0; bj < 2; ++bj) *(u32x4*)(O + (size_t)row * ldo + colb + bj * 128) = pack8(acc[ai][bj][m][0], acc[ai][bj][m][1]); }
    }
};
struct EpiRes {
    __device__ __forceinline__ void meta_issue(const Unit&, LAS unsigned char*, int) const {}
    const bf16_t* xb; bf16_t* H; float* SSQ; unsigned char* H8;
    __device__ __forceinline__ void operator()(f32x4 (&acc)[2][2][4][2], const Unit& u, int wr, int wc, int fr, int fq, const LAS float* meta) const {
        const int rbase = u.pm * BM + wr * 64 + fr, colb = u.pn * BM + wc * 32 + fq * 8;
        u32x4 xa[2][4][2];
#pragma unroll
        for (int ai = 0; ai < 2; ++ai)
#pragma unroll
            for (int m = 0; m < 4; ++m)
#pragma unroll
                for (int bj = 0; bj < 2; ++bj) xa[ai][m][bj] = *(const u32x4*)(xb + (size_t)(rbase + ai * HALF + m * 16) * DM + colb + bj * 128);
#pragma unroll
        for (int ai = 0; ai < 2; ++ai)
#pragma unroll
            for (int m = 0; m < 4; ++m) { const int row = rbase + ai * HALF + m * 16; float ss = 0.f;
#pragma unroll
                for (int bj = 0; bj < 2; ++bj) { const size_t o = (size_t)row * DM + colb + bj * 128; const u32x4 xw = xa[ai][m][bj];
                    const f32x4 x0 = (f32x4){__uint_as_float(xw.x << 16), __uint_as_float(xw.x & 0xffff0000u), __uint_as_float(xw.y << 16), __uint_as_float(xw.y & 0xffff0000u)};
                    const f32x4 x1 = (f32x4){__uint_as_float(xw.z << 16), __uint_as_float(xw.z & 0xffff0000u), __uint_as_float(xw.w << 16), __uint_as_float(xw.w & 0xffff0000u)};
                    const f32x4 h0 = acc[ai][bj][m][0] + x0, h1 = acc[ai][bj][m][1] + x1;
                    ss += dot4(h0) + dot4(h1);
                    *(u32x4*)(H + o) = pack8(h0, h1);
                    u32x2 w8; w8.x = pack4_fp8(h0, F8_H); w8.y = pack4_fp8(h1, F8_H); *(u32x2*)(H8 + o) = w8; }
                ss += __shfl_xor(ss, 16); ss += __shfl_xor(ss, 32);
                if (fq == 0) SSQ[(size_t)row * 32 + u.pn * 4 + wc] = ss; }
    }
};
struct EpiRouter {
    float* PART;
    __device__ __forceinline__ void meta_issue(const Unit&, LAS unsigned char*, int) const {}
    __device__ __forceinline__ void operator()(f32x4 (&acc)[2][2][4][2], const Unit& u, int wr, int wc, int fr, int fq, const LAS float* meta) const {
        if (wc < 2) {
            const int rbase = u.pm * BM + wr * 64 + fr;
#pragma unroll
            for (int ai = 0; ai < 2; ++ai)
#pragma unroll
                for (int m = 0; m < 4; ++m) { const int row = rbase + ai * HALF + m * 16;
#pragma unroll
                    for (int n = 0; n < 2; ++n) *(f32x4*)(PART + ((size_t)u.e * M + row) * 64 + wc * 32 + n * 16 + fq * 4) = acc[ai][0][m][n]; }
        }
    }
};
struct KSplitSched {
    static constexpr bool GATHER = false;
    const char* A; const char* Bt; int G, c;
    __device__ __forceinline__ bool next(int i, Unit& u) const { const int L = i * G + c; if (L >= (M / BM) * 4) return false; u.pm = L >> 2; u.pn = 0; u.e = L & 3; return true; }
    __device__ __forceinline__ const char* a_base(const Unit& u) const { return A + (size_t)u.pm * BM * DM * 2 + (size_t)u.e * 512 * 2; }
    __device__ __forceinline__ const char* b_base(const Unit& u) const { return Bt + (size_t)u.e * 512 * 2; }
    __device__ __forceinline__ unsigned a_off(const Unit&, int row, int C) const { return (unsigned)(row * DM + C) * 2u; }
    __device__ __forceinline__ unsigned b_off(int row, int C) const { return (unsigned)(row * DM + C) * 2u; }
};
__device__ __forceinline__ f32x4 bf4lo(unsigned a, unsigned b) { return (f32x4){__uint_as_float(a << 16), __uint_as_float(a & 0xffff0000u), __uint_as_float(b << 16), __uint_as_float(b & 0xffff0000u)}; }
struct EpiFinal {
    const bf16_t* H2B; const bf16_t* PP; const float* rs2; float* out;
    __device__ __forceinline__ void meta_issue(const Unit& u, LAS unsigned char* mb, int wid) const { G8_META_DMA(rs2 + u.pm * BM + wid * 64 + lane_id_fresh(), mb, 0, wid); }
    __device__ __forceinline__ void operator()(f32x4 (&acc)[2][2][4][2], const Unit& u, int wr, int wc, int fr, int fq, const LAS float* meta) const {
        const int rbase = u.pm * BM + wr * 64 + fr, colb = u.pn * BM + wc * 32 + fq * 8;
        float rsv[2][4];
#pragma unroll
        for (int ai = 0; ai < 2; ++ai)
#pragma unroll
            for (int m = 0; m < 4; ++m) rsv[ai][m] = meta[ai * HALF + wr * 64 + m * 16 + fr];
        u32x4 hb[2][2][2], pb[2][2][2];
#define EF_LOAD(buf, b) do { _Pragma("unroll") for (int r2 = 0; r2 < 2; ++r2) { const int row_ = rbase + ((b) >> 1) * HALF + (((b) & 1) * 2 + r2) * 16; \
            _Pragma("unroll") for (int bj = 0; bj < 2; ++bj) { const size_t o_ = (size_t)row_ * DM + colb + bj * 128; hb[buf][r2][bj] = *(const u32x4*)(H2B + o_); pb[buf][r2][bj] = *(const u32x4*)(PP + o_); } } } while (0)
        EF_LOAD(0, 0);
#pragma unroll
        for (int b = 0; b < 4; ++b) {
            if (b == 0) EF_LOAD(1, 1); else if (b == 1) EF_LOAD(0, 2); else if (b == 2) EF_LOAD(1, 3);
#pragma unroll
            for (int r2 = 0; r2 < 2; ++r2) { const int ai = b >> 1, m = (b & 1) * 2 + r2, row = rbase + ai * HALF + m * 16; const float rs = rsv[ai][m];
#pragma unroll
                for (int bj = 0; bj < 2; ++bj) { const size_t o = (size_t)row * DM + colb + bj * 128;
                    const u32x4 hv = hb[b & 1][r2][bj], pv = pb[b & 1][r2][bj];
                    const f32x4 h0 = bf4lo(hv.x, hv.y), h1 = bf4lo(hv.z, hv.w), p0 = bf4lo(pv.x, pv.y), p1 = bf4lo(pv.z, pv.w);
                    f32x4 z0 = acc[ai][bj][m][0] * rs, z1 = acc[ai][bj][m][1] * rs, o0, o1;
#pragma unroll
                    for (int j = 0; j < 4; ++j) { o0[j] = h0[j] + p0[j] * fast_sigmoid(z0[j]); o1[j] = h1[j] + p1[j] * fast_sigmoid(z1[j]); }
                    *(f32x4*)(out + o) = o0; *(f32x4*)(out + o + 4) = o1; } }
        }
#undef EF_LOAD
    }
};

struct MoeTab { const LAS int* texp; const LAS int* trow0; const LAS int* tcnt; int ntile; };
struct UpSched {
    static constexpr bool GATHER = true;
    const char* Hb; const char* Wup; const int* LIST; MoeTab T; int G, c;
    __device__ __forceinline__ bool next(int i, Unit& u) const { const int L = i * G + c; if (L >= T.ntile * 4) return false; u.pm = L >> 2; u.pn = L & 3; u.e = T.texp[u.pm]; return true; }
    __device__ __forceinline__ const char* a_base(const Unit&) const { return Hb; }
    __device__ __forceinline__ const char* b_base(const Unit& u) const { return Wup + ((size_t)u.e * 1024 + (size_t)u.pn * 256) * DM; }
    __device__ __forceinline__ unsigned a_off(const Unit& u, int row, int C) const {
        int idx = T.trow0[u.pm] + row; const int n = T.tcnt[u.e]; idx = idx < n ? idx : n - 1;
        const int slot = LIST[(size_t)u.e * M + idx]; return (unsigned)(slot >> 1) * (unsigned)DM + (unsigned)C * 2u; }
    __device__ __forceinline__ unsigned b_off(int row, int C) const { return (unsigned)(row * DM + C * 2); }
};
struct DnSched {
    static constexpr bool GATHER = false;
    const char* HID; const char* Wdn; MoeTab T; int G, c;
    __device__ __forceinline__ bool next(int i, Unit& u) const { const int L = i * G + c; if (L >= T.ntile * 8) return false; u.pm = L >> 3; u.pn = L & 7; u.e = T.texp[u.pm]; return true; }
    __device__ __forceinline__ const char* a_base(const Unit& u) const { return HID + (size_t)u.pm * 256 * DFF; }
    __device__ __forceinline__ const char* b_base(const Unit& u) const { return Wdn + ((size_t)u.e * DM + (size_t)u.pn * 256) * DFF; }
    __device__ __forceinline__ unsigned a_off(const Unit&, int row, int C) const { return (unsigned)(row * DFF + C * 2); }
    __device__ __forceinline__ unsigned b_off(int row, int C) const { return (unsigned)(row * DFF + C * 2); }
};
struct EpiUp {
    const float* LRS; bf16_t* HID; MoeTab T; const float* ZERO;
    __device__ __forceinline__ void meta_issue(const Unit& u, LAS unsigned char* mb, int wid) const { const int n = T.tcnt[u.e]; const int idx = T.trow0[u.pm] + wid * 64 + lane_id_fresh();
        G8_META_DMA(idx < n ? LRS + (size_t)u.e * M + idx : ZERO, mb, 0, wid); }
    __device__ __forceinline__ void operator()(f32x4 (&acc)[2][2][4][2], const Unit& u, int wr, int wc, int fr, int fq, const LAS float* meta) const {
        const int colb = u.pn * 128 + wc * 32 + fq * 8;
        float rsv[2][4];
#pragma unroll
        for (int ai = 0; ai < 2; ++ai)
#pragma unroll
            for (int m = 0; m < 4; ++m) rsv[ai][m] = meta[ai * HALF + wr * 64 + m * 16 + fr];
#pragma unroll
        for (int ai = 0; ai < 2; ++ai)
#pragma unroll
            for (int m = 0; m < 4; ++m) {
                const int rit = ai * HALF + wr * 64 + m * 16 + fr; const float rs = rsv[ai][m];
                f32x4 h[2];
#pragma unroll
                for (int nn = 0; nn < 2; ++nn) { const f32x4 a = acc[ai][0][m][nn] * rs, b = acc[ai][1][m][nn] * rs;
#pragma unroll
                    for (int j = 0; j < 4; ++j) h[nn][j] = a[j] * fast_sigmoid(a[j]) * b[j]; }
                u32x2 w8; w8.x = pack4_fp8(h[0], F8_HID); w8.y = pack4_fp8(h[1], F8_HID);
                *(u32x2*)((unsigned char*)HID + ((size_t)u.pm * 256 + rit) * DFF + colb) = w8;
            }
    }
};
struct EpiDn {
    const int* LIST; const float* LTW; bf16_t* Y0; bf16_t* Y1; MoeTab T;
    __device__ __forceinline__ void meta_issue(const Unit& u, LAS unsigned char* mb, int wid) const { const int n = T.tcnt[u.e]; int idx = T.trow0[u.pm] + wid * 64 + lane_id_fresh(); idx = idx < n ? idx : n - 1;
        G8_META_DMA(LIST + (size_t)u.e * M + idx, mb, 0, wid); G8_META_DMA(LTW + (size_t)u.e * M + idx, mb, 1, wid); }
    __device__ __forceinline__ void operator()(f32x4 (&acc)[2][2][4][2], const Unit& u, int wr, int wc, int fr, int fq, const LAS float* meta) const {
        const int r0 = T.trow0[u.pm], n = T.tcnt[u.e], colb = u.pn * BM + wc * 32 + fq * 8;
        int slv[2][4]; float twv[2][4];
#pragma unroll
        for (int ai = 0; ai < 2; ++ai)
#pragma unroll
            for (int m = 0; m < 4; ++m) { const int rit = ai * HALF + wr * 64 + m * 16 + fr; slv[ai][m] = ((const LAS int*)meta)[rit]; twv[ai][m] = meta[256 + rit]; }
#pragma unroll
        for (int ai = 0; ai < 2; ++ai)
#pragma unroll
            for (int m = 0; m < 4; ++m) {
                const int idx = r0 + ai * HALF + wr * 64 + m * 16 + fr;
                if (idx < n) { const int slot = slv[ai][m]; const float tw = twv[ai][m];
                    unsigned char* Y = (unsigned char*)((slot & 1) ? Y1 : Y0) + (size_t)(slot >> 1) * DM + colb;
#pragma unroll
                    for (int bj = 0; bj < 2; ++bj) { u32x2 w8; w8.x = pack4_fp8(acc[ai][bj][m][0] * tw, F8_Y); w8.y = pack4_fp8(acc[ai][bj][m][1] * tw, F8_Y); *(u32x2*)(Y + bj * 128) = w8; } }
            }
    }
};
}

struct Args { const float* in[27]; float* out; unsigned char* ws; int ph_lo, ph_hi, li, pad; };
struct Frame {
    LAS unsigned char* lds; volatile LAS unsigned* MISC; unsigned char* ws;
    int wave, vcu, G;
};

__device__ __forceinline__ float wave_sum(float v) {
#pragma unroll
    for (int o = 1; o < 64; o <<= 1) v += __shfl_xor(v, o);
    return v;
}

__device__ __forceinline__ void tr_item(const float* src, int ld, const float* ks, int k0, int c0, bf16_t* dst, int ldk, int d0, int d1, LAS float* scr, int lane) {
    f32x4 v[16];
#pragma unroll
    for (int i = 0; i < 16; ++i) v[i] = *(const f32x4*)(src + (size_t)(k0 + 4 * i + (lane >> 4)) * ld + c0 + (lane & 15) * 4);
    const int c8 = lane & 7;
    f32x4 g0 = (f32x4){1.f, 1.f, 1.f, 1.f}, g1 = g0;
    if (ks) { g0 = *(const f32x4*)(ks + k0 + 8 * c8); g1 = *(const f32x4*)(ks + k0 + 8 * c8 + 4); }
#pragma unroll
    for (int i = 0; i < 16; ++i) { LAS float* s = scr + (4 * i + (lane >> 4)) * 65 + (lane & 15) * 4; s[0] = v[i][0]; s[1] = v[i][1]; s[2] = v[i][2]; s[3] = v[i][3]; }
    asm volatile("s_waitcnt lgkmcnt(0)" ::: "memory");
#pragma unroll
    for (int j = 0; j < 8; ++j) { const int rr = j * 8 + (lane >> 3), c32 = rr & 31;
        const int p32 = ((c32 >> 2) & 1) * 16 + (c32 >> 3) * 4 + (c32 & 3), drow = ((rr >> 5) ? d1 : d0) + p32;
        const LAS float* s = scr + (8 * c8) * 65 + rr;
        u32x4 o; o.x = cvt_pk_bf16(s[0] * g0[0], s[65] * g0[1]); o.y = cvt_pk_bf16(s[2 * 65] * g0[2], s[3 * 65] * g0[3]); o.z = cvt_pk_bf16(s[4 * 65] * g1[0], s[5 * 65] * g1[1]); o.w = cvt_pk_bf16(s[6 * 65] * g1[2], s[7 * 65] * g1[3]);
        *(u32x4*)(dst + (size_t)drow * ldk + k0 + 8 * c8) = o; }
    asm volatile("s_waitcnt lgkmcnt(0)" ::: "memory");
}
__device__ __forceinline__ void tr_item8(const float* src, int ld, const float* ks, int k0, int c0, unsigned char* dst, int ldk, int d0, int d1, LAS float* scr, int lane) {
    f32x4 v[16];
#pragma unroll
    for (int i = 0; i < 16; ++i) v[i] = *(const f32x4*)(src + (size_t)(k0 + 4 * i + (lane >> 4)) * ld + c0 + (lane & 15) * 4);
    const int c8 = lane & 7;
    f32x4 g0 = (f32x4){1.f, 1.f, 1.f, 1.f}, g1 = g0;
    if (ks) { g0 = *(const f32x4*)(ks + k0 + 8 * c8); g1 = *(const f32x4*)(ks + k0 + 8 * c8 + 4); }
#pragma unroll
    for (int i = 0; i < 16; ++i) { LAS float* s = scr + (4 * i + (lane >> 4)) * 65 + (lane & 15) * 4; s[0] = v[i][0]; s[1] = v[i][1]; s[2] = v[i][2]; s[3] = v[i][3]; }
    asm volatile("s_waitcnt lgkmcnt(0)" ::: "memory");
#pragma unroll
    for (int j = 0; j < 8; ++j) { const int rr = j * 8 + (lane >> 3), c32 = rr & 31;
        const int p32 = ((c32 >> 2) & 1) * 16 + (c32 >> 3) * 4 + (c32 & 3), drow = ((rr >> 5) ? d1 : d0) + p32;
        const LAS float* s = scr + (8 * c8) * 65 + rr;
        u32x2 o; o.x = pack4_fp8((f32x4){s[0], s[65], s[2 * 65], s[3 * 65]} * g0, F8_W); o.y = pack4_fp8((f32x4){s[4 * 65], s[5 * 65], s[6 * 65], s[7 * 65]} * g1, F8_W);
        *(u32x2*)(dst + (size_t)drow * ldk + k0 + 8 * c8) = o; }
    asm volatile("s_waitcnt lgkmcnt(0)" ::: "memory");
}
__device__ __forceinline__ int map_in(int c) {
    if (c < 2048) { const int w = c & 255; return (c & ~255) + ((w >> 5) & 1) * 128 + (w >> 6) * 32; }
    if (c < 4096) return c;
    const int ch = (c - 4096) & 1023; return (16 + (ch >> 7)) * 256 + ((ch >> 5) & 3) * 32 + (c >= 5120 ? 128 : 0);
}

__device__ __forceinline__ void prep_row(const float* x, const float* p, bf16_t* XB, float* RS0, bf16_t* PB, int row, int lane) {
    const GAS f32x4* xr = (const GAS f32x4*)(x + (size_t)row * DM) + lane;
    f32x4 v[8]; float s = 0.f;
#pragma unroll
    for (int j = 0; j < 8; ++j) v[j] = xr[64 * j];
    const f32x4 pv = *((const GAS f32x4*)(p + (size_t)row * PLE) + lane);
#pragma unroll
    for (int j = 0; j < 8; ++j) s += dot4(v[j]);
    s = wave_sum(s);
    GAS u32x2* o = (GAS u32x2*)(XB + (size_t)row * DM) + lane;
#pragma unroll
    for (int j = 0; j < 8; ++j) { u32x2 w; w.x = cvt_pk_bf16(v[j][0], v[j][1]); w.y = cvt_pk_bf16(v[j][2], v[j][3]); o[64 * j] = w; }
    if (lane == 0) RS0[row] = rsqrtf(s * (1.f / DM) + EPS);
    u32x2 w; w.x = cvt_pk_bf16(pv[0], pv[1]); w.y = cvt_pk_bf16(pv[2], pv[3]);
    *((GAS u32x2*)(PB + (size_t)row * PLE) + lane) = w;
}

__device__ __forceinline__ void p0_prologue(Frame& F, const Args& a) {
    unsigned char* ws = F.ws; const int lane = lane_id(), tid = F.wave * 64 + lane;
    const float* w_in = a.in[4]; const float* g_mix = a.in[3]; const float* w_o = a.in[15]; const float* g_ffn = a.in[16];
    const float* w1 = a.in[21]; const float* w3 = a.in[22]; const float* w2 = a.in[23]; const float* g_ple = a.in[24]; const float* w_gate = a.in[25]; const float* w_proj = a.in[26];
    if (blockIdx.x == 0 && tid < 256) {
        LAS float* red = (LAS float*)(F.lds + LCTL_OFF + 128);
        const float* rel_bias = a.in[2]; const int t = tid;
        float gq = 0.f, gk = 0.f, rb = fabsf(rel_bias[t]);
        if (t < 64) { gq = fabsf(a.in[5][t]); gk = fabsf(a.in[6][t]); }
        for (int o = 32; o > 0; o >>= 1) { gq = fmaxf(gq, __shfl_xor(gq, o)); gk = fmaxf(gk, __shfl_xor(gk, o)); rb = fmaxf(rb, __shfl_xor(rb, o)); }
        if ((t & 63) == 0) { red[t >> 6] = rb; if (t == 0) { red[8] = gq; red[9] = gk; } }
    }
    __syncthreads();
    if (blockIdx.x == 0 && tid < 256) {
        LAS float* red = (LAS float*)(F.lds + LCTL_OFF + 128);
        const float* rel_bias = a.in[2]; const int t = tid;
        const float rbm = fmaxf(fmaxf(red[0], red[1]), fmaxf(red[2], red[3]));
        const float m0 = 8.f * red[8] * red[9] + rbm;
        float* BT = (float*)(ws + WS_BT);
        for (int i = t; i < NH * BT_N; i += 256) { const int h = i / BT_N, idx = i % BT_N, rel = idx - 255; BT[i] = (rel_bias[rel_bucket(rel) * NH + h] - m0) * LOG2E; }
        if (t < 64) {
            float x1 = a.in[7][t] * a.in[8][t], x2 = a.in[9][t] * a.in[10][t];
            for (int o = 32; o > 0; o >>= 1) { x1 += __shfl_xor(x1, o); x2 += __shfl_xor(x2, o); }
            if (t == 0) ((float*)(ws + WS_LAM))[0] = expf(x1) - expf(x2) + LAM_INIT;
        }
    }
    __syncthreads();
    const int gw = F.vcu * NWAVES + F.wave, NGW = F.G * NWAVES;
    for (int m = gw; m < M; m += NGW) prep_row(a.in[0], a.in[1], (bf16_t*)(ws + WS_A), (float*)(ws + WS_RS0), (bf16_t*)(ws + WS_PB), m, lane);
    { const float* w_group = a.in[17]; const float* w_expert = a.in[19]; bf16_t* WR = (bf16_t*)(ws + WS_WR);
      for (int i = (F.vcu * NWAVES + F.wave) * 64 + lane; i < 256 * (DM / 8); i += F.G * NTHR) { const int pr = i / (DM / 8), k8 = (i % (DM / 8)) * 8;
          float v[8];
#pragma unroll
          for (int q = 0; q < 8; ++q) { const int k = k8 + q; v[q] = pr < 4 ? g_ffn[k] * w_group[k * 4 + pr] : pr < 36 ? g_ffn[k] * w_expert[k * 32 + pr - 4] : 0.f; }
          u32x4 o; o.x = cvt_pk_bf16(v[0], v[1]); o.y = cvt_pk_bf16(v[2], v[3]); o.z = cvt_pk_bf16(v[4], v[5]); o.w = cvt_pk_bf16(v[6], v[7]);
          *(u32x4*)(WR + (size_t)pr * DM + k8) = o; } }
    LAS float* scr = (LAS float*)(F.lds + F.wave * 16640);
    constexpr int I_IN = 32 * 96, I_O = 32 * 32, I_G = 32 * 32, I_P = 4 * 32, I_UP = 32 * 512, I_DN = 32 * 256;
    constexpr int NITEMS = I_IN + I_O + I_G + I_P + I_UP + I_DN;
    for (int it = gw; it < NITEMS; it += NGW) {
        int r = it;
        if (r < I_IN) { const int kb = r / 96, cb = r % 96, c0 = cb * 64; tr_item(w_in, 6144, g_mix, kb * 64, c0, (bf16_t*)(ws + WS_WIN), DM, map_in(c0), map_in(c0 + 32), scr, lane); continue; } r -= I_IN;
        if (r < I_O) { const int kb = r / 32, c0 = (r % 32) * 64; tr_item(w_o, DM, nullptr, kb * 64, c0, (bf16_t*)(ws + WS_WO), DM, c0, c0 + 32, scr, lane); continue; } r -= I_O;
        if (r < I_G) { const int kb = r / 32, c0 = (r % 32) * 64; tr_item8(w_gate, DM, g_ple, kb * 64, c0, ws + WS_WG, DM, c0, c0 + 32, scr, lane); continue; } r -= I_G;
        if (r < I_P) { const int kb = r / 32, c0 = (r % 32) * 64; tr_item(w_proj, DM, nullptr, kb * 64, c0, (bf16_t*)(ws + WS_WP), PLE, c0, c0 + 32, scr, lane); continue; } r -= I_P;
        if (r < I_UP) { const int e = r / 512, q = r % 512, which = q / 256, q2 = q % 256, kb = q2 / 8, c0 = (q2 % 8) * 64;
            const float* src = (which ? w3 : w1) + (size_t)e * DM * DFF;
            const int d0 = (c0 >> 7) * 256 + ((c0 >> 5) & 3) * 32 + which * 128, d1 = ((c0 + 32) >> 7) * 256 + (((c0 + 32) >> 5) & 3) * 32 + which * 128;
            tr_item8(src, DFF, g_ffn, kb * 64, c0, ws + WS_WUP + (size_t)e * 1024 * DM, DM, d0, d1, scr, lane); continue; } r -= I_UP;
        { const int e = r / 256, q = r % 256, kb = q / 32, c0 = (q % 32) * 64;
            tr_item8(w2 + (size_t)e * DFF * DM, DM, nullptr, kb * 64, c0, ws + WS_WDN + (size_t)e * DM * DFF, DFF, c0, c0 + 32, scr, lane); }
    }
}


namespace att {
typedef short v4i16_t __attribute__((ext_vector_type(4)));
constexpr int SLOT = 32768, STG_STRIDE = 132, STG_BYTES = 32 * STG_STRIDE * 4;
static_assert(4 * SLOT <= RING_BYTES && 8 * STG_BYTES <= LCTL_OFF, "attention LDS");
__device__ __forceinline__ void glds16(const void* gsrc, unsigned lds_dst) { unsigned keep;
    asm volatile("s_mov_b32 %0, m0\n\ts_mov_b32 m0, %2\n\ts_nop 0\n\tglobal_load_lds_dwordx4 %1, off\n\ts_mov_b32 m0, %0" : "=&s"(keep) : "v"(gsrc), "s"(lds_dst) : "memory"); }
__device__ __forceinline__ v4i16_t vtr(const LAS unsigned char* p) { return __builtin_amdgcn_ds_read_tr16_b64_v4i16((LAS v4i16_t*)p); }
__device__ __forceinline__ int crow(int r, int hi) { return (r & 3) + 8 * (r >> 2) + 4 * hi; }

__device__ __forceinline__ void attn_unit(int b, int h, int qb, const bf16_t* Q, const bf16_t* K, const bf16_t* V, bf16_t* AO, const float* g_subln, float lam, LAS unsigned char* lds, int wid) {
    const int lane = lane_id(), r32 = lane & 31, hi = lane >> 5;
    const int pair = wid >> 1, comp = wid & 1;
    const long rowbase = (long)b * SEQ; const int q0 = qb * 128, myrow0 = q0 + pair * 32;
    const int cw = myrow0 >> 6;
    const int NT = (q0 >> 6) + 2;
    const LAS float* bt = (const LAS float*)(lds + LBT_OFF);
    const float ffar = __builtin_amdgcn_exp2f(bt[0]);
    const bf16_t* ksrc = K + (size_t)(rowbase + 8 * wid + (lane >> 3)) * 1024 + h * 128 + (((lane & 7) ^ (((8 * wid + (lane >> 3)) >> 1) & 7)) * 8);
    const bf16_t* vsrc = V + (size_t)(rowbase + 16 * (wid & 3) + (lane >> 2)) * 1024 + h * 128 + (wid >> 2) * 32 + (lane & 3) * 8;
    const unsigned lds0 = (unsigned)(size_t)lds;
    const unsigned kdst = lds0 + wid * 1024, vdst = lds0 + 16384 + (wid >> 2) * 4096 + (wid & 3) * 1024;
#define ATT_DMA(t, sl) do { const size_t go_ = (size_t)(t) * 65536; const unsigned so_ = (unsigned)(sl); \
        glds16(ksrc + go_, (unsigned)__builtin_amdgcn_readfirstlane(kdst + so_)); glds16(ksrc + go_ + 64, (unsigned)__builtin_amdgcn_readfirstlane(kdst + so_ + 8192)); \
        glds16(vsrc + go_, (unsigned)__builtin_amdgcn_readfirstlane(vdst + so_)); glds16(vsrc + go_ + 64, (unsigned)__builtin_amdgcn_readfirstlane(vdst + so_ + 8192)); } while (0)
    f32x16 o[4];
#pragma unroll
    for (int d = 0; d < 4; ++d)
#pragma unroll
        for (int r = 0; r < 16; ++r) o[d][r] = 0.f;
    float l = 0.f;
    ATT_DMA(0, 0); ATT_DMA(1, SLOT);
    bf16x8 qr[4];
#pragma unroll
    for (int d0 = 0; d0 < 4; ++d0) qr[d0] = *(const bf16x8*)(Q + (size_t)(rowbase + myrow0 + r32) * 1024 + h * 128 + comp * 64 + d0 * 16 + hi * 8);
    asm volatile("" :: "v"(qr[0]), "v"(qr[1]), "v"(qr[2]), "v"(qr[3]));
    int sl_cur = 0, sl_prev = 3 * SLOT, sl_nn = 2 * SLOT;
    int kofs[4];
#pragma unroll
    for (int d0 = 0; d0 < 4; ++d0) kofs[d0] = comp * 8192 + r32 * 128 + (((2 * d0 + hi) ^ ((r32 >> 1) & 7)) * 16);
    const int vofs = 16384 + ((lane >> 4) & 1) * 32 + (lane & 3) * 8 + (4 * hi + ((lane & 15) >> 2)) * 64;
    const bool grpY = wid >= 4;
    u32x4 pw[4];
#define ATT_SGB(mask, n) __builtin_amdgcn_sched_group_barrier(mask, n, 0)
    f32x16 p1;
#define ATT_QKEXP(t, slot) do { const LAS unsigned char* sb = lds + (slot); f32x16 p0; \
        bf16x8 kf[4][2]; \
        _Pragma("unroll") for (int d0 = 0; d0 < 4; ++d0) { kf[d0][0] = *(const LAS bf16x8*)(sb + kofs[d0]); kf[d0][1] = *(const LAS bf16x8*)(sb + kofs[d0] + 4096); } \
        if ((t) == cw - 2 && (t) > 0) l *= ffar; \
        if ((t) >= cw - 2) { const int base = 64 * (t) + 4 * hi - (myrow0 + r32) + 255; \
            _Pragma("unroll") for (int r = 0; r < 16; ++r) { p0[r] = bt[base + (r & 3) + 8 * (r >> 2)]; p1[r] = bt[base + 32 + (r & 3) + 8 * (r >> 2)]; } \
            _Pragma("unroll") for (int d0 = 0; d0 < 4; ++d0) { \
                p0 = __builtin_amdgcn_mfma_f32_32x32x16_bf16(kf[d0][0], qr[d0], p0, 0, 0, 0); p1 = __builtin_amdgcn_mfma_f32_32x32x16_bf16(kf[d0][1], qr[d0], p1, 0, 0, 0); } } \
        else { const f32x16 z16 = {0.f, 0.f, 0.f, 0.f, 0.f, 0.f, 0.f, 0.f, 0.f, 0.f, 0.f, 0.f, 0.f, 0.f, 0.f, 0.f};     \
            p0 = __builtin_amdgcn_mfma_f32_32x32x16_bf16(kf[0][0], qr[0], z16, 0, 0, 0); p1 = __builtin_amdgcn_mfma_f32_32x32x16_bf16(kf[0][1], qr[0], z16, 0, 0, 0); \
            _Pragma("unroll") for (int d0 = 1; d0 < 4; ++d0) { \
                p0 = __builtin_amdgcn_mfma_f32_32x32x16_bf16(kf[d0][0], qr[d0], p0, 0, 0, 0); p1 = __builtin_amdgcn_mfma_f32_32x32x16_bf16(kf[d0][1], qr[d0], p1, 0, 0, 0); } } \
        float sacc = 0.f; \
        _Pragma("unroll") for (int r = 0; r < 16; ++r) { p0[r] = __builtin_amdgcn_exp2f(p0[r]); sacc += p0[r]; } \
        l += sacc; \
        _Pragma("unroll") for (int i = 0; i < 4; ++i) { pw[0][i] = cvt_pk_bf16(p0[2 * i], p0[2 * i + 1]); pw[1][i] = cvt_pk_bf16(p0[8 + 2 * i], p0[9 + 2 * i]); } } while (0)
#define ATT_VLD2(dst, db, k0) do { _Pragma("unroll") for (int kk = 0; kk < 2; ++kk) { \
            const v4i16_t lo = vtr(sb + vofs + (db) * 4096 + ((k0) + kk) * 1024), hh = vtr(sb + vofs + (db) * 4096 + ((k0) + kk) * 1024 + 512); \
            dst[(db) * 2 + kk] = (bf16x8){lo[0], lo[1], lo[2], lo[3], hh[0], hh[1], hh[2], hh[3]}; } } while (0)
#define ATT_PV(t, slot) do { const LAS unsigned char* sb = lds + (slot); bf16x8 h1[8], h2[8]; \
        if ((t) == cw - 2 && (t) > 0) { _Pragma("unroll") for (int db = 0; db < 4; ++db) o[db] = o[db] * ffar; } \
        _Pragma("unroll") for (int db = 0; db < 4; ++db) ATT_VLD2(h1, db, 0); \
          \
        float sacc = 0.f; \
        _Pragma("unroll") for (int r = 0; r < 16; ++r) { p1[r] = __builtin_amdgcn_exp2f(p1[r]); sacc += p1[r]; } \
        l += sacc; \
        _Pragma("unroll") for (int i = 0; i < 4; ++i) { pw[2][i] = cvt_pk_bf16(p1[2 * i], p1[2 * i + 1]); pw[3][i] = cvt_pk_bf16(p1[8 + 2 * i], p1[9 + 2 * i]); } \
        __builtin_amdgcn_sched_barrier(0); \
        _Pragma("unroll") for (int db = 0; db < 4; ++db) ATT_VLD2(h2, db, 2); \
        _Pragma("unroll") for (int db = 0; db < 4; ++db) { o[db] = __builtin_amdgcn_mfma_f32_32x32x16_bf16(__builtin_bit_cast(bf16x8, pw[0]), h1[db * 2], o[db], 0, 0, 0); \
                                                         o[db] = __builtin_amdgcn_mfma_f32_32x32x16_bf16(__builtin_bit_cast(bf16x8, pw[1]), h1[db * 2 + 1], o[db], 0, 0, 0); } \
        _Pragma("unroll") for (int db = 0; db < 4; ++db) { o[db] = __builtin_amdgcn_mfma_f32_32x32x16_bf16(__builtin_bit_cast(bf16x8, pw[2]), h2[db * 2], o[db], 0, 0, 0); \
                                                         o[db] = __builtin_amdgcn_mfma_f32_32x32x16_bf16(__builtin_bit_cast(bf16x8, pw[3]), h2[db * 2 + 1], o[db], 0, 0, 0); } } while (0)
#define ATT_WAIT_A(s_) do { if ((s_) + 1 < NT) asm volatile("s_waitcnt vmcnt(4) lgkmcnt(0)\n\ts_barrier" ::: "memory"); else asm volatile("s_waitcnt vmcnt(0) lgkmcnt(0)\n\ts_barrier" ::: "memory"); } while (0)
#define ATT_BAR_B() asm volatile("s_waitcnt lgkmcnt(0)\n\ts_barrier" ::: "memory")
    asm volatile(".p2align 8" ::: "memory");
    if (!grpY) {
        for (int s = 0; s <= NT; ++s) {
            ATT_WAIT_A(s);
            if (s < NT && s <= cw) ATT_QKEXP(s, sl_cur);
            ATT_BAR_B();
            if (s + 2 < NT) ATT_DMA(s + 2, sl_nn);
            if (s < NT && s <= cw) ATT_PV(s, sl_cur);
            sl_prev = sl_cur; sl_cur = (sl_cur == 3 * SLOT) ? 0 : sl_cur + SLOT; sl_nn = (sl_nn == 3 * SLOT) ? 0 : sl_nn + SLOT;
        }
    } else {
        for (int s = 0; s <= NT; ++s) {
            ATT_WAIT_A(s);
            if (s >= 1 && s - 1 <= cw) ATT_PV(s - 1, sl_prev);
            ATT_BAR_B();
            if (s + 2 < NT) ATT_DMA(s + 2, sl_nn);
            if (s < NT && s <= cw) ATT_QKEXP(s, sl_cur);
            sl_prev = sl_cur; sl_cur = (sl_cur == 3 * SLOT) ? 0 : sl_cur + SLOT; sl_nn = (sl_nn == 3 * SLOT) ? 0 : sl_nn + SLOT;
        }
    }
#undef ATT_WAIT_A
#undef ATT_BAR_B
#undef ATT_QKEXP
#undef ATT_PV
#undef ATT_VLD2
#undef ATT_SGB
#undef ATT_DMA
    l += __shfl_xor(l, 32);
    asm volatile("s_waitcnt vmcnt(0) lgkmcnt(0)\n\ts_barrier" ::: "memory");
    {   LAS float* st = (LAS float*)(lds + wid * STG_BYTES);
#pragma unroll
        for (int db = 0; db < 4; ++db)
#pragma unroll
            for (int r = 0; r < 16; ++r) st[crow(r, hi) * STG_STRIDE + db * 32 + r32] = o[db][r];
        if (hi == 0) ((LAS float*)(lds + LLS_OFF))[wid * 32 + r32] = l;
    }
    asm volatile("s_waitcnt lgkmcnt(0)\n\ts_barrier" ::: "memory");
    {   const int rsel = comp * 16 + (lane >> 2), quarter = lane & 3;
        const LAS float* s1 = (const LAS float*)(lds + (pair * 2) * STG_BYTES) + rsel * STG_STRIDE + quarter * 32;
        const LAS float* s2 = (const LAS float*)(lds + (pair * 2 + 1) * STG_BYTES) + rsel * STG_STRIDE + quarter * 32;
        const LAS float* ls = (const LAS float*)(lds + LLS_OFF);
        const float i1 = 1.f / ls[(pair * 2) * 32 + rsel], i2 = lam / ls[(pair * 2 + 1) * 32 + rsel];
        f32x4 v[8]; float ss = 0.f;
#pragma unroll
        for (int c = 0; c < 8; ++c) { v[c] = *(const LAS f32x4*)(s1 + c * 4) * i1 - *(const LAS f32x4*)(s2 + c * 4) * i2; ss += dot4(v[c]); }
        ss += __shfl_xor(ss, 1); ss += __shfl_xor(ss, 2);
        const float rstd = rsqrtf(ss * (1.f / 128.f) + EPS) * (1.f - LAM_INIT);
        bf16_t* op = AO + (size_t)(rowbase + myrow0 + rsel - comp * 16 + comp * 16) * DM + h * 128 + quarter * 32;
#pragma unroll
        for (int c = 0; c < 4; ++c) { const f32x4 g0 = *(const f32x4*)(g_subln + quarter * 32 + c * 8), g1 = *(const f32x4*)(g_subln + quarter * 32 + c * 8 + 4);
            *(u32x4*)(op + c * 8) = pack8(v[2 * c] * rstd * g0, v[2 * c + 1] * rstd * g1); }
    }
    asm volatile("s_waitcnt lgkmcnt(0)\n\ts_barrier" ::: "memory");
}
}

__device__ __forceinline__ void p2_conv(Frame& F, const Args& a) {
    unsigned char* ws = F.ws; const int lane = lane_id(), c0 = lane * 16;
    const bf16_t* CU = (const bf16_t*)(ws + WS_D); const bf16_t* GB = (const bf16_t*)(ws + WS_C) + (size_t)M * 1024; bf16_t* AO = (bf16_t*)(ws + WS_AO);
    const float* conv_w = a.in[12]; const float* conv_b = a.in[13]; const float* g_conv = a.in[14];
    f32x4 w0[4], w1[4], w2[4], cb[4], gc[4];
#pragma unroll
    for (int i = 0; i < 4; ++i) { w0[i] = *(const f32x4*)(conv_w + c0 + i * 4); w1[i] = *(const f32x4*)(conv_w + 1024 + c0 + i * 4); w2[i] = *(const f32x4*)(conv_w + 2048 + c0 + i * 4);
        cb[i] = *(const f32x4*)(conv_b + c0 + i * 4); gc[i] = *(const f32x4*)(g_conv + c0 + i * 4); }
    const int gw = F.vcu * NWAVES + F.wave, NGW = F.G * NWAVES;
    for (int row = gw; row < M; row += NGW) {
        const int s = row & (SEQ - 1);
        const u32x4 zz = (u32x4){0u, 0u, 0u, 0u};
        u32x4 x0[2], x1[2], x2[2], gb[2];
#pragma unroll
        for (int i = 0; i < 2; ++i) { x0[i] = *(const u32x4*)(CU + (size_t)row * 1024 + c0 + i * 8); gb[i] = *(const u32x4*)(GB + (size_t)row * 1024 + c0 + i * 8);
            x1[i] = s >= 1 ? *(const u32x4*)(CU + (size_t)(row - 1) * 1024 + c0 + i * 8) : zz; x2[i] = s >= 2 ? *(const u32x4*)(CU + (size_t)(row - 2) * 1024 + c0 + i * 8) : zz; }
        f32x4 z[4]; float ss = 0.f;
#pragma unroll
        for (int i = 0; i < 4; ++i) { const int q = i >> 1;
            const f32x4 a0 = (i & 1) ? g8::bf4lo(x0[q].z, x0[q].w) : g8::bf4lo(x0[q].x, x0[q].y), a1 = (i & 1) ? g8::bf4lo(x1[q].z, x1[q].w) : g8::bf4lo(x1[q].x, x1[q].y);
            const f32x4 a2 = (i & 1) ? g8::bf4lo(x2[q].z, x2[q].w) : g8::bf4lo(x2[q].x, x2[q].y), g = (i & 1) ? g8::bf4lo(gb[q].z, gb[q].w) : g8::bf4lo(gb[q].x, gb[q].y);
            z[i] = g * (w2[i] * a0 + w1[i] * a1 + w0[i] * a2 + cb[i]); ss += dot4(z[i]); }
        ss += __shfl_xor(ss, 1); ss += __shfl_xor(ss, 2); ss += __shfl_xor(ss, 4);
        const float r = rsqrtf(ss * (1.f / 128.f) + EPS);
        *(u32x4*)(AO + (size_t)row * DM + 1024 + c0) = pack8(z[0] * r * gc[0], z[1] * r * gc[1]);
        *(u32x4*)(AO + (size_t)row * DM + 1024 + c0 + 8) = pack8(z[2] * r * gc[2], z[3] * r * gc[3]);
    }
}
__device__ __forceinline__ void p2_attention(Frame& F, const Args& a) {
    unsigned char* ws = F.ws; const int tid = F.wave * 64 + lane_id();
    const bf16_t* Qb = (const bf16_t*)(ws + WS_B); const bf16_t* Kb = Qb + (size_t)M * 1024; const bf16_t* Vb = (const bf16_t*)(ws + WS_C); bf16_t* AO = (bf16_t*)(ws + WS_AO);
    const int bh = F.vcu >> 3, j = F.vcu & 7, b = bh >> 3, h = bh & 7;
    if (bh >= BATCH * NH) return;
    const float lam = ((const float*)(ws + WS_LAM))[0];
    { LAS float* bt = (LAS float*)(F.lds + LBT_OFF); const float* BT = (const float*)(ws + WS_BT) + h * BT_N; if (tid < BT_N) bt[tid] = BT[tid]; }
    asm volatile("s_waitcnt vmcnt(0) lgkmcnt(0)\n\ts_barrier" ::: "memory");
    for (int i = 0; i < 4; ++i) { const int qb = (i == 0) ? 31 - j : (i == 1) ? 16 + j : (i == 2) ? 15 - j : j;
        att::attn_unit(b, h, qb, Qb, Kb, Vb, AO, a.in[11], lam, F.lds, F.wave); }
}

__device__ __forceinline__ void p5_route(Frame& F, const Args& a) {
    unsigned char* ws = F.ws; const int lane = lane_id();
    const float* PART = (const float*)(ws + WS_PART); const float* SSQ = (const float*)(ws + WS_SSQ);
    const float* b_group = a.in[18]; const float* b_expert = a.in[20];
    float* RS1 = (float*)(ws + WS_RS1); int* TE = (int*)(ws + WS_TE); float* TW = (float*)(ws + WS_TW); unsigned* CNT = (unsigned*)(ws + WS_CNT); int* LIST = (int*)(ws + WS_LIST);
    for (int row = (F.vcu * NWAVES + F.wave) * 64 + lane; row < M; row += F.G * NTHR) {
        float ss = 0.f;
#pragma unroll
        for (int i = 0; i < 8; ++i) { const f32x4 v = *(const f32x4*)(SSQ + (size_t)row * 32 + i * 4); ss += (v[0] + v[1]) + (v[2] + v[3]); }
        const float rs = rsqrtf(ss * (1.f / DM) + EPS);
        f32x4 gl = (f32x4){0.f, 0.f, 0.f, 0.f};
#pragma unroll
        for (int ks = 0; ks < 4; ++ks) gl = gl + *(const f32x4*)(PART + ((size_t)ks * M + row) * 64);
        int gi = 0; float gm = -1e30f; float glv[4];
#pragma unroll
        for (int g = 0; g < 4; ++g) { glv[g] = gl[g] * rs + b_group[g]; if (glv[g] > gm) { gm = glv[g]; gi = g; } }
        float den = 0.f;
#pragma unroll
        for (int g = 0; g < 4; ++g) den += expf(glv[g] - gm);
        const float pg = 1.f / den;
        f32x4 e0 = (f32x4){0.f, 0.f, 0.f, 0.f}, e1 = e0;
#pragma unroll
        for (int ks = 0; ks < 4; ++ks) { const float* pp = PART + ((size_t)ks * M + row) * 64 + 4 + gi * 8; e0 = e0 + *(const f32x4*)pp; e1 = e1 + *(const f32x4*)(pp + 4); }
        float v0 = -1e30f, v1 = -1e30f; int i0 = 0, i1 = 0;
#pragma unroll
        for (int e = 0; e < 8; ++e) { const float v = (e < 4 ? e0[e & 3] : e1[e & 3]) * rs + b_expert[gi * 8 + e];
            if (v > v0) { v1 = v0; i1 = i0; v0 = v; i0 = e; } else if (v > v1) { v1 = v; i1 = e; } }
        const float ex = expf(v1 - v0), w0 = pg / (1.f + ex), w1 = pg * ex / (1.f + ex);
        const int x0 = gi * 8 + i0, x1 = gi * 8 + i1;
        RS1[row] = rs; TE[row * 2] = x0; TE[row * 2 + 1] = x1; TW[row * 2] = w0; TW[row * 2 + 1] = w1;
        float* LRS = (float*)(ws + WS_LRS); float* LTW = (float*)(ws + WS_LTW);
        const unsigned p0 = atomicAdd(&CNT[x0], 1u); LIST[(size_t)x0 * M + p0] = row * 2; LRS[(size_t)x0 * M + p0] = rs; LTW[(size_t)x0 * M + p0] = w0;
        const unsigned p1 = atomicAdd(&CNT[x1], 1u); LIST[(size_t)x1 * M + p1] = row * 2 + 1; LRS[(size_t)x1 * M + p1] = rs; LTW[(size_t)x1 * M + p1] = w1;
    }
}
__device__ __forceinline__ g8::MoeTab moe_tables(Frame& F) {
    LAS int* tab = (LAS int*)(F.lds + LTAB_OFF); const int tid = F.wave * 64 + lane_id();
    const unsigned* CNT = (const unsigned*)(F.ws + WS_CNT);
    __syncthreads();
    if (tid < 32) tab[384 + tid] = (int)__hip_atomic_load(CNT + tid, __ATOMIC_RELAXED, __HIP_MEMORY_SCOPE_AGENT);
    __syncthreads();
    if (tid == 0) { int nt = 0;
        for (int e = 0; e < NE; ++e) { const int n = tab[384 + e]; for (int r = 0; r < n && nt < 192; r += 256) { tab[nt] = e; tab[192 + nt] = r; ++nt; } }
        tab[416] = nt; }
    __syncthreads();
    g8::MoeTab T; T.texp = tab; T.trow0 = tab + 192; T.tcnt = tab + 384; T.ntile = tab[416];
    return T;
}
__device__ __forceinline__ void p7_combine(Frame& F) {
    unsigned char* ws = F.ws;
    bf16_t* H = (bf16_t*)(ws + WS_B); const bf16_t* Y0 = (const bf16_t*)(ws + WS_A); const bf16_t* Y1 = (const bf16_t*)(ws + WS_D); float* RS2 = (float*)(ws + WS_RS2); unsigned char* H28 = ws + WS_H28;
    const int gw = F.vcu * NWAVES + F.wave, NGW = F.G * NWAVES, lane = lane_id();
    for (int row = gw; row < M; row += NGW) {
        float ss = 0.f;
#pragma unroll
        for (int j = 0; j < 4; ++j) { const size_t o = (size_t)row * DM + j * 512 + lane * 8;
            const u32x4 hv = *(const u32x4*)(H + o); const u32x2 y0 = *(const u32x2*)((const unsigned char*)Y0 + o), y1 = *(const u32x2*)((const unsigned char*)Y1 + o);
            const f32x4 a = g8::bf4lo(hv.x, hv.y) + (unpack4_fp8(y0.x) + unpack4_fp8(y1.x)) * (1.f / F8_Y), b = g8::bf4lo(hv.z, hv.w) + (unpack4_fp8(y0.y) + unpack4_fp8(y1.y)) * (1.f / F8_Y);
            ss += dot4(a) + dot4(b);
            *(u32x4*)(H + o) = pack8(a, b);
            u32x2 w8; w8.x = pack4_fp8(a, F8_H); w8.y = pack4_fp8(b, F8_H); *(u32x2*)(H28 + o) = w8; }
        ss = wave_sum(ss);
        if (lane == 0) RS2[row] = rsqrtf(ss * (1.f / DM) + EPS);
    }
}

__global__ void __launch_bounds__(NTHR, 2) mk_fwd(Args args) {
    extern __shared__ __attribute__((aligned(16))) unsigned char lds_raw[];
    Frame F;
    F.lds = (LAS unsigned char*)lds_raw; F.MISC = (volatile LAS unsigned*)(F.lds + LCTL_OFF); F.ws = args.ws;
    F.wave = __builtin_amdgcn_readfirstlane(threadIdx.x >> 6);
    F.G = gridDim.x; { const int bx = blockIdx.x; F.vcu = (F.G % 8 == 0) ? (bx % 8) * (F.G / 8) + bx / 8 : bx; }
    unsigned char* ws = args.ws;
    if (threadIdx.x < 32) F.MISC[threadIdx.x] = 0u;
    __syncthreads();
    XcdBarrier bar = xcd_barrier_post((unsigned*)(ws + WS_BAR) + args.li * XCD_BAR_WORDS, F.MISC + 8);
    const int lo = args.ph_lo, hi = args.ph_hi;
#define IN(k) (lo <= (k) && (k) < hi)
#define SEAM(k) do { if (IN(k) && IN((k) + 1)) xcd_barrier(bar); } while (0)

    bf16_t* XB = (bf16_t*)(ws + WS_A); bf16_t* AO = (bf16_t*)(ws + WS_AO);
    bf16_t* Qb = (bf16_t*)(ws + WS_B); bf16_t* Kb = Qb + (size_t)M * 1024; bf16_t* H = Qb;
    bf16_t* Vb = (bf16_t*)(ws + WS_C); bf16_t* GB = Vb + (size_t)M * 1024;
    bf16_t* CU = (bf16_t*)(ws + WS_D);
    bf16_t* PP = (bf16_t*)(ws + WS_AO)  ; bf16_t* PB = (bf16_t*)(ws + WS_PB);
    float* RS0 = (float*)(ws + WS_RS0); float* RS2 = (float*)(ws + WS_RS2);

    if (IN(0)) { p0_prologue(F, args); } SEAM(0);

    if (IN(1)) {
        g8::DenseSched S; S.init(XB, DM * 2, ws + WS_WIN, DM * 2, M, 6144, F.G, (int)blockIdx.x);
        g8::EpiProj E{RS0, args.in[5], args.in[6], Qb, Kb, Vb, GB, CU};
        g8::gemm_phase<g8::EpiProj, g8::DenseSched>(F.lds, F.wave, DM, S, E);
    } SEAM(1);

    if (IN(2)) { p2_conv(F, args); p2_attention(F, args); } SEAM(2);

    if (IN(3)) {
        g8::DenseSched S; S.init(AO, DM * 2, ws + WS_WO, DM * 2, M, DM, F.G, (int)blockIdx.x);
        g8::EpiRes E{XB, H, (float*)(ws + WS_SSQ), ws + WS_H8};
        g8::gemm_phase<g8::EpiRes, g8::DenseSched>(F.lds, F.wave, DM, S, E);
    } SEAM(3);

    if (IN(4)) {
        g8::KSplitSched S{(const char*)H, (const char*)(ws + WS_WR), F.G, (int)blockIdx.x};
        g8::EpiRouter E{(float*)(ws + WS_PART)};
        g8::gemm_phase<g8::EpiRouter, g8::KSplitSched>(F.lds, F.wave, 512, S, E);
    } SEAM(4);

    if (IN(5)) { p5_route(F, args); } SEAM(5);

    if (IN(6)) {
        const g8::MoeTab T = moe_tables(F);
        g8::UpSched S{(const char*)(ws + WS_H8), (const char*)(ws + WS_WUP), (const int*)(ws + WS_LIST), T, F.G, F.vcu};
        g8::EpiUp E{(const float*)(ws + WS_LRS), Vb  , T, (const float*)(ws + WS_ZERO)};
        g8::gemm_phase<g8::EpiUp, g8::UpSched, true>(F.lds, F.wave, DM, S, E, E8_W, E8_H);
        { unsigned char* w2 = F.ws; const int nrem = (((const LAS int*)(F.lds + LTAB_OFF))[416] * 4) % F.G; const bool all = (nrem == 0) || (F.G - nrem < 96);
          g8::TailSched S2{(const char*)(w2 + WS_PB), (const char*)(w2 + WS_WP), PLE * 2, PLE * 2, (M / 256) * 8, all ? F.vcu : F.vcu - nrem, all ? F.G : F.G - nrem};
          g8::EpiBf16 E2{(bf16_t*)(w2 + WS_AO), DM};
          int kple = PLE; asm volatile("" : "+s"(kple));
          g8::gemm_phase<g8::EpiBf16, g8::TailSched>(F.lds, F.wave, kple, S2, E2); }
    } SEAM(6);

    if (IN(7)) {
        const g8::MoeTab T = moe_tables(F);
        g8::DnSched S{(const char*)Vb, (const char*)(ws + WS_WDN), T, F.G, F.vcu};
        g8::EpiDn E{(const int*)(ws + WS_LIST), (const float*)(ws + WS_LTW), XB  , CU  , T};
        int kdff = DFF; asm volatile("" : "+s"(kdff));
        g8::gemm_phase<g8::EpiDn, g8::DnSched, true>(F.lds, F.wave, kdff, S, E, E8_W, E8_HID);
    } SEAM(7);

    if (IN(8)) { p7_combine(F); } SEAM(8);

    if (IN(9)) {
        g8::DenseSched S; S.init(ws + WS_H28, DM, ws + WS_WG, DM, M, DM, F.G, (int)blockIdx.x);
        g8::EpiFinal E{H, PP, RS2, args.out};
        g8::gemm_phase<g8::EpiFinal, g8::DenseSched, true>(F.lds, F.wave, DM, S, E, E8_W, E8_H);
    }
#undef IN
#undef SEAM
}


static int mk_grid = 0;
static void launch_mk(Args a, int lo, int hi, int li, hipStream_t stream) {
    a.ph_lo = lo; a.ph_hi = hi; a.li = li; a.pad = 0;
    hipLaunchKernelGGL(mk_fwd, dim3(mk_grid), dim3(NTHR), LDS_BYTES, stream, a);
}

extern "C" void kernel_launch(void* const* d_in, const int* in_sizes, int n_in, void* d_out, int out_size, void* d_ws, size_t ws_size, hipStream_t stream) {
    if (n_in != 27 || ws_size < WS_END) { fprintf(stderr, "kernel_launch: unexpected n_in %d / ws %zu\n", n_in, ws_size); return; }
    if (mk_grid == 0) {
        int dev = 0, cus = 0;
        (void)hipGetDevice(&dev); (void)hipDeviceGetAttribute(&cus, hipDeviceAttributeMultiprocessorCount, dev);
        (void)hipFuncSetAttribute((const void*)mk_fwd, hipFuncAttributeMaxDynamicSharedMemorySize, LDS_BYTES);
        int per_cu = 0; (void)hipOccupancyMaxActiveBlocksPerMultiprocessor(&per_cu, (const void*)mk_fwd, NTHR, LDS_BYTES); (void)hipGetLastError();
        mk_grid = 256;
        if (cus != 256 || per_cu < 1) fprintf(stderr, "kernel_launch: note: %d CUs, occupancy query %d; built for 256 CUs x 1 workgroup\n", cus, per_cu);
    }
    float* out = (float*)d_out; unsigned char* ws = (unsigned char*)d_ws;
    (void)in_sizes; (void)out_size;
    (void)hipMemsetAsync(ws + WS_CTL, 0, 1 * MiB, stream);
    Args a{};
    for (int i = 0; i < 27; ++i) a.in[i] = (const float*)d_in[i];
    a.out = out; a.ws = ws;
    launch_mk(a, 0, 10, 0, stream);
}
```
